# Optimizing an MI355X kernel written in HIP

```python
import math
import jax, jax.numpy as jnp
from jax import lax
import numpy as np

D_MODEL = 1024
BATCH = 2
SEQ = 8192
DEPTH = 2

N_MIXERS = 2
N_SB_LAYERS = (DEPTH + N_MIXERS - 1) // N_MIXERS
N_NSA_LAYERS = DEPTH // N_MIXERS
N_HEADS = 16
HEAD_DIM = 64
MIX_WIDTH = N_HEADS * HEAD_DIM
N_KV_HEADS = 4
GROUP = N_HEADS // N_KV_HEADS
SB_IN = 3 * MIX_WIDTH
NSA_IN = MIX_WIDTH + 6 * N_KV_HEADS * HEAD_DIM + 3 * N_HEADS
D_FF = ((8 * D_MODEL + 2) // 3 + 255) // 256 * 256
PLE_DIM = 256
Q_BLOCK = 128
REL_BUCKETS = 32
REL_MAX_DIST = 128
CMP_LEN = 32
CMP_STRIDE = 16
CMP_HIDDEN = 256
SEL_LEN = 64
SEL_TOPK = 16
WINDOW = 512
FORCED_SCORE = 100.0
EPS = 1e-6

kernel_name = "hybrid_stickbreak_nsa_trunk"


def rms_norm(x, g):
    xf = x.astype(jnp.float32)
    y = xf * lax.rsqrt(jnp.mean(xf * xf, axis=-1, keepdims=True) + EPS)
    return (y * g.astype(jnp.float32)).astype(x.dtype)


def rel_bucket(dist):
    n = jnp.maximum(dist, 0)
    exact = REL_BUCKETS // 2
    nf = jnp.maximum(n, 1).astype(jnp.float32)
    large = exact + (jnp.log(nf / exact) / math.log(REL_MAX_DIST / exact)
                     * (REL_BUCKETS - exact)).astype(jnp.int32)
    large = jnp.minimum(large, REL_BUCKETS - 1)
    return jnp.where(n < exact, n, large)


def swiglu(x, w_in, w_out):
    a, b = jnp.split(x @ w_in, 2, axis=-1)
    return (jax.nn.silu(a) * b) @ w_out


def stick_breaking_attention(h, w_in, w_out):
    B, S, _ = h.shape
    qkv = (h @ w_in).reshape(B, S, 3, N_HEADS, HEAD_DIM).transpose(2, 0, 3, 1, 4)
    q, k, v = qkv[0], qkv[1], qkv[2]
    scale = HEAD_DIM ** -0.5
    kpos = jnp.arange(S)

    def block(q0):
        qb = lax.dynamic_slice_in_dim(q, q0, Q_BLOCK, axis=2)
        z = jnp.einsum('bhqd,bhkd->bhqk', qb, k).astype(jnp.float32) * scale
        t = q0 + jnp.arange(Q_BLOCK)
        causal = kpos[None, :] < t[:, None]
        log_fail = jnp.where(causal, jax.nn.log_sigmoid(-z), 0.0)
        after = lax.cumsum(log_fail, axis=3, reverse=True) - log_fail
        a = jnp.where(causal, jnp.exp(jax.nn.log_sigmoid(z) + after), 0.0)
        return jnp.einsum('bhqk,bhkd->bhqd', a, v.astype(jnp.float32))

    out = lax.map(block, jnp.arange(0, S, Q_BLOCK))
    out = out.transpose(1, 0, 3, 2, 4).reshape(B, S, MIX_WIDTH).astype(h.dtype)
    return out @ w_out


def native_sparse_attention(h, w_in, w_out, rel_bias, pe_k, pe_v,
                            ck_w1, ck_w2, cv_w1, cv_w2):
    B, S, _ = h.shape
    scale = HEAD_DIM ** -0.5
    proj = h @ w_in
    q = proj[..., :MIX_WIDTH].reshape(B, S, N_KV_HEADS, GROUP, HEAD_DIM)
    q = q.transpose(0, 2, 3, 1, 4)
    kv_end = MIX_WIDTH + 6 * N_KV_HEADS * HEAD_DIM
    kv = proj[..., MIX_WIDTH:kv_end].reshape(B, S, 6, N_KV_HEADS, HEAD_DIM)
    kv = kv.transpose(2, 0, 3, 1, 4)
    k_cmp, v_cmp, k_sel, v_sel, k_win, v_win = (kv[i] for i in range(6))
    gates = jax.nn.sigmoid(proj[..., kv_end:].astype(jnp.float32))
    gates = gates.reshape(B, S, 3, N_KV_HEADS, GROUP).transpose(2, 0, 3, 4, 1)

    n_cmp = (S - CMP_LEN) // CMP_STRIDE + 1
    win_idx = jnp.arange(n_cmp)[:, None] * CMP_STRIDE + jnp.arange(CMP_LEN)[None, :]

    def compress(kx, pe, w1, w2):
        blocks = kx[:, :, win_idx] + pe
        flat = blocks.reshape(B, N_KV_HEADS, n_cmp, CMP_LEN * HEAD_DIM)
        return jax.nn.gelu(flat @ w1) @ w2

    kc = compress(k_cmp, pe_k, ck_w1, ck_w2)
    vc = compress(v_cmp, pe_v, cv_w1, cv_w2)
    cmp_start = jnp.arange(n_cmp) * CMP_STRIDE
    cmp_end = cmp_start + CMP_LEN - 1

    n_sel = S // SEL_LEN
    top_k = min(SEL_TOPK, n_sel)
    sel_ids = jnp.arange(n_sel)
    sel_start = sel_ids * SEL_LEN
    overlap = ((cmp_start[:, None] < sel_start[None, :] + SEL_LEN)
               & (cmp_start[:, None] + CMP_LEN > sel_start[None, :])).astype(jnp.float32)
    ks_b = k_sel.reshape(B, N_KV_HEADS, n_sel, SEL_LEN, HEAD_DIM)
    vs_b = v_sel.reshape(B, N_KV_HEADS, n_sel, SEL_LEN, HEAD_DIM)
    b_i = jnp.arange(B)[:, None, None, None]
    h_i = jnp.arange(N_KV_HEADS)[None, :, None, None]
    h_i5 = h_i[..., None]
    table_t = rel_bias.reshape(REL_BUCKETS, N_KV_HEADS, GROUP).transpose(1, 0, 2)

    pad = ((0, 0), (0, 0), (WINDOW, 0), (0, 0))
    kw_pad = jnp.pad(k_win, pad)
    vw_pad = jnp.pad(v_win, pad)
    slab = Q_BLOCK + WINDOW
    dist_w = jnp.arange(Q_BLOCK)[:, None] - jnp.arange(slab)[None, :] + WINDOW
    band = (dist_w >= 0) & (dist_w < WINDOW)
    bias_w = rel_bias[rel_bucket(dist_w)].reshape(Q_BLOCK, slab, N_KV_HEADS, GROUP)
    bias_w = bias_w.transpose(2, 3, 0, 1).astype(jnp.float32)

    def block(q0):
        t = q0 + jnp.arange(Q_BLOCK)
        qb = lax.dynamic_slice_in_dim(q, q0, Q_BLOCK, axis=3)

        dist_c = t[:, None] - cmp_end[None, :]
        bias_c = rel_bias[rel_bucket(dist_c)].reshape(Q_BLOCK, n_cmp, N_KV_HEADS, GROUP)
        bias_c = bias_c.transpose(2, 3, 0, 1).astype(jnp.float32)
        s_c = jnp.einsum('bhgqd,bhnd->bhgqn', qb, kc).astype(jnp.float32) * scale + bias_c
        s_c = jnp.where(dist_c >= 0, s_c, -jnp.inf)
        m_c = jnp.max(s_c, axis=-1, keepdims=True)
        e_c = jnp.exp(s_c - jnp.where(jnp.isfinite(m_c), m_c, 0.0))
        den_c = jnp.sum(e_c, axis=-1, keepdims=True)
        p_c = e_c / jnp.where(den_c > 0, den_c, 1.0)
        o_c = jnp.einsum('bhgqn,bhnd->bhgqd', p_c, vc.astype(jnp.float32))

        imp = jnp.einsum('bhgqn,ns->bhqs', p_c, overlap)
        cur = t // SEL_LEN
        forced = ((sel_ids[None, :] == 0) | (sel_ids[None, :] == cur[:, None])
                  | (sel_ids[None, :] == cur[:, None] - 1))
        causal_blk = sel_ids[None, :] <= cur[:, None]
        imp = jnp.where(forced, FORCED_SCORE, jnp.where(causal_blk, imp, -1.0))
        _, idx = lax.top_k(imp, top_k)
        kg = ks_b[b_i, h_i, idx]
        vg = vs_b[b_i, h_i, idx]
        pos = idx[..., None] * SEL_LEN + jnp.arange(SEL_LEN)
        dist_s = t[None, None, :, None, None] - pos
        bias_s = jnp.moveaxis(table_t[h_i5, rel_bucket(dist_s)], -1, 2).astype(jnp.float32)
        s_s = jnp.einsum('bhgqd,bhqkld->bhgqkl', qb, kg).astype(jnp.float32) * scale + bias_s
        s_s = jnp.where((dist_s >= 0)[:, :, None], s_s, -jnp.inf)
        s_s = s_s.reshape(B, N_KV_HEADS, GROUP, Q_BLOCK, top_k * SEL_LEN)
        p_s = jax.nn.softmax(s_s, axis=-1).reshape(B, N_KV_HEADS, GROUP, Q_BLOCK, top_k, SEL_LEN)
        o_s = jnp.einsum('bhgqkl,bhqkld->bhgqd', p_s, vg.astype(jnp.float32))

        kw = lax.dynamic_slice_in_dim(kw_pad, q0, slab, axis=2)
        vw = lax.dynamic_slice_in_dim(vw_pad, q0, slab, axis=2)
        ok_w = band & ((q0 - WINDOW + jnp.arange(slab)) >= 0)[None, :]
        s_w = jnp.einsum('bhgqd,bhkd->bhgqk', qb, kw).astype(jnp.float32) * scale + bias_w
        p_w = jax.nn.softmax(jnp.where(ok_w, s_w, -jnp.inf), axis=-1)
        o_w = jnp.einsum('bhgqk,bhkd->bhgqd', p_w, vw.astype(jnp.float32))

        g = lax.dynamic_slice_in_dim(gates, q0, Q_BLOCK, axis=4)[..., None]
        return g[0] * o_c + g[1] * o_s + g[2] * o_w

    out = lax.map(block, jnp.arange(0, S, Q_BLOCK))
    out = out.transpose(1, 0, 4, 2, 3, 5).reshape(B, S, MIX_WIDTH).astype(h.dtype)
    return out @ w_out


def setup_inputs(seed: int = 0) -> dict:
    key = jax.random.key(seed)
    ks = jax.random.split(key, 24)
    f32 = jnp.float32

    def nrm(k, shape, scale):
        return jax.random.normal(k, shape, f32) * scale

    def gain(k, shape):
        return 1.0 + 0.01 * jax.random.normal(k, shape, f32)

    return {
        "x": nrm(ks[0], (BATCH, SEQ, D_MODEL), 1.0),
        "p": nrm(ks[1], (DEPTH, BATCH, SEQ, PLE_DIM), 1.0),
        "rel_bias": nrm(ks[2], (REL_BUCKETS, N_HEADS), 0.5),
        "norm_mix": gain(ks[3], (DEPTH, D_MODEL)),
        "norm_ffn": gain(ks[4], (DEPTH, D_MODEL)),
        "norm_ple": gain(ks[5], (DEPTH, D_MODEL)),
        "final_norm": gain(ks[6], (D_MODEL,)),
        "sb_w_in": nrm(ks[7], (N_SB_LAYERS, D_MODEL, SB_IN), D_MODEL ** -0.5),
        "sb_w_out": nrm(ks[8], (N_SB_LAYERS, MIX_WIDTH, D_MODEL), MIX_WIDTH ** -0.5),
        "nsa_w_in": nrm(ks[9], (N_NSA_LAYERS, D_MODEL, NSA_IN), D_MODEL ** -0.5),
        "nsa_w_out": nrm(ks[10], (N_NSA_LAYERS, MIX_WIDTH, D_MODEL), MIX_WIDTH ** -0.5),
        "nsa_pe_k": nrm(ks[11], (N_NSA_LAYERS, CMP_LEN, HEAD_DIM), 0.02),
        "nsa_pe_v": nrm(ks[12], (N_NSA_LAYERS, CMP_LEN, HEAD_DIM), 0.02),
        "nsa_ck_w1": nrm(ks[13], (N_NSA_LAYERS, CMP_LEN * HEAD_DIM, CMP_HIDDEN), (CMP_LEN * HEAD_DIM) ** -0.5),
        "nsa_ck_w2": nrm(ks[14], (N_NSA_LAYERS, CMP_HIDDEN, HEAD_DIM), CMP_HIDDEN ** -0.5),
        "nsa_cv_w1": nrm(ks[15], (N_NSA_LAYERS, CMP_LEN * HEAD_DIM, CMP_HIDDEN), (CMP_LEN * HEAD_DIM) ** -0.5),
        "nsa_cv_w2": nrm(ks[16], (N_NSA_LAYERS, CMP_HIDDEN, HEAD_DIM), CMP_HIDDEN ** -0.5),
        "ffn_w_in": nrm(ks[17], (DEPTH, D_MODEL, 2 * D_FF), D_MODEL ** -0.5),
        "ffn_w_out": nrm(ks[18], (DEPTH, D_FF, D_MODEL), D_FF ** -0.5),
        "ple_w_proj": nrm(ks[19], (DEPTH, PLE_DIM, D_MODEL), PLE_DIM ** -0.5),
        "ple_w_gate": nrm(ks[20], (DEPTH, D_MODEL, D_MODEL), D_MODEL ** -0.5),
    }


def reference(x, p, rel_bias, norm_mix, norm_ffn, norm_ple, final_norm,
              sb_w_in, sb_w_out, nsa_w_in, nsa_w_out, nsa_pe_k, nsa_pe_v,
              nsa_ck_w1, nsa_ck_w2, nsa_cv_w1, nsa_cv_w2,
              ffn_w_in, ffn_w_out, ple_w_proj, ple_w_gate):
    h = x
    for i in range(DEPTH):
        j = i // N_MIXERS
        hn = rms_norm(h, norm_mix[i])
        if i % N_MIXERS == 0:
            mix = stick_breaking_attention(hn, sb_w_in[j], sb_w_out[j])
        else:
            mix = native_sparse_attention(hn, nsa_w_in[j], nsa_w_out[j], rel_bias,
                                          nsa_pe_k[j], nsa_pe_v[j], nsa_ck_w1[j],
                                          nsa_ck_w2[j], nsa_cv_w1[j], nsa_cv_w2[j])
        h = h + mix
        h = h + swiglu(rms_norm(h, norm_ffn[i]), ffn_w_in[i], ffn_w_out[i])
        gate = jax.nn.sigmoid(rms_norm(h, norm_ple[i]) @ ple_w_gate[i])
        h = h + gate * (p[i] @ ple_w_proj[i])
    return rms_norm(h, final_norm)
```

```cpp
#include <hip/hip_runtime.h>
#include <hip/hip_bf16.h>
#include <cstdio>
#include <cstdint>
#include <cmath>
namespace pg8 {
#define PG8_LAS __attribute__((address_space(3)))
typedef unsigned short bf16_t;
typedef short bf16x8 __attribute__((ext_vector_type(8)));
typedef float f32x4 __attribute__((ext_vector_type(4)));
typedef float f32x2 __attribute__((ext_vector_type(2)));
typedef unsigned u32x4 __attribute__((ext_vector_type(4)));
typedef unsigned u32x2 __attribute__((ext_vector_type(2)));
constexpr int BM = 256, BK = 64, HALF = 128, HTB = HALF * BK * 2  , STAGE_BYTES = 8 * HTB, NXCD = 8, WGM = 8;

__host__ __device__ __forceinline__ int lds_byte(int r, int c) { const int st = (r >> 4) * 2 + (c >> 5), rr = r & 15, cc = c & 31, ob = rr * 64 + cc * 2; return st * 1024 + (ob ^ (((ob >> 9) & 1) << 5)); }
__host__ __device__ __forceinline__ void stage_rc(int b, int& R, int& C) { const int st = b / 1024, sb = b % 1024, swz = sb ^ (((sb >> 9) & 1) << 5); R = (st >> 1) * 16 + swz / 64; C = (st & 1) * 32 + (swz % 64) / 2; }
__host__ __device__ __forceinline__ int perm32(int rho) { const int n = rho >> 4, i = rho & 15; return 8 * (i >> 2) + 4 * n + (i & 3); }

struct Unit { int pm, pn; };
struct Gemm { const bf16_t* A; const bf16_t* Bt; };

struct StaticOrder {
    int nM, nN, nwg, G, c;
    __host__ __device__ void init(int M, int N, int G_, int c_) { nM = M / BM; nN = N / BM; nwg = nM * nN; G = G_; c = c_; }
    __host__ __device__ bool next(int i, Unit& u) const {
        const long L = (long)i * G + c; if (L >= nwg) return false;
        int wgid = (int)L; { const int q = nwg / NXCD, r = nwg % NXCD, xcd = wgid % NXCD, off = wgid / NXCD; wgid = (xcd < r ? xcd * (q + 1) : r * (q + 1) + (xcd - r) * q) + off; }
        const int nig = WGM * nN, gid = wgid / nig, fm = gid * WGM, gsz = (nM - fm) < WGM ? (nM - fm) : WGM;
        u.pm = fm + ((wgid % nig) % gsz); u.pn = (wgid % nig) / gsz; return true;
    }
    __device__ __forceinline__ void a_ready(const Unit&) const {}
    __device__ __forceinline__ void done(const Unit&) const {}
};
struct OneUnit {
    bool has;
    __device__ __forceinline__ bool next(int i, Unit& u) const { if (i > 0 || !has) return false; u.pm = 0; u.pn = 0; return true; }
    __device__ __forceinline__ void a_ready(const Unit&) const {}
    __device__ __forceinline__ void done(const Unit&) const {}
};

__device__ __forceinline__ unsigned cvt_pk_bf16(float lo, float hi) { unsigned r; asm volatile("v_cvt_pk_bf16_f32 %0, %1, %2" : "=v"(r) : "v"(lo), "v"(hi)); return r; }
__device__ __forceinline__ float sigmoidf_(float x) { return 1.0f / (1.0f + __expf(-x)); }

constexpr int SEQ_ = 8192;
__device__ __forceinline__ void load_rstd(const float* ssq, const Unit& u, int wr, int fr, int fq, float (&rs)[2][4]) {
#pragma unroll
    for (int ai = 0; ai < 2; ++ai)
#pragma unroll
        for (int m = 0; m < 4; ++m) {
            const int row = u.pm * BM + ai * HALF + wr * 64 + m * 16 + fr;
            const f32x4 v = *(const f32x4*)(ssq + (size_t)row * 16 + 4 * fq);
            float s = (v[0] + v[1]) + (v[2] + v[3]);
            s += __shfl_xor(s, 16); s += __shfl_xor(s, 32);
            rs[ai][m] = rsqrtf(s * (1.0f / 1024.0f) + 1e-6f);
        }
}
struct EpiQKV {
    static constexpr bool PERM = true, AFTER_DRAIN = false;
    const float* ssq; bf16_t* Q; bf16_t* Kh; bf16_t* Vh;
    __device__ __forceinline__ void operator()(const f32x4 (&acc)[2][2][4][2], const Unit& u, int wr, int wc, int fr_, int fq_) const {
        int fr = fr_, fq = fq_; asm volatile("" : "+v"(fr), "+v"(fq));
        float rs[2][4]; load_rstd(ssq, u, wr, fr, fq, rs);
        const int t3 = u.pn >> 2; const int ct = (u.pn & 3) * 256 + wc * 32 + 8 * fq; const float sc = t3 == 0 ? 0.125f : 1.0f;
#pragma unroll
        for (int ai = 0; ai < 2; ++ai)
#pragma unroll
            for (int m = 0; m < 4; ++m) { const int row = u.pm * BM + ai * HALF + wr * 64 + m * 16 + fr; const int b = row >> 13, s = row & (SEQ_ - 1); const float r = rs[ai][m] * sc;
#pragma unroll
                for (int bj = 0; bj < 2; ++bj) { const int c = ct + bj * HALF; const f32x4 v0 = acc[ai][bj][m][0] * r, v1 = acc[ai][bj][m][1] * r;
                    u32x4 w; w.x = cvt_pk_bf16(v0[0], v0[1]); w.y = cvt_pk_bf16(v0[2], v0[3]); w.z = cvt_pk_bf16(v1[0], v1[1]); w.w = cvt_pk_bf16(v1[2], v1[3]);
                    bf16_t* dst;
                    if (t3 == 0) dst = Q + (size_t)row * 1024 + c;
                    else dst = (t3 == 1 ? Kh : Vh) + ((size_t)(b * 16 + (c >> 6)) * SEQ_ + s) * 64 + (c & 63);
                    *(u32x4*)dst = w; } }
    }
};
struct EpiNSA {
    static constexpr bool PERM = true, AFTER_DRAIN = false;
    const float* ssq; bf16_t* Q; bf16_t* KV; size_t kvsz; float* gates;
    __device__ __forceinline__ void operator()(const f32x4 (&acc)[2][2][4][2], const Unit& u, int wr, int wc, int fr_, int fq_) const {
        int fr = fr_, fq = fq_; asm volatile("" : "+v"(fr), "+v"(fq));
        float rs[2][4]; load_rstd(ssq, u, wr, fr, fq, rs);
        const int pn = u.pn; const int cw = wc * 32 + 8 * fq;
#pragma unroll
        for (int ai = 0; ai < 2; ++ai)
#pragma unroll
            for (int m = 0; m < 4; ++m) { const int row = u.pm * BM + ai * HALF + wr * 64 + m * 16 + fr; const int b = row >> 13, s = row & (SEQ_ - 1);
#pragma unroll
                for (int bj = 0; bj < 2; ++bj) { const int c = cw + bj * HALF;
                    if (pn < 10) { const float r = rs[ai][m] * (pn < 4 ? 0.125f : 1.0f); const f32x4 v0 = acc[ai][bj][m][0] * r, v1 = acc[ai][bj][m][1] * r;
                        u32x4 w; w.x = cvt_pk_bf16(v0[0], v0[1]); w.y = cvt_pk_bf16(v0[2], v0[3]); w.z = cvt_pk_bf16(v1[0], v1[1]); w.w = cvt_pk_bf16(v1[2], v1[3]);
                        bf16_t* dst;
                        if (pn < 4) dst = Q + (size_t)row * 1024 + pn * 256 + c;
                        else dst = KV + (size_t)(pn - 4) * kvsz + ((size_t)(b * 4 + (c >> 6)) * SEQ_ + s) * 64 + (c & 63);
                        *(u32x4*)dst = w;
                    } else if (c < 64) { const float r = rs[ai][m]; f32x4 v0 = acc[ai][bj][m][0] * r, v1 = acc[ai][bj][m][1] * r;
#pragma unroll
                        for (int e = 0; e < 4; ++e) { v0[e] = sigmoidf_(v0[e]); v1[e] = sigmoidf_(v1[e]); }
                        float* dst = gates + (size_t)row * 64 + c; *(f32x4*)dst = v0; *(f32x4*)(dst + 4) = v1; } } }
    }
};
struct EpiSwiglu {
    static constexpr bool PERM = true, AFTER_DRAIN = false;
    const float* ssq; bf16_t* act;
    __device__ __forceinline__ void operator()(const f32x4 (&acc)[2][2][4][2], const Unit& u, int wr, int wc, int fr_, int fq_) const {
        int fr = fr_, fq = fq_; asm volatile("" : "+v"(fr), "+v"(fq));
        float rs[2][4]; load_rstd(ssq, u, wr, fr, fq, rs);
        const int c0 = u.pn * 128 + wc * 16 + 4 * fq;
#pragma unroll
        for (int ai = 0; ai < 2; ++ai)
#pragma unroll
            for (int m = 0; m < 4; ++m) { const int row = u.pm * BM + ai * HALF + wr * 64 + m * 16 + fr; const float r = rs[ai][m];
#pragma unroll
                for (int bj = 0; bj < 2; ++bj) { const f32x4 a = acc[ai][bj][m][0] * r, bb = acc[ai][bj][m][1] * r; f32x4 o;
#pragma unroll
                    for (int e = 0; e < 4; ++e) o[e] = a[e] * sigmoidf_(a[e]) * bb[e];
                    u32x2 w; w.x = cvt_pk_bf16(o[0], o[1]); w.y = cvt_pk_bf16(o[2], o[3]);
                    *(u32x2*)(act + (size_t)row * 2816 + c0 + bj * 64) = w; } }
    }
};
struct EpiBf16Plain {
    static constexpr bool PERM = true, AFTER_DRAIN = false;
    bf16_t* O; int ldc;
    __device__ __forceinline__ void operator()(const f32x4 (&acc)[2][2][4][2], const Unit& u, int wr, int wc, int fr_, int fq_) const {
        int fr = fr_, fq = fq_; asm volatile("" : "+v"(fr), "+v"(fq));
        const int c0 = u.pn * BM + wc * 32 + 8 * fq;
#pragma unroll
        for (int ai = 0; ai < 2; ++ai)
#pragma unroll
            for (int m = 0; m < 4; ++m) { const int row = u.pm * BM + ai * HALF + wr * 64 + m * 16 + fr;
#pragma unroll
                for (int bj = 0; bj < 2; ++bj) { const f32x4 v0 = acc[ai][bj][m][0], v1 = acc[ai][bj][m][1];
                    u32x4 w; w.x = cvt_pk_bf16(v0[0], v0[1]); w.y = cvt_pk_bf16(v0[2], v0[3]); w.z = cvt_pk_bf16(v1[0], v1[1]); w.w = cvt_pk_bf16(v1[2], v1[3]);
                    *(u32x4*)(O + (size_t)row * ldc + c0 + bj * HALF) = w; } }
    }
};
struct EpiRes {
    static constexpr bool PERM = false, AFTER_DRAIN = false;
    const float* base; float* out; bf16_t* hb; float* ssq;
    __device__ __forceinline__ void operator()(const f32x4 (&acc)[2][2][4][2], const Unit& u, int wr, int wc, int fr_, int fq_) const {
        int fr = fr_, fq = fq_; asm volatile("" : "+v"(fr), "+v"(fq));
        const int c0 = u.pn * BM + wc * 32 + 4 * fq;
#pragma unroll
        for (int ai = 0; ai < 2; ++ai)
#pragma unroll
            for (int m = 0; m < 4; ++m) { const int row = u.pm * BM + ai * HALF + wr * 64 + m * 16 + fr; const size_t off = (size_t)row * 1024 + c0; float s = 0.f;
#pragma unroll
                for (int bj = 0; bj < 2; ++bj)
#pragma unroll
                    for (int n = 0; n < 2; ++n) { const size_t o2 = off + bj * HALF + n * 16; const f32x4 v = *(const f32x4*)(base + o2) + acc[ai][bj][m][n];
                        *(f32x4*)(out + o2) = v; u32x2 w; w.x = cvt_pk_bf16(v[0], v[1]); w.y = cvt_pk_bf16(v[2], v[3]); *(u32x2*)(hb + o2) = w;
                        s += (v[0] * v[0] + v[1] * v[1]) + (v[2] * v[2] + v[3] * v[3]); }
                s += __shfl_xor(s, 16); s += __shfl_xor(s, 32);
                if (fq == 0) ssq[(size_t)row * 16 + u.pn * 4 + wc] = s; }
    }
};
struct EpiGate {
    static constexpr bool PERM = false, AFTER_DRAIN = false;
    const float* ssq_in; const float* base; float* out; bf16_t* pp; float* ssq_out;
    __device__ __forceinline__ void operator()(const f32x4 (&acc)[2][2][4][2], const Unit& u, int wr, int wc, int fr_, int fq_) const {
        int fr = fr_, fq = fq_; asm volatile("" : "+v"(fr), "+v"(fq));
        float rs[2][4]; load_rstd(ssq_in, u, wr, fr, fq, rs);
        const int c0 = u.pn * BM + wc * 32 + 4 * fq;
#pragma unroll
        for (int ai = 0; ai < 2; ++ai)
#pragma unroll
            for (int m = 0; m < 4; ++m) { const int row = u.pm * BM + ai * HALF + wr * 64 + m * 16 + fr; const size_t off = (size_t)row * 1024 + c0; const float r = rs[ai][m]; float s = 0.f;
#pragma unroll
                for (int bj = 0; bj < 2; ++bj)
#pragma unroll
                    for (int n = 0; n < 2; ++n) { const size_t o2 = off + bj * HALF + n * 16; const u32x2 pw = *(const u32x2*)(pp + o2);
                        f32x4 pv; pv[0] = __uint_as_float(pw.x << 16); pv[1] = __uint_as_float(pw.x & 0xffff0000u); pv[2] = __uint_as_float(pw.y << 16); pv[3] = __uint_as_float(pw.y & 0xffff0000u);
                        const f32x4 a = acc[ai][bj][m][n] * r; f32x4 v = *(const f32x4*)(base + o2);
#pragma unroll
                        for (int e = 0; e < 4; ++e) v[e] += sigmoidf_(a[e]) * pv[e];
                        *(f32x4*)(out + o2) = v; u32x2 w; w.x = cvt_pk_bf16(v[0], v[1]); w.y = cvt_pk_bf16(v[2], v[3]); *(u32x2*)(pp + o2) = w;
                        s += (v[0] * v[0] + v[1] * v[1]) + (v[2] * v[2] + v[3] * v[3]); }
                s += __shfl_xor(s, 16); s += __shfl_xor(s, 32);
                if (fq == 0) ssq_out[(size_t)row * 16 + u.pn * 4 + wc] = s; }
    }
};
struct EpiSlab {
    static constexpr bool PERM = false, AFTER_DRAIN = false;
    float* slab;
    __device__ __forceinline__ void operator()(const f32x4 (&acc)[2][2][4][2], const Unit& u, int wr, int wc, int fr_, int fq_) const {
        int fr = fr_, fq = fq_; asm volatile("" : "+v"(fr), "+v"(fq));
        const int c0 = wc * 32 + 4 * fq;
#pragma unroll
        for (int ai = 0; ai < 2; ++ai)
#pragma unroll
            for (int m = 0; m < 4; ++m) { const int row = ai * HALF + wr * 64 + m * 16 + fr;
#pragma unroll
                for (int bj = 0; bj < 2; ++bj)
#pragma unroll
                    for (int n = 0; n < 2; ++n) *(f32x4*)(slab + (size_t)row * 256 + c0 + bj * HALF + n * 16) = acc[ai][bj][m][n]; }
    }
};

template <class Epi, class Sched, int LDA, int LDB, int KK, bool ALIGN_EPI = false, bool SP2 = false>
__device__ __forceinline__ void gemm_phase(PG8_LAS unsigned char* lds, const Gemm g, const Sched& S, const Epi& E) {
    int tid_ = threadIdx.x; asm volatile("" : "+v"(tid_));
    const int tid = tid_, wid = __builtin_amdgcn_readfirstlane(tid >> 6), lane = tid & 63, wr = wid >> 2, wc = wid & 3, fr = lane & 15, fq = lane >> 4;
    constexpr int K = KK, nt = K / BK;
    unsigned voffA[2], voffB[2];
#pragma unroll
    for (int i = 0; i < 2; ++i) { int R, C; stage_rc(tid * 16 + i * 8192, R, C); const int Rb = Epi::PERM ? ((R & ~31) + perm32(R & 31)) : R;
        voffA[i] = (unsigned)(R * LDA + C) * 2u; voffB[i] = (unsigned)(Rb * LDB + C) * 2u; }
    constexpr size_t kstep = (size_t)(BK * 2);
    constexpr size_t hstepA = (size_t)HALF * LDA * 2, hstepB = (size_t)HALF * LDB * 2;
    constexpr size_t tstepA = 2 * hstepA, tstepB = 2 * hstepB;
    const unsigned ldsw = (unsigned)wid * 1024u;
    const int aoff = lds_byte(wr * 64 + fr, fq * 8), boff = lds_byte(wc * 32 + fr, fq * 8);
#define PG8_SA(b, h) (((b) * 2 + (h)) * HTB)
#define PG8_SB(b, h) ((4 + (b) * 2 + (h)) * HTB)
#define PG8_STAGE_(bufoff, rsrc, soff, voff) do { _Pragma("unroll") for (int _i = 0; _i < 2; ++_i) \
        __builtin_amdgcn_raw_ptr_buffer_load_lds(rsrc, (PG8_LAS unsigned*)(lds + (bufoff) + ldsw + _i * 8192), 16, (int)(voff)[_i], (int)(soff), 0, 0); } while (0)
#define PG8_STAGEA(bufoff, soff) PG8_STAGE_(bufoff, rA, soff, voffA)
#define PG8_STAGEB(bufoff, soff) PG8_STAGE_(bufoff, rB, soff, voffB)
#define PG8_LDA(dst, b, h) do { _Pragma("unroll") for (int m = 0; m < 4; ++m) _Pragma("unroll") for (int k = 0; k < 2; ++k) dst[m][k] = *(const PG8_LAS bf16x8*)(lds + PG8_SA(b, h) + aoff + m * 2048 + k * 1024); } while (0)
#define PG8_LDB(dst, b, h) do { _Pragma("unroll") for (int n = 0; n < 2; ++n) _Pragma("unroll") for (int k = 0; k < 2; ++k) dst[n][k] = *(const PG8_LAS bf16x8*)(lds + PG8_SB(b, h) + boff + n * 2048 + k * 1024); } while (0)
#define PG8_MMA(ai, bj, At, Bt) do { __builtin_amdgcn_s_setprio(1); _Pragma("unroll") for (int m = 0; m < 4; ++m) _Pragma("unroll") for (int n = 0; n < 2; ++n) _Pragma("unroll") for (int k = 0; k < 2; ++k) \
        acc[ai][bj][m][n] = __builtin_amdgcn_mfma_f32_16x16x32_bf16(Bt[n][k], At[m][k], acc[ai][bj][m][n], 0, 0, 0); __builtin_amdgcn_s_setprio(0); } while (0)
#define PG8_WAIT_V(n) asm volatile("s_waitcnt vmcnt(" #n ")" ::: "memory")
#define PG8_WAIT_L(n) asm volatile("s_waitcnt lgkmcnt(" #n ")" ::: "memory")
#define PG8_BAR __builtin_amdgcn_s_barrier()
#define PG8_SCHED __builtin_amdgcn_sched_barrier(0)
    Unit cur, nxt; int ui = 0;
    if (!S.next(0, cur)) return;
    f32x4 acc[2][2][4][2];
#pragma unroll
    for (int a = 0; a < 2; ++a)
#pragma unroll
        for (int b = 0; b < 2; ++b)
#pragma unroll
            for (int m = 0; m < 4; ++m)
#pragma unroll
                for (int n = 0; n < 2; ++n) acc[a][b][m][n] = (f32x4){0.f, 0.f, 0.f, 0.f};
    bf16x8 At[4][2], B0[2][2], B1[2][2];
    const __amdgpu_buffer_rsrc_t rA = __builtin_amdgcn_make_buffer_rsrc((void*)g.A, 0, 0x7ffffff0, 0x00020000), rB = __builtin_amdgcn_make_buffer_rsrc((void*)g.Bt, 0, 0x7ffffff0, 0x00020000);
    unsigned cA = (unsigned)cur.pm * (unsigned)tstepA, cB = (unsigned)cur.pn * (unsigned)tstepB;
    S.a_ready(cur);
    if constexpr (SP2) {
        PG8_STAGEB(PG8_SB(0, 0), cB); PG8_STAGEB(PG8_SB(0, 1), cB + hstepB); PG8_STAGEA(PG8_SA(0, 0), cA); PG8_STAGEA(PG8_SA(0, 1), cA + hstepA);
        if (wr == 1) PG8_BAR;
        PG8_WAIT_V(2); PG8_BAR;
        PG8_STAGEB(PG8_SB(1, 0), cB + kstep); PG8_STAGEA(PG8_SA(1, 0), cA + kstep); PG8_STAGEB(PG8_SB(1, 1), cB + hstepB + kstep);
        PG8_WAIT_V(6); PG8_BAR;
    } else {
        PG8_STAGEB(PG8_SB(0, 0), cB); PG8_STAGEA(PG8_SA(0, 0), cA); PG8_STAGEB(PG8_SB(0, 1), cB + hstepB); PG8_STAGEA(PG8_SA(0, 1), cA + hstepA);
        if (wr == 1) PG8_BAR;
        PG8_WAIT_V(4); PG8_BAR;
        PG8_STAGEB(PG8_SB(1, 0), cB + kstep); PG8_STAGEA(PG8_SA(1, 0), cA + kstep); PG8_STAGEB(PG8_SB(1, 1), cB + hstepB + kstep);
        PG8_WAIT_V(6); PG8_BAR;
    }
    for (;;) {
        const bool has_next = S.next(ui + 1, nxt);
        const unsigned nA = has_next ? (unsigned)nxt.pm * (unsigned)tstepA : cA, nB = has_next ? (unsigned)nxt.pn * (unsigned)tstepB : cB;
        for (int t = 0; t < nt; t += 2) {
            const bool last = (t == nt - 2);
            const unsigned a1 = cA + (unsigned)(t + 1) * (unsigned)kstep;
            const unsigned a2 = last ? nA : cA + (unsigned)(t + 2) * (unsigned)kstep, b2 = last ? nB : cB + (unsigned)(t + 2) * (unsigned)kstep;
            const unsigned a3 = a2 + (unsigned)kstep, b3 = b2 + (unsigned)kstep;
            if (last && has_next) S.a_ready(nxt);
            if constexpr (SP2) {
            PG8_LDB(B0, 0, 0); PG8_LDB(B1, 0, 1); PG8_SCHED; PG8_LDA(At, 0, 0); PG8_STAGEA(PG8_SA(1, 1), a1 + hstepA);
            PG8_WAIT_V(8); PG8_WAIT_L(0); PG8_BAR; PG8_MMA(0, 0, At, B0); PG8_MMA(0, 1, At, B1); PG8_BAR; PG8_SCHED;
            PG8_LDA(At, 0, 1); PG8_STAGEB(PG8_SB(0, 0), b2); PG8_STAGEB(PG8_SB(0, 1), b2 + hstepB); PG8_STAGEA(PG8_SA(0, 0), a2);
            PG8_WAIT_V(8); PG8_WAIT_L(0); PG8_BAR; PG8_MMA(1, 0, At, B0); PG8_MMA(1, 1, At, B1); PG8_BAR; PG8_SCHED;
            PG8_LDB(B0, 1, 0); PG8_LDB(B1, 1, 1); PG8_SCHED; PG8_LDA(At, 1, 0); PG8_STAGEA(PG8_SA(0, 1), a2 + hstepA);
            PG8_WAIT_V(8); PG8_WAIT_L(0); PG8_BAR; PG8_MMA(0, 0, At, B0); PG8_MMA(0, 1, At, B1); PG8_BAR; PG8_SCHED;
            PG8_LDA(At, 1, 1); PG8_STAGEB(PG8_SB(1, 0), b3); PG8_STAGEB(PG8_SB(1, 1), b3 + hstepB); PG8_STAGEA(PG8_SA(1, 0), a3);
            PG8_WAIT_V(8); PG8_WAIT_L(0); PG8_BAR; PG8_MMA(1, 0, At, B0); PG8_MMA(1, 1, At, B1); PG8_BAR; PG8_SCHED;
            } else {
            PG8_LDB(B0, 0, 0); PG8_SCHED; PG8_LDA(At, 0, 0); PG8_STAGEA(PG8_SA(1, 1), a1 + hstepA);
            PG8_WAIT_L(8); PG8_BAR; PG8_WAIT_L(0); PG8_MMA(0, 0, At, B0); PG8_BAR; PG8_SCHED;
            PG8_LDB(B1, 0, 1); PG8_STAGEB(PG8_SB(0, 0), b2);
            PG8_BAR; PG8_WAIT_L(0); PG8_MMA(0, 1, At, B1); PG8_BAR;
            PG8_LDA(At, 0, 1); PG8_STAGEA(PG8_SA(0, 0), a2);
            PG8_BAR; PG8_WAIT_L(0); PG8_MMA(1, 0, At, B0); PG8_BAR; PG8_SCHED;
            PG8_STAGEB(PG8_SB(0, 1), b2 + hstepB);
            PG8_WAIT_V(6); PG8_BAR; PG8_MMA(1, 1, At, B1); PG8_BAR;
            PG8_LDB(B0, 1, 0); PG8_SCHED; PG8_LDA(At, 1, 0); PG8_STAGEA(PG8_SA(0, 1), a2 + hstepA);
            PG8_WAIT_L(8); PG8_BAR; PG8_WAIT_L(0); PG8_MMA(0, 0, At, B0); PG8_BAR; PG8_SCHED;
            PG8_LDB(B1, 1, 1); PG8_STAGEB(PG8_SB(1, 0), b3);
            PG8_BAR; PG8_WAIT_L(0); PG8_MMA(0, 1, At, B1); PG8_BAR;
            PG8_LDA(At, 1, 1); PG8_STAGEA(PG8_SA(1, 0), a3);
            PG8_BAR; PG8_WAIT_L(0); PG8_MMA(1, 0, At, B0); PG8_BAR; PG8_SCHED;
            PG8_STAGEB(PG8_SB(1, 1), b3 + hstepB);
            PG8_WAIT_V(6); PG8_BAR; PG8_MMA(1, 1, At, B1); PG8_BAR;
            }
        }
        if constexpr (ALIGN_EPI) { if (wr == 0) PG8_BAR; }
        if constexpr (!Epi::AFTER_DRAIN) { E(acc, cur, wr, wc, fr, fq); S.done(cur); }
        if (!has_next) break;
#pragma unroll
        for (int a = 0; a < 2; ++a)
#pragma unroll
            for (int b = 0; b < 2; ++b)
#pragma unroll
                for (int m = 0; m < 4; ++m)
#pragma unroll
                    for (int n = 0; n < 2; ++n) acc[a][b][m][n] = (f32x4){0.f, 0.f, 0.f, 0.f};
        cur = nxt; cA = nA; cB = nB; ++ui;
        if constexpr (ALIGN_EPI) { if (wr == 1) PG8_BAR; }
    }
    PG8_WAIT_V(0);
    if constexpr (!ALIGN_EPI) { if (wr == 0) PG8_BAR; }
    PG8_BAR;
    if constexpr (Epi::AFTER_DRAIN) { E.fused(acc, cur, wr, wc, fr, fq, lds, wid, lane); S.done(cur); }
#undef PG8_SA
#undef PG8_SB
#undef PG8_STAGE_
#undef PG8_STAGEA
#undef PG8_STAGEB
#undef PG8_LDA
#undef PG8_LDB
#undef PG8_MMA
#undef PG8_WAIT_V
#undef PG8_WAIT_L
#undef PG8_BAR
#undef PG8_SCHED
}
}
#ifndef PG8_SP2
#define PG8_SP2 true
#endif
#ifndef PG8_ALIGN
#define PG8_ALIGN true
#endif
constexpr int NWAVES = 8;
constexpr int BATCH = 2, T = 8192, D = 1024, H = 16, HD = 64, FF = 2816, HKV = 4;
constexpr int M = BATCH * T;
constexpr int NQKV = 3 * D, NNSA_SRC = 2608, NNSA = 2816, NFFI = 2 * FF, PLE = 256;
constexpr int NCMP = 511, CMPH = 256, CMPK = 2048;
constexpr float RMS_EPS = 1e-6f;
constexpr size_t MiB = 1u << 20;
constexpr size_t WS_CTL = 0, CTL_ZERO_BYTES = 1 * MiB;
constexpr size_t WS_WQKV = 2 * MiB;
constexpr size_t WS_WO0  = WS_WQKV + (size_t)NQKV * D * 2;
constexpr size_t WS_WFI0 = WS_WO0 + (size_t)D * D * 2;
constexpr size_t WS_WFO0 = WS_WFI0 + (size_t)NFFI * D * 2;
constexpr size_t WS_WG0  = WS_WFO0 + (size_t)D * FF * 2;
constexpr size_t WS_WP0  = WS_WG0 + (size_t)D * D * 2;
constexpr size_t WS_WNSA = WS_WP0 + (size_t)D * PLE * 2;
constexpr size_t WS_WO1  = WS_WNSA + (size_t)NNSA * D * 2;
constexpr size_t WS_WFI1 = WS_WO1 + (size_t)D * D * 2;
constexpr size_t WS_WFO1 = WS_WFI1 + (size_t)NFFI * D * 2;
constexpr size_t WS_WG1  = WS_WFO1 + (size_t)D * FF * 2;
constexpr size_t WS_WP1  = WS_WG1 + (size_t)D * D * 2;
constexpr size_t WS_WCK  = WS_WP1 + (size_t)D * PLE * 2;
constexpr size_t WS_WCV  = WS_WCK + (size_t)CMPH * CMPK * 2;
constexpr size_t WS_WEND = WS_WCV + (size_t)CMPH * CMPK * 2;
static_assert(WS_WEND <= 58 * MiB, "weights");
constexpr size_t WS_HB   = 58 * MiB;
constexpr size_t WS_SSQ0 = 90 * MiB, WS_SSQ1 = 91 * MiB;
constexpr size_t WS_MISC = 93 * MiB;
constexpr size_t WS_KCVC = 92 * MiB;
constexpr size_t WS_PB   = 94 * MiB;
constexpr size_t WS_QO   = 128 * MiB;
constexpr size_t WS_K0   = 160 * MiB, WS_V0 = 192 * MiB;
constexpr size_t WS_ACT  = 128 * MiB;
constexpr size_t WS_PP   = 224 * MiB;
constexpr size_t WS_KV1  = 160 * MiB;
constexpr size_t KVSZ    = (size_t)BATCH * HKV * T * HD;
constexpr size_t WS_GATES = 208 * MiB;
constexpr size_t WS_SLAB = 212 * MiB;
constexpr size_t WS_END  = 256 * MiB;
static_assert(WS_ACT + (size_t)M * FF * 2 <= WS_PP && WS_SLAB + 32 * MiB <= WS_END, "ws map");
constexpr int CW_TMO = 0, CW_CODE = 1;
constexpr int CW_BAR = 4096;
constexpr int RING_OFF = 0, RING_BYTES = 131072;
constexpr int LDSCTL_OFF = RING_BYTES, MISC_OFF = LDSCTL_OFF + 320;
constexpr int LDS_BYTES = 147456;
static_assert(MISC_OFF + 128 <= LDS_BYTES, "LDS map");

#define GAS __attribute__((address_space(1)))
#define LAS __attribute__((address_space(3)))
typedef unsigned short bf16;
typedef unsigned v4u __attribute__((ext_vector_type(4)));
typedef float f32x4 __attribute__((ext_vector_type(4)));
typedef short bf16x8 __attribute__((ext_vector_type(8)));
typedef GAS unsigned gu32;
typedef GAS unsigned long long gu64;
#define RLX_AGENT __ATOMIC_RELAXED, __HIP_MEMORY_SCOPE_AGENT
#define LDS_WAIT() asm volatile("s_waitcnt lgkmcnt(0)" ::: "memory")
#define VM_WAIT() asm volatile("s_waitcnt vmcnt(0)" ::: "memory")
__device__ __forceinline__ unsigned long long rt() { return __builtin_amdgcn_s_memrealtime(); }
__device__ __forceinline__ unsigned f2bf(float f) { unsigned u = __builtin_bit_cast(unsigned, f); return (u + 0x7fffu + ((u >> 16) & 1u)) >> 16; }
__device__ __forceinline__ unsigned pk2(float lo, float hi) { return f2bf(lo) | (f2bf(hi) << 16); }

#define XB_TMO      128
#define XB_XCNT(j)  (256  + 64 * (j))
#define XB_XSUB(j)  (1280 + 64 * (j))
#define XB_XGEN(j)  (2304 + 64 * (j))
#define XB_TOP      3328
#define XB_TOPGEN   3392
#define XCD_BAR_WORDS 3456
#define XB_SPIN_CAP (1u << 18)

__device__ __forceinline__ unsigned xb_ld(unsigned* p)              { return __hip_atomic_load(p, __ATOMIC_RELAXED, __HIP_MEMORY_SCOPE_AGENT); }
__device__ __forceinline__ unsigned xb_add(unsigned* p, unsigned v) { return __hip_atomic_fetch_add(p, v, __ATOMIC_RELAXED, __HIP_MEMORY_SCOPE_AGENT); }
__device__ __forceinline__ unsigned xb_xcc_id() { return (unsigned)__builtin_amdgcn_s_getreg((3 << 11) | 20) & 0xFu; }
#define XB_SPIN(cond, bar) do { unsigned _sp = 0; while (cond) { __builtin_amdgcn_s_sleep(1); \
    if ((++_sp & 255u) == 0u) { if (xb_ld(&(bar)[XB_TMO])) break; if (_sp > XB_SPIN_CAP) { atomicAdd(&(bar)[XB_TMO], 1u); break; } } } } while (0)

struct XcdBarrier {
    unsigned* bar; unsigned x;
    volatile LAS unsigned* st;
};

__device__ __forceinline__ XcdBarrier xcd_barrier_post(unsigned* bar, volatile LAS unsigned* st) {
    XcdBarrier b; b.bar = bar; b.x = xb_xcc_id(); b.st = st;
    if (threadIdx.x == 0) (void)xb_add(&bar[XB_XCNT(b.x)], 1u);
    return b;
}
__device__ __forceinline__ void xcd_barrier_complete(unsigned* bar, unsigned x, unsigned& nloc, unsigned& nx) {
    const unsigned G = gridDim.x * gridDim.y * gridDim.z;
    unsigned sum, cnt, mine, sp = 0u;
    for (;;) {
        sum = 0u; cnt = 0u; mine = 0u;
#pragma unroll
        for (unsigned j = 0; j < 16; ++j) { const unsigned c = xb_ld(&bar[XB_XCNT(j)]); sum += c; cnt += (c > 0u) ? 1u : 0u; }
        mine = xb_ld(&bar[XB_XCNT(x)]);
        if (sum == G) break;
        __builtin_amdgcn_s_sleep(1);
        if ((++sp & 255u) == 0u) { if (xb_ld(&bar[XB_TMO])) break; if (sp > XB_SPIN_CAP) { atomicAdd(&bar[XB_TMO], 1u); break; } }
    }
    nloc = mine > 0u ? mine : 1u; nx = cnt > 0u ? cnt : 1u;
}

__device__ __forceinline__ void xcd_barrier(const XcdBarrier& b) {
    asm volatile("s_waitcnt vmcnt(0)" ::: "memory");
    __syncthreads();
    if (threadIdx.x == 0) {
        unsigned* bar = b.bar;
        __builtin_amdgcn_s_waitcnt(0);
        unsigned nloc = b.st[0], nx = b.st[1];
        if (nloc == 0u) { xcd_barrier_complete(bar, b.x, nloc, nx); b.st[0] = nloc; b.st[1] = nx; }
        const unsigned old = xb_add(&bar[XB_XSUB(b.x)], 1u);
        const unsigned gen = old / nloc;
        if (old + 1u == (gen + 1u) * nloc) {
            __builtin_amdgcn_fence(__ATOMIC_RELEASE, "agent");
            asm volatile("s_waitcnt vmcnt(0)" ::: "memory");
            const unsigned og = xb_add(&bar[XB_TOP], 1u);
            const unsigned tg = og / nx;
            if (og + 1u == (tg + 1u) * nx) xb_add(&bar[XB_TOPGEN], 1u);
            else XB_SPIN(xb_ld(&bar[XB_TOPGEN]) == tg, bar);
            __builtin_amdgcn_fence(__ATOMIC_ACQUIRE, "agent");
            xb_add(&bar[XB_XGEN(b.x)], 1u);
            asm volatile("s_waitcnt vmcnt(0)" ::: "memory");
        } else {
            XB_SPIN(xb_ld(&bar[XB_XGEN(b.x)]) == gen, bar);
            __builtin_amdgcn_fence(__ATOMIC_ACQUIRE, "agent");
            asm volatile("s_waitcnt vmcnt(0)" ::: "memory");
        }
    }
    __syncthreads();
}
struct Frame {
    LAS unsigned char* lds;
    int tid, lane, wave;
    int vcu, G;
};
struct Args { const float* in[21]; float* out; unsigned char* ws; };
__device__ __forceinline__ const Args* kargs() { const Args* p = (const Args*)__builtin_amdgcn_kernarg_segment_ptr(); asm volatile("" : "+s"(p)); return p; }
__device__ __forceinline__ float wave_sum(float v) {
#pragma unroll
    for (int o = 1; o < 64; o <<= 1) v += __shfl_xor(v, o);
    return v;
}
__device__ __forceinline__ float wave_max(float v) {
#pragma unroll
    for (int o = 1; o < 64; o <<= 1) v = fmaxf(v, __shfl_xor(v, o));
    return v;
}
__device__ __forceinline__ unsigned long long wave_max_u64(unsigned long long v) {
#pragma unroll
    for (int o = 1; o < 64; o <<= 1) { const unsigned lo = __shfl_xor((unsigned)v, o), hi = __shfl_xor((unsigned)(v >> 32), o); const unsigned long long w = ((unsigned long long)hi << 32) | lo; v = w > v ? w : v; }
    return v;
}
__device__ __forceinline__ float bflo(unsigned u) { return __uint_as_float(u << 16); }
__device__ __forceinline__ float bfhi(unsigned u) { return __uint_as_float(u & 0xffff0000u); }
__device__ __forceinline__ float bf2f(bf16 u) { return __uint_as_float((unsigned)u << 16); }

template <int MAP> __device__ __forceinline__ void conv_item(const float* W, int K, int Nsrc, int Ndst, const float* gain, bf16* WT, LAS float* scr, int item, int lane) {
    const int nblk = Ndst / 32, kb = item / nblk, nb = item % nblk, k0 = 64 * kb, n0 = 32 * nb;
    const int nd = n0 + (lane & 31);
    int sc = nd; if (MAP == 1) sc = nd < Nsrc ? nd : -1; if (MAP == 2) sc = ((nd & 4) ? FF : 0) + 4 * (nd >> 3) + (nd & 3);
#pragma unroll 8
    for (int i = 0; i < 32; ++i) { const int kk = 2 * i + (lane >> 5); float v = 0.f;
        if (sc >= 0) { v = W[(size_t)(k0 + kk) * Nsrc + sc]; if (gain) v *= gain[k0 + kk]; }
        scr[kk * 33 + (lane & 31)] = v; }
    LDS_WAIT(); asm volatile("" ::: "memory");
    const int c = lane & 7;
#pragma unroll
    for (int j = 0; j < 4; ++j) { const int n = (lane >> 3) + 8 * j; const LAS float* s = scr + (8 * c) * 33 + n;
        v4u o; o.x = pk2(s[0 * 33], s[1 * 33]); o.y = pk2(s[2 * 33], s[3 * 33]); o.z = pk2(s[4 * 33], s[5 * 33]); o.w = pk2(s[6 * 33], s[7 * 33]);
        *(GAS v4u*)(WT + (size_t)(n0 + n) * K + k0 + 8 * c) = o; }
    LDS_WAIT(); asm volatile("" ::: "memory");
}
#define WSP(T_, off) ((T_*)(ap->ws + (off)))
__device__ __forceinline__ void p0_prologue(Frame& F) {
    const Args* ap = kargs();
    LAS float* scr = (LAS float*)(F.lds + RING_OFF + F.wave * 16384);
    const int gw = F.vcu * NWAVES + F.wave, NGW = F.G * NWAVES;
    constexpr int I_QKV = (D / 64) * (NQKV / 32), I_DD = (D / 64) * (D / 32), I_FI = (D / 64) * (NFFI / 32), I_FO = (FF / 64) * (D / 32), I_P = (PLE / 64) * (D / 32),
                  I_NSA = (D / 64) * (NNSA / 32), I_C = (CMPK / 64) * (CMPH / 32);
    constexpr int NITEMS = I_QKV + I_DD + I_FI + I_FO + I_DD + I_P + I_NSA + I_DD + I_FI + I_FO + I_DD + I_P + I_C + I_C;
    for (int it = gw; it < NITEMS; it += NGW) {
        int r = it;
        if (r < I_QKV) { conv_item<0>(ap->in[7], D, NQKV, NQKV, ap->in[3], WSP(bf16, WS_WQKV), scr, r, F.lane); continue; } r -= I_QKV;
        if (r < I_DD)  { conv_item<0>(ap->in[8], D, D, D, nullptr, WSP(bf16, WS_WO0), scr, r, F.lane); continue; } r -= I_DD;
        if (r < I_FI)  { conv_item<2>(ap->in[17], D, NFFI, NFFI, ap->in[4], WSP(bf16, WS_WFI0), scr, r, F.lane); continue; } r -= I_FI;
        if (r < I_FO)  { conv_item<0>(ap->in[18], FF, D, D, nullptr, WSP(bf16, WS_WFO0), scr, r, F.lane); continue; } r -= I_FO;
        if (r < I_DD)  { conv_item<0>(ap->in[20], D, D, D, ap->in[5], WSP(bf16, WS_WG0), scr, r, F.lane); continue; } r -= I_DD;
        if (r < I_P)   { conv_item<0>(ap->in[19], PLE, D, D, nullptr, WSP(bf16, WS_WP0), scr, r, F.lane); continue; } r -= I_P;
        if (r < I_NSA) { conv_item<1>(ap->in[9], D, NNSA_SRC, NNSA, ap->in[3] + D, WSP(bf16, WS_WNSA), scr, r, F.lane); continue; } r -= I_NSA;
        if (r < I_DD)  { conv_item<0>(ap->in[10], D, D, D, nullptr, WSP(bf16, WS_WO1), scr, r, F.lane); continue; } r -= I_DD;
        if (r < I_FI)  { conv_item<2>(ap->in[17] + (size_t)D * NFFI, D, NFFI, NFFI, ap->in[4] + D, WSP(bf16, WS_WFI1), scr, r, F.lane); continue; } r -= I_FI;
        if (r < I_FO)  { conv_item<0>(ap->in[18] + (size_t)FF * D, FF, D, D, nullptr, WSP(bf16, WS_WFO1), scr, r, F.lane); continue; } r -= I_FO;
        if (r < I_DD)  { conv_item<0>(ap->in[20] + (size_t)D * D, D, D, D, ap->in[5] + D, WSP(bf16, WS_WG1), scr, r, F.lane); continue; } r -= I_DD;
        if (r < I_P)   { conv_item<0>(ap->in[19] + (size_t)PLE * D, PLE, D, D, nullptr, WSP(bf16, WS_WP1), scr, r, F.lane); continue; } r -= I_P;
        if (r < I_C)   { conv_item<0>(ap->in[13], CMPK, CMPH, CMPH, nullptr, WSP(bf16, WS_WCK), scr, r, F.lane); continue; } r -= I_C;
        conv_item<0>(ap->in[15], CMPK, CMPH, CMPH, nullptr, WSP(bf16, WS_WCV), scr, r, F.lane);
    }
    {
        bf16* hb = WSP(bf16, WS_HB); float* ssq = WSP(float, WS_SSQ0);
        for (int m = gw; m < M; m += NGW) {
            const GAS f32x4* xr = (const GAS f32x4*)(ap->in[0] + (size_t)m * D) + F.lane; f32x4 v[4]; float s = 0.f;
#pragma unroll
            for (int j = 0; j < 4; ++j) { v[j] = xr[64 * j]; s += (v[j].x * v[j].x + v[j].y * v[j].y) + (v[j].z * v[j].z + v[j].w * v[j].w); }
            s = wave_sum(s);
            GAS unsigned long long* o8 = (GAS unsigned long long*)(hb + (size_t)m * D) + F.lane;
#pragma unroll
            for (int j = 0; j < 4; ++j) o8[64 * j] = (unsigned long long)pk2(v[j].x, v[j].y) | ((unsigned long long)pk2(v[j].z, v[j].w) << 32);
            if (F.lane < 16) ssq[(size_t)m * 16 + F.lane] = F.lane == 0 ? s : 0.f;
        }
    }
    {
        const GAS f32x4* p4 = (const GAS f32x4*)ap->in[1]; GAS unsigned long long* o8 = (GAS unsigned long long*)WSP(bf16, WS_PB);
        const int NI = 2 * M * PLE / 4; const int gt = F.vcu * (NWAVES * 64) + F.tid, NTH = F.G * NWAVES * 64;
        for (int i = gt; i < NI; i += NTH) { const f32x4 v = p4[i]; o8[i] = (unsigned long long)pk2(v.x, v.y) | ((unsigned long long)pk2(v.z, v.w) << 32); }
    }
    {
        float* b1p = WSP(float, WS_MISC);
        for (int it = gw; it < 64; it += NGW) { const int which = it >> 5, c = (it >> 2) & 7, jb = it & 3, j = jb * 64 + F.lane;
            const float* pe = which ? ap->in[12] : ap->in[11]; const float* w1 = which ? ap->in[15] : ap->in[13]; float a = 0.f;
            for (int kk = c * 256; kk < c * 256 + 256; ++kk) a += pe[kk] * w1[(size_t)kk * CMPH + j];
            b1p[(which * 8 + c) * 256 + j] = a; }
    }
}

__device__ __forceinline__ int t5_bucket(int n) {
    if (n < 16) return n < 0 ? 0 : n;
    if (n >= 113) return 31;
    return 16 + (n >= 19) + (n >= 21) + (n >= 24) + (n >= 27) + (n >= 31) + (n >= 35) + (n >= 40) + (n >= 46) + (n >= 52) + (n >= 59) + (n >= 67) + (n >= 77) + (n >= 87) + (n >= 99);
}
__device__ __forceinline__ void load_q64(float (&q)[64], const bf16* p) {
    const uint4* p4 = (const uint4*)p;
#pragma unroll
    for (int i = 0; i < 8; ++i) { const uint4 w = p4[i]; q[8 * i + 0] = bflo(w.x); q[8 * i + 1] = bfhi(w.x); q[8 * i + 2] = bflo(w.y); q[8 * i + 3] = bfhi(w.y);
        q[8 * i + 4] = bflo(w.z); q[8 * i + 5] = bfhi(w.z); q[8 * i + 6] = bflo(w.w); q[8 * i + 7] = bfhi(w.w); }
}
__device__ __forceinline__ float dot64(const float (&q)[64], const bf16* p) {
    const uint4* p4 = (const uint4*)p; float a = 0.f;
#pragma unroll
    for (int i = 0; i < 8; ++i) { const uint4 w = p4[i];
        a += q[8 * i + 0] * bflo(w.x); a += q[8 * i + 1] * bfhi(w.x); a += q[8 * i + 2] * bflo(w.y); a += q[8 * i + 3] * bfhi(w.y);
        a += q[8 * i + 4] * bflo(w.z); a += q[8 * i + 5] * bfhi(w.z); a += q[8 * i + 6] * bflo(w.w); a += q[8 * i + 7] * bfhi(w.w); }
    return a;
}
__device__ __forceinline__ void sb_simple(Frame& F) {
    const Args* ap = kargs();
    bf16* QO = WSP(bf16, WS_QO); const bf16* Kh = WSP(bf16, WS_K0); const bf16* Vh = WSP(bf16, WS_V0);
    const int gt = F.vcu * (NWAVES * 64) + F.tid, NTH = F.G * NWAVES * 64;
    for (int it = gt; it < BATCH * H * T; it += NTH) {
        const int t = it & (T - 1), h = (it >> 13) & 15, b = it >> 17;
        bf16* qp = QO + ((size_t)(b * T + t)) * D + h * HD;
        float q[64]; load_q64(q, qp);
        float o[64];
#pragma unroll
        for (int d = 0; d < 64; ++d) o[d] = 0.f;
        const bf16* kp = Kh + ((size_t)(b * H + h) * T) * HD; const bf16* vp = Vh + ((size_t)(b * H + h) * T) * HD;
        float carry = 0.f;
        for (int s = t - 1; s >= 0; --s) {
            const float z = dot64(q, kp + (size_t)s * HD);
            const float sp = fmaxf(z, 0.f) + log1pf(expf(-fabsf(z)));
            const float a = expf((z - sp) + carry);
            const uint4* v4 = (const uint4*)(vp + (size_t)s * HD);
#pragma unroll
            for (int i = 0; i < 8; ++i) { const uint4 w = v4[i];
                o[8 * i + 0] += a * bflo(w.x); o[8 * i + 1] += a * bfhi(w.x); o[8 * i + 2] += a * bflo(w.y); o[8 * i + 3] += a * bfhi(w.y);
                o[8 * i + 4] += a * bflo(w.z); o[8 * i + 5] += a * bfhi(w.z); o[8 * i + 6] += a * bflo(w.w); o[8 * i + 7] += a * bfhi(w.w); }
            carry -= sp;
            if (carry < -104.f) break;
        }
        uint4* o4 = (uint4*)qp;
#pragma unroll
        for (int i = 0; i < 8; ++i) { uint4 w; w.x = pk2(o[8 * i + 0], o[8 * i + 1]); w.y = pk2(o[8 * i + 2], o[8 * i + 3]); w.z = pk2(o[8 * i + 4], o[8 * i + 5]); w.w = pk2(o[8 * i + 6], o[8 * i + 7]); o4[i] = w; }
    }
}
__device__ __forceinline__ float gelu_tanh(float x) { const float u = 0.7978845608028654f * (x + 0.044715f * x * x * x); return 0.5f * x * (1.0f + tanhf(u)); }
__device__ __forceinline__ void cmp_stage2(Frame& F) {
    const Args* ap = kargs();
    LAS float* hbuf = (LAS float*)(F.lds + RING_OFF + F.wave * 16384);
    const int gw = F.vcu * NWAVES + F.wave, NGW = F.G * NWAVES;
    const float* slab = WSP(float, WS_SLAB); const float* b1p = WSP(float, WS_MISC); bf16* kcvc = WSP(bf16, WS_KCVC);
    for (int it = gw; it < 2 * 4096; it += NGW) {
        const int which = it >> 12, r = it & 4095, tile = r >> 8, rr = r & 255, i = r & 511;
        const float* w2 = which ? ap->in[16] : ap->in[14];
#pragma unroll
        for (int q = 0; q < 4; ++q) { const int j = F.lane + 64 * q; float pre = 0.f;
#pragma unroll
            for (int ks = 0; ks < 4; ++ks) pre += slab[((size_t)((ks * 2 + which) * 16 + tile) * 256 + rr) * 256 + j];
#pragma unroll
            for (int c = 0; c < 8; ++c) pre += b1p[(which * 8 + c) * 256 + j];
            hbuf[j] = gelu_tanh(pre); }
        LDS_WAIT(); asm volatile("" ::: "memory");
        float a = 0.f;
        for (int j = 0; j < 256; ++j) a += hbuf[j] * w2[j * 64 + F.lane];
        if (i >= NCMP) a = 0.f;
        kcvc[((size_t)which * 4096 + r) * 64 + F.lane] = (bf16)f2bf(a);
        LDS_WAIT(); asm volatile("" ::: "memory");
    }
}
__device__ __forceinline__ void nsa_simple(Frame& F) {
    const Args* ap = kargs();
    LAS float* pbuf = (LAS float*)(F.lds + RING_OFF + F.wave * 16384);
    LAS float* pg = pbuf + 1024;
    LAS float* obuf = pbuf + 1536;
    LAS int* selb = (LAS int*)(pbuf + 2304);
    const int gw = F.vcu * NWAVES + F.wave, NGW = F.G * NWAVES, lane = F.lane;
    bf16* NQ = WSP(bf16, WS_QO); const bf16* KV = WSP(bf16, WS_KV1); const bf16* KCVC = WSP(bf16, WS_KCVC);
    const float* gates = WSP(float, WS_GATES); const float* rel_bias = ap->in[2];
    for (int it = gw; it < BATCH * HKV * T; it += NGW) {
        const int t = it & (T - 1), hkv = (it >> 13) & 3, b = it >> 15, bh = b * 4 + hkv, cur = t >> 6;
        const bf16* kc = KCVC + (size_t)bh * 512 * 64; const bf16* vc = KCVC + (size_t)4096 * 64 + (size_t)bh * 512 * 64;
        const bf16* ksel = KV + 2 * KVSZ + (size_t)bh * T * HD; const bf16* vsel = KV + 3 * KVSZ + (size_t)bh * T * HD;
        const bf16* kwin = KV + 4 * KVSZ + (size_t)bh * T * HD; const bf16* vwin = KV + 5 * KVSZ + (size_t)bh * T * HD;
        bf16* qrow = NQ + (size_t)(b * T + t) * D + hkv * 256;
        const int nv = t >= 31 ? ((t - 31) >> 4) + 1 : 0;
#pragma unroll 1
        for (int i = 0; i < 8; ++i) pg[lane + 64 * i] = 0.f;
#pragma unroll 1
        for (int g = 0; g < 4; ++g) {
            const int hq = hkv * 4 + g; float qv[64]; load_q64(qv, qrow + g * 64);
            float mx = -INFINITY;
#pragma unroll 1
            for (int i = 0; i < 8; ++i) { const int n = lane + 64 * i;
                const float sc = n < nv ? dot64(qv, kc + (size_t)n * 64) + rel_bias[t5_bucket(t - 16 * n - 31) * 16 + hq] : -INFINITY; pbuf[n] = sc; mx = fmaxf(mx, sc); }
            mx = wave_max(mx); const float mm = mx == -INFINITY ? 0.f : mx; float sum = 0.f;
#pragma unroll 1
            for (int i = 0; i < 8; ++i) { const int n = lane + 64 * i; const float e = n < nv ? expf(pbuf[n] - mm) : 0.f; pbuf[n] = e; sum += e; }
            sum = wave_sum(sum); const float inv = 1.0f / (sum > 0.f ? sum : 1.0f);
#pragma unroll 1
            for (int i = 0; i < 8; ++i) { const int n = lane + 64 * i; const float p = pbuf[n] * inv; pbuf[n] = p; pg[n] += p; }
            LDS_WAIT(); asm volatile("" ::: "memory");
            float a = 0.f;
            for (int n = 0; n < nv; ++n) a += pbuf[n] * bf2f(vc[(size_t)n * 64 + lane]);
            obuf[g * 64 + lane] = a;
            LDS_WAIT(); asm volatile("" ::: "memory");
        }
        unsigned long long key[2];
#pragma unroll
        for (int q = 0; q < 2; ++q) { const int j = lane + 64 * q; float imp = 0.f;
#pragma unroll
            for (int dn = -1; dn <= 3; ++dn) { const int n = 4 * j + dn; if (n >= 0 && n < 512) imp += pg[n]; }
            const bool forced = (j == 0) || (j == cur) || (j == cur - 1); const float val = forced ? 100.0f : imp;
            key[q] = j <= cur ? (((unsigned long long)__float_as_uint(val) << 32) | (unsigned)(128 - j)) : 0ull; }
#pragma unroll 1
        for (int r = 0; r < 16; ++r) { unsigned long long k = key[0] > key[1] ? key[0] : key[1]; k = wave_max_u64(k);
            const int sj = k ? 128 - (int)(unsigned)(k & 0xffffffffull) : -1; if (lane == 0) selb[r] = sj;
            if (k) { if (key[0] == k) key[0] = 0ull; if (key[1] == k) key[1] = 0ull; } }
        LDS_WAIT(); asm volatile("" ::: "memory");
#pragma unroll 1
        for (int g = 0; g < 4; ++g) {
            const int hq = hkv * 4 + g; float qv[64]; load_q64(qv, qrow + g * 64);
            float mx = -INFINITY;
#pragma unroll 1
            for (int r = 0; r < 16; ++r) { const int sj = selb[r]; const int pos = sj * 64 + lane, dist = t - pos;
                const float sc = (sj >= 0 && dist >= 0) ? dot64(qv, ksel + (size_t)pos * 64) + rel_bias[t5_bucket(dist) * 16 + hq] : -INFINITY; pbuf[r * 64 + lane] = sc; mx = fmaxf(mx, sc); }
            mx = wave_max(mx); float sum = 0.f;
#pragma unroll 1
            for (int r = 0; r < 16; ++r) { const float sc = pbuf[r * 64 + lane]; const float e = sc == -INFINITY ? 0.f : expf(sc - mx); pbuf[r * 64 + lane] = e; sum += e; }
            sum = wave_sum(sum); const float inv = 1.0f / sum;
            LDS_WAIT(); asm volatile("" ::: "memory");
            float a = 0.f;
#pragma unroll 1
            for (int r = 0; r < 16; ++r) { const int sj = selb[r]; if (sj < 0) continue; const bf16* vb = vsel + (size_t)sj * 64 * 64 + lane;
                for (int kk = 0; kk < 64; ++kk) a += pbuf[r * 64 + kk] * bf2f(vb[kk * 64]); }
            obuf[256 + g * 64 + lane] = a * inv;
            LDS_WAIT(); asm volatile("" ::: "memory");
            mx = -INFINITY;
#pragma unroll 1
            for (int i = 0; i < 8; ++i) { const int kk = lane + 64 * i, pos = t - 511 + kk;
                const float sc = pos >= 0 ? dot64(qv, kwin + (size_t)pos * 64) + rel_bias[t5_bucket(511 - kk) * 16 + hq] : -INFINITY; pbuf[kk] = sc; mx = fmaxf(mx, sc); }
            mx = wave_max(mx); sum = 0.f;
#pragma unroll 1
            for (int i = 0; i < 8; ++i) { const int kk = lane + 64 * i; const float sc = pbuf[kk]; const float e = sc == -INFINITY ? 0.f : expf(sc - mx); pbuf[kk] = e; sum += e; }
            sum = wave_sum(sum); const float inv2 = 1.0f / sum;
            LDS_WAIT(); asm volatile("" ::: "memory");
            a = 0.f;
            for (int kk = (t >= 511 ? 0 : 511 - t); kk < 512; ++kk) a += pbuf[kk] * bf2f(vwin[(size_t)(t - 511 + kk) * 64 + lane]);
            obuf[512 + g * 64 + lane] = a * inv2;
            LDS_WAIT(); asm volatile("" ::: "memory");
        }
        const float* gr = gates + (size_t)(b * T + t) * 64 + hkv * 4;
#pragma unroll
        for (int g = 0; g < 4; ++g) { const float v = gr[g] * obuf[g * 64 + lane] + gr[16 + g] * obuf[256 + g * 64 + lane] + gr[32 + g] * obuf[512 + g * 64 + lane]; qrow[g * 64 + lane] = (bf16)f2bf(v); }
        LDS_WAIT(); asm volatile("" ::: "memory");
    }
}

#define PHASE_BEGIN() const Args* ap = kargs(); (void)ap
template <int PH> __device__ __forceinline__ void run_phase(LAS unsigned char* lds_base) {
    Frame F; F.lds = lds_base;
    int bx = blockIdx.x, G = gridDim.x; asm volatile("" : "+s"(bx), "+s"(G));
    { int t_ = threadIdx.x; asm volatile("" : "+v"(t_)); F.tid = t_; F.lane = t_ & 63; F.wave = __builtin_amdgcn_readfirstlane(t_ >> 6); F.G = G; F.vcu = (G % 8 == 0) ? (bx % 8) * (G / 8) + bx / 8 : bx; }
    constexpr int ph = PH; constexpr int layer = PH >= 7 ? 1 : 0;
        switch (ph) {
        case 0:
#ifndef SKIP_P0
            p0_prologue(F);
#endif
            break;
        case 1: {
            PHASE_BEGIN();
            pg8::Gemm g{WSP(bf16, WS_HB), WSP(bf16, WS_WQKV)}; pg8::StaticOrder S; S.init(M, NQKV, G, bx);
            pg8::EpiQKV E{WSP(float, WS_SSQ0), WSP(bf16, WS_QO), WSP(bf16, WS_K0), WSP(bf16, WS_V0)};
            pg8::gemm_phase<pg8::EpiQKV, pg8::StaticOrder, D, D, D, PG8_ALIGN, PG8_SP2>(F.lds + RING_OFF, g, S, E);
        } break;
        case 2:
#ifndef SKIP_SB
            sb_simple(F);
#endif
            break;
        case 3: case 11: {
            PHASE_BEGIN();
            pg8::Gemm g{WSP(bf16, WS_QO), layer ? WSP(bf16, WS_WO1) : WSP(bf16, WS_WO0)}; pg8::StaticOrder S; S.init(M, D, G, bx);
            pg8::EpiRes E{layer ? ap->out : ap->in[0], ap->out, WSP(bf16, WS_HB), layer ? WSP(float, WS_SSQ0) : WSP(float, WS_SSQ1)};
            pg8::gemm_phase<pg8::EpiRes, pg8::StaticOrder, D, D, D, PG8_ALIGN, PG8_SP2>(F.lds + RING_OFF, g, S, E);
        } break;
        case 4: case 12: {
            PHASE_BEGIN();
            pg8::Gemm g{WSP(bf16, WS_HB), layer ? WSP(bf16, WS_WFI1) : WSP(bf16, WS_WFI0)}; pg8::StaticOrder S; S.init(M, NFFI, G, bx);
            pg8::EpiSwiglu E{layer ? WSP(float, WS_SSQ0) : WSP(float, WS_SSQ1), WSP(bf16, WS_ACT)};
            pg8::gemm_phase<pg8::EpiSwiglu, pg8::StaticOrder, D, D, D, PG8_ALIGN, PG8_SP2>(F.lds + RING_OFF, g, S, E);
        } break;
        case 5: case 13: {
            {
                PHASE_BEGIN();
                pg8::Gemm g{WSP(bf16, WS_ACT), layer ? WSP(bf16, WS_WFO1) : WSP(bf16, WS_WFO0)}; pg8::StaticOrder S; S.init(M, D, G, bx);
                pg8::EpiRes E{ap->out, ap->out, WSP(bf16, WS_HB), layer ? WSP(float, WS_SSQ1) : WSP(float, WS_SSQ0)};
                pg8::gemm_phase<pg8::EpiRes, pg8::StaticOrder, FF, FF, FF, PG8_ALIGN, PG8_SP2>(F.lds + RING_OFF, g, S, E);
            }
            {
                PHASE_BEGIN();
                pg8::Gemm g{WSP(bf16, WS_PB) + (size_t)layer * M * PLE, layer ? WSP(bf16, WS_WP1) : WSP(bf16, WS_WP0)}; pg8::StaticOrder S; S.init(M, D, G, bx);
                pg8::EpiBf16Plain E{WSP(bf16, WS_PP), D};
                pg8::gemm_phase<pg8::EpiBf16Plain, pg8::StaticOrder, PLE, PLE, PLE, PG8_ALIGN, PG8_SP2>(F.lds + RING_OFF, g, S, E);
            }
        } break;
        case 6: case 14: {
            PHASE_BEGIN();
            pg8::Gemm g{WSP(bf16, WS_HB), layer ? WSP(bf16, WS_WG1) : WSP(bf16, WS_WG0)}; pg8::StaticOrder S; S.init(M, D, G, bx);
            pg8::EpiGate E{layer ? WSP(float, WS_SSQ1) : WSP(float, WS_SSQ0), ap->out, ap->out, WSP(bf16, WS_PP), layer ? WSP(float, WS_SSQ0) : WSP(float, WS_SSQ1)};
            pg8::gemm_phase<pg8::EpiGate, pg8::StaticOrder, D, D, D, PG8_ALIGN, PG8_SP2>(F.lds + RING_OFF, g, S, E);
        } break;
        case 7: {
            PHASE_BEGIN();
            pg8::Gemm g{WSP(bf16, WS_PP), WSP(bf16, WS_WNSA)}; pg8::StaticOrder S; S.init(M, NNSA, G, bx);
            pg8::EpiNSA E{WSP(float, WS_SSQ1), WSP(bf16, WS_QO), WSP(bf16, WS_KV1), KVSZ, WSP(float, WS_GATES)};
            pg8::gemm_phase<pg8::EpiNSA, pg8::StaticOrder, D, D, D, PG8_ALIGN, PG8_SP2>(F.lds + RING_OFF, g, S, E);
        } break;
        case 8: {
            PHASE_BEGIN();
            const int uix = F.vcu; const bool has = uix < 128; const int which = (uix >> 6) & 1, tile = (uix >> 2) & 15, ks = uix & 3;
            const bf16* Ab = WSP(bf16, WS_KV1) + (size_t)which * KVSZ + (size_t)(tile >> 1) * T * HD + (size_t)(tile & 1) * 256 * 1024 + ks * 512;
            const bf16* Bb = (which ? WSP(bf16, WS_WCV) : WSP(bf16, WS_WCK)) + ks * 512;
            pg8::Gemm g{Ab, Bb}; pg8::OneUnit S{has};
            pg8::EpiSlab E{WSP(float, WS_SLAB) + (size_t)((ks * 2 + which) * 16 + tile) * 65536};
            pg8::gemm_phase<pg8::EpiSlab, pg8::OneUnit, 1024, CMPK, 512, false, PG8_SP2>(F.lds + RING_OFF, g, S, E);
        } break;
        case 9:
#ifndef SKIP_C2
            cmp_stage2(F);
#endif
            break;
        case 10:
#ifndef SKIP_NSA
            nsa_simple(F);
#endif
            break;
        default: {
            PHASE_BEGIN();
            const int gw = F.vcu * NWAVES + F.wave, NGW = F.G * NWAVES; const float* gf = ap->in[6]; const float* SSQ = WSP(float, WS_SSQ0);
            f32x4 gv[4];
#pragma unroll
            for (int j = 0; j < 4; ++j) gv[j] = ((const f32x4*)gf)[F.lane + 64 * j];
            for (int m = gw; m < M; m += NGW) {
                float s = F.lane < 16 ? SSQ[(size_t)m * 16 + F.lane] : 0.f; s = wave_sum(s);
                const float r = rsqrtf(s * (1.0f / 1024.0f) + RMS_EPS);
                GAS f32x4* xr = (GAS f32x4*)(ap->out + (size_t)m * D) + F.lane;
#pragma unroll
                for (int j = 0; j < 4; ++j) { f32x4 v = xr[64 * j]; v = v * r * gv[j]; xr[64 * j] = v; }
            }
        } break;
        }
}
__global__ void __launch_bounds__(NWAVES * 64, 2) fwd_kernel(Args args) {
    extern __shared__ __attribute__((aligned(16))) unsigned char lds[];
    LAS unsigned char* L = (LAS unsigned char*)lds;
    { const int tid = threadIdx.x; for (int u = tid; u < (LDS_BYTES - LDSCTL_OFF) / 4; u += NWAVES * 64) ((LAS unsigned*)(L + LDSCTL_OFF))[u] = 0u; }
    __syncthreads();
    XcdBarrier bar = xcd_barrier_post((unsigned*)((gu32*)(args.ws + WS_CTL) + CW_BAR), (volatile LAS unsigned*)(L + MISC_OFF) + 8);
#define BAR_() do { XcdBarrier b2 = bar; asm volatile("" : "+s"(b2.bar), "+s"(b2.x)); xcd_barrier(b2); } while (0)
#define STEP(P) run_phase<P>(L); BAR_()
    STEP(0); STEP(1); STEP(2); STEP(3); STEP(4); STEP(5); STEP(6); STEP(7); STEP(8); STEP(9); STEP(10); STEP(11); STEP(12); STEP(13); STEP(14);
    run_phase<15>(L);
}

extern "C" void kernel_launch(void* const* d_in, const int* in_sizes, int n_in, void* d_out, int out_size, void* d_ws, size_t ws_size, hipStream_t stream) {
    static int grid = 0;
    if (grid == 0) {
        if (n_in != 21 || in_sizes[0] != M * D || out_size != M * D || ws_size < WS_END) { fprintf(stderr, "kernel_launch: unexpected shapes (n_in %d, in0 %d, out %d, ws %zu)\n", n_in, n_in > 0 ? in_sizes[0] : -1, out_size, ws_size); grid = -1; return; }
        int dev = 0, cus = 0, per_cu = 0;
        if (hipGetDevice(&dev) != hipSuccess || hipDeviceGetAttribute(&cus, hipDeviceAttributeMultiprocessorCount, dev) != hipSuccess) { grid = -1; return; }
        if (hipFuncSetAttribute((const void*)fwd_kernel, hipFuncAttributeMaxDynamicSharedMemorySize, LDS_BYTES) != hipSuccess) { fprintf(stderr, "kernel_launch: hipFuncSetAttribute failed\n"); grid = -1; return; }
        if (hipOccupancyMaxActiveBlocksPerMultiprocessor(&per_cu, (const void*)fwd_kernel, NWAVES * 64, LDS_BYTES) != hipSuccess || per_cu < 1) { fprintf(stderr, "kernel_launch: occupancy query reports %d blocks per CU\n", per_cu); per_cu = 1; }
        (void)hipGetLastError();
        grid = cus;
    }
    if (grid < 0) return;
    if (hipMemsetAsync((char*)d_ws + WS_CTL, 0, CTL_ZERO_BYTES, stream) != hipSuccess) { fprintf(stderr, "kernel_launch: memset failed\n"); return; }
    Args a{};
    for (int i = 0; i < 21; ++i) a.in[i] = (const float*)d_in[i];
    a.out = (float*)d_out; a.ws = (unsigned char*)d_ws;
    hipLaunchKernelGGL(fwd_kernel, dim3(grid), dim3(NWAVES * 64), LDS_BYTES, stream, a);
    const hipError_t le = hipPeekAtLastError();
    if (le != hipSuccess) fprintf(stderr, "kernel_launch: launch failed: %s\n", hipGetErrorName(le));
}
```

```cpp
#include <hip/hip_runtime.h>
#include <hip/hip_bf16.h>
#include <cstdio>
#include <cstdint>
#include <cmath>
namespace pg8 {
#define PG8_LAS __attribute__((address_space(3)))
typedef unsigned short bf16_t;
typedef short bf16x8 __attribute__((ext_vector_type(8)));
typedef float f32x4 __attribute__((ext_vector_type(4)));
typedef float f32x2 __attribute__((ext_vector_type(2)));
typedef unsigned u32x4 __attribute__((ext_vector_type(4)));
typedef unsigned u32x2 __attribute__((ext_vector_type(2)));
constexpr int BM = 256, BK = 64, HALF = 128, HTB = HALF * BK * 2  , STAGE_BYTES = 8 * HTB, NXCD = 8, WGM = 4;

__host__ __device__ __forceinline__ int lds_byte(int r, int c) { const int st = (r >> 4) * 2 + (c >> 5), rr = r & 15, cc = c & 31, ob = rr * 64 + cc * 2; return st * 1024 + (ob ^ (((ob >> 9) & 1) << 5)); }
__host__ __device__ __forceinline__ void stage_rc(int b, int& R, int& C) { const int st = b / 1024, sb = b % 1024, swz = sb ^ (((sb >> 9) & 1) << 5); R = (st >> 1) * 16 + swz / 64; C = (st & 1) * 32 + (swz % 64) / 2; }
__host__ __device__ __forceinline__ int perm32(int rho) { const int n = rho >> 4, i = rho & 15; return 8 * (i >> 2) + 4 * n + (i & 3); }

struct Unit { int pm, pn; };
struct Gemm { const bf16_t* A; const bf16_t* Bt; };

struct StaticOrder {
    int nM, nN, nwg, G, c;
    __host__ __device__ void init(int M, int N, int G_, int c_) { nM = M / BM; nN = N / BM; nwg = nM * nN; G = G_; c = c_; }
    __host__ __device__ bool next(int i, Unit& u) const {
        const long L = (long)i * G + c; if (L >= nwg) return false;
        int wgid = (int)L; { const int q = nwg / NXCD, r = nwg % NXCD, xcd = wgid % NXCD, off = wgid / NXCD; wgid = (xcd < r ? xcd * (q + 1) : r * (q + 1) + (xcd - r) * q) + off; }
        const int nig = WGM * nN, gid = wgid / nig, fm = gid * WGM, gsz = (nM - fm) < WGM ? (nM - fm) : WGM;
        u.pm = fm + ((wgid % nig) % gsz); u.pn = (wgid % nig) / gsz; return true;
    }
    __device__ __forceinline__ void a_ready(const Unit&) const {}
    __device__ __forceinline__ void done(const Unit&) const {}
};
struct UpperHalfOrder {
    int c, G;
    __device__ __forceinline__ bool next(int i, Unit& u) const { if (G != 256) { const int L = i * G + c; if (L >= 256) return false; u.pm = L >> 2; u.pn = L & 3; return true; }
        if (c < 128 || i >= 2) return false; const int L = (c - 128) + 128 * i; u.pm = L >> 2; u.pn = L & 3; return true; }
    __device__ __forceinline__ void a_ready(const Unit&) const {}
    __device__ __forceinline__ void done(const Unit&) const {}
};
struct OneUnit {
    bool has;
    __device__ __forceinline__ bool next(int i, Unit& u) const { if (i > 0 || !has) return false; u.pm = 0; u.pn = 0; return true; }
    __device__ __forceinline__ void a_ready(const Unit&) const {}
    __device__ __forceinline__ void done(const Unit&) const {}
};

__device__ __forceinline__ unsigned cvt_pk_bf16(float lo, float hi) { unsigned r; asm volatile("v_cvt_pk_bf16_f32 %0, %1, %2" : "=v"(r) : "v"(lo), "v"(hi)); return r; }
__device__ __forceinline__ float sigmoidf_(float x) { return __builtin_amdgcn_rcpf(1.0f + __builtin_amdgcn_exp2f(-1.4426950408889634f * x)); }

constexpr int SEQ_ = 8192;
constexpr int RTAB_OFF = 131072, RTAB_UNITS = 8;
template <class Sched> __device__ __forceinline__ void fill_rstd(PG8_LAS unsigned char* lds, const float* ssq, const Sched& S) {
    int t_ = threadIdx.x; asm volatile("" : "+v"(t_));
    PG8_LAS float* rtab = (PG8_LAS float*)(lds + RTAB_OFF); const int row = t_ & 255, half = t_ >> 8;
    Unit u;
#pragma unroll 1
    for (int ui = half; ui < RTAB_UNITS && S.next(ui, u); ui += 2) {
        const f32x4* p = (const f32x4*)(ssq + (size_t)(u.pm * BM + row) * 16);
        const f32x4 a = p[0], b = p[1], c = p[2], d = p[3];
        const float s = (((a[0] + a[1]) + (a[2] + a[3])) + ((b[0] + b[1]) + (b[2] + b[3]))) + (((c[0] + c[1]) + (c[2] + c[3])) + ((d[0] + d[1]) + (d[2] + d[3])));
        rtab[ui * 256 + row] = rsqrtf(s * (1.0f / 1024.0f) + 1e-6f);
    }
    asm volatile("s_waitcnt lgkmcnt(0)" ::: "memory"); __builtin_amdgcn_s_barrier(); asm volatile("" ::: "memory");
}
__device__ __forceinline__ void load_rstd(const PG8_LAS unsigned char* lds, int ui, int wr, int fr, float (&rs)[2][4]) {
    const PG8_LAS float* rtab = (const PG8_LAS float*)(lds + RTAB_OFF) + ui * 256;
#pragma unroll
    for (int ai = 0; ai < 2; ++ai)
#pragma unroll
        for (int m = 0; m < 4; ++m) rs[ai][m] = rtab[ai * HALF + wr * 64 + m * 16 + fr];
}
struct EpiQKV {
    static constexpr bool PERM = true, AFTER_DRAIN = false;
    const PG8_LAS unsigned char* lds; bf16_t* Q; bf16_t* Kh; bf16_t* Vh;
    __device__ __forceinline__ void operator()(const f32x4 (&acc)[2][2][4][2], const Unit& u, int ui, int wr, int wc, int fr_, int fq_) const {
        int fr = fr_, fq = fq_; asm volatile("" : "+v"(fr), "+v"(fq));
        float rs[2][4]; load_rstd(lds, ui, wr, fr, rs);
        const int t3 = u.pn >> 2; const int ct = (u.pn & 3) * 256 + wc * 32 + 8 * fq; const float sc = t3 == 0 ? 0.125f : 1.0f;
        char* const dbase = (char*)Q + (size_t)(t3 >= 1 ? 1 : 0) * (size_t)((const char*)Kh - (const char*)Q) + (size_t)(t3 >= 2 ? 1 : 0) * (size_t)((const char*)Vh - (const char*)Kh);
        const int row0 = u.pm * BM + wr * 64 + fr;
        unsigned off0, st_ai, st_m, st_bj;
        if (t3 == 0) { off0 = (unsigned)(row0 * 2048 + ct * 2); st_ai = HALF * 2048; st_m = 16 * 2048; st_bj = HALF * 2; }
        else { const int b = row0 >> 13, s = row0 & (SEQ_ - 1); off0 = (unsigned)(((b * 16 + (ct >> 6)) * SEQ_ + s) * 128 + (ct & 63) * 2); st_ai = HALF * 128; st_m = 16 * 128; st_bj = 2 * SEQ_ * 128; }
#pragma unroll
        for (int ai = 0; ai < 2; ++ai)
#pragma unroll
            for (int m = 0; m < 4; ++m) { const float r = rs[ai][m] * sc;
#pragma unroll
                for (int bj = 0; bj < 2; ++bj) { const f32x4 v0 = acc[ai][bj][m][0] * r, v1 = acc[ai][bj][m][1] * r;
                    u32x4 w; w.x = cvt_pk_bf16(v0[0], v0[1]); w.y = cvt_pk_bf16(v0[2], v0[3]); w.z = cvt_pk_bf16(v1[0], v1[1]); w.w = cvt_pk_bf16(v1[2], v1[3]);
                    const unsigned off = off0 + ai * st_ai + m * st_m + bj * st_bj;
                    *(u32x4*)(dbase + (size_t)off) = w; } }
    }
};
struct EpiNSA {
    static constexpr bool PERM = true, AFTER_DRAIN = false;
    const PG8_LAS unsigned char* lds; bf16_t* Q; bf16_t* KV; size_t kvsz; float* gates;
    __device__ __forceinline__ void operator()(const f32x4 (&acc)[2][2][4][2], const Unit& u, int ui, int wr, int wc, int fr_, int fq_) const {
        int fr = fr_, fq = fq_; asm volatile("" : "+v"(fr), "+v"(fq));
        float rs[2][4]; load_rstd(lds, ui, wr, fr, rs);
        const int pn = u.pn; const int cw = wc * 32 + 8 * fq;
        const int row0 = u.pm * BM + wr * 64 + fr;
        if (pn < 10) {
            char* const dbase = pn < 4 ? (char*)Q : (char*)KV + (size_t)(pn - 4) * kvsz * 2;
            unsigned off0, st_ai, st_m, st_bj;
            if (pn < 4) { off0 = (unsigned)(row0 * 2048 + (pn * 256 + cw) * 2); st_ai = HALF * 2048; st_m = 16 * 2048; st_bj = HALF * 2; }
            else { const int b = row0 >> 13, s = row0 & (SEQ_ - 1); off0 = (unsigned)(((b * 4 + (cw >> 6)) * SEQ_ + s) * 128 + (cw & 63) * 2); st_ai = HALF * 128; st_m = 16 * 128; st_bj = 2 * SEQ_ * 128; }
            const float sc = pn < 4 ? 0.125f : 1.0f;
#pragma unroll
            for (int ai = 0; ai < 2; ++ai)
#pragma unroll
                for (int m = 0; m < 4; ++m) { const float r = rs[ai][m] * sc;
#pragma unroll
                    for (int bj = 0; bj < 2; ++bj) { const f32x4 v0 = acc[ai][bj][m][0] * r, v1 = acc[ai][bj][m][1] * r;
                        u32x4 w; w.x = cvt_pk_bf16(v0[0], v0[1]); w.y = cvt_pk_bf16(v0[2], v0[3]); w.z = cvt_pk_bf16(v1[0], v1[1]); w.w = cvt_pk_bf16(v1[2], v1[3]);
                        *(u32x4*)(dbase + (size_t)(off0 + ai * st_ai + m * st_m + bj * st_bj)) = w; } }
        } else if (cw < 64) {
            const unsigned off0 = (unsigned)(row0 * 64 + cw) * 4u;
#pragma unroll
            for (int ai = 0; ai < 2; ++ai)
#pragma unroll
                for (int m = 0; m < 4; ++m) { const float r = rs[ai][m]; f32x4 v0 = acc[ai][0][m][0] * r, v1 = acc[ai][0][m][1] * r;
#pragma unroll
                    for (int e = 0; e < 4; ++e) { v0[e] = sigmoidf_(v0[e]); v1[e] = sigmoidf_(v1[e]); }
                    char* const dst = (char*)gates + (size_t)(off0 + ai * (HALF * 256) + m * (16 * 256)); *(f32x4*)dst = v0; *(f32x4*)(dst + 16) = v1; }
        }
    }
};
struct EpiSwiglu {
    static constexpr bool PERM = true, AFTER_DRAIN = false;
    const PG8_LAS unsigned char* lds; bf16_t* act;
    __device__ __forceinline__ void operator()(const f32x4 (&acc)[2][2][4][2], const Unit& u, int ui, int wr, int wc, int fr_, int fq_) const {
        int fr = fr_, fq = fq_; asm volatile("" : "+v"(fr), "+v"(fq));
        float rs[2][4]; load_rstd(lds, ui, wr, fr, rs);
        const int c0 = u.pn * 128 + wc * 32 + 8 * fq; const unsigned off0 = (unsigned)((u.pm * BM + wr * 64 + fr) * 2816 + c0) * 2u;
#pragma unroll
        for (int ai = 0; ai < 2; ++ai)
#pragma unroll
            for (int m = 0; m < 4; ++m) { const float r = rs[ai][m]; u32x4 w; unsigned* wp = (unsigned*)&w;
#pragma unroll
                for (int n = 0; n < 2; ++n) { const f32x4 a = acc[ai][0][m][n] * r, bb = acc[ai][1][m][n] * r; f32x4 o;
#pragma unroll
                    for (int e = 0; e < 4; ++e) o[e] = a[e] * sigmoidf_(a[e]) * bb[e];
                    wp[2 * n] = cvt_pk_bf16(o[0], o[1]); wp[2 * n + 1] = cvt_pk_bf16(o[2], o[3]); }
                *(u32x4*)((char*)act + (size_t)(off0 + ai * (HALF * 5632) + m * (16 * 5632))) = w; }
    }
};
struct EpiBf16Plain {
    static constexpr bool PERM = true, AFTER_DRAIN = false;
    bf16_t* O; int ldc;
    __device__ __forceinline__ void operator()(const f32x4 (&acc)[2][2][4][2], const Unit& u, int ui, int wr, int wc, int fr_, int fq_) const {
        int fr = fr_, fq = fq_; asm volatile("" : "+v"(fr), "+v"(fq));
        const int c0 = u.pn * BM + wc * 32 + 8 * fq; const unsigned off0 = (unsigned)((u.pm * BM + wr * 64 + fr) * ldc + c0) * 2u, st_r = (unsigned)ldc * 32u;
#pragma unroll
        for (int ai = 0; ai < 2; ++ai)
#pragma unroll
            for (int m = 0; m < 4; ++m) {
#pragma unroll
                for (int bj = 0; bj < 2; ++bj) { const f32x4 v0 = acc[ai][bj][m][0], v1 = acc[ai][bj][m][1];
                    u32x4 w; w.x = cvt_pk_bf16(v0[0], v0[1]); w.y = cvt_pk_bf16(v0[2], v0[3]); w.z = cvt_pk_bf16(v1[0], v1[1]); w.w = cvt_pk_bf16(v1[2], v1[3]);
                    *(u32x4*)((char*)O + (size_t)(off0 + (ai * 8 + m) * st_r + bj * (HALF * 2))) = w; } }
    }
};
__device__ __forceinline__ void unpack8(const u32x4& w, f32x4& lo, f32x4& hi) {
    lo[0] = __uint_as_float(w.x << 16); lo[1] = __uint_as_float(w.x & 0xffff0000u); lo[2] = __uint_as_float(w.y << 16); lo[3] = __uint_as_float(w.y & 0xffff0000u);
    hi[0] = __uint_as_float(w.z << 16); hi[1] = __uint_as_float(w.z & 0xffff0000u); hi[2] = __uint_as_float(w.w << 16); hi[3] = __uint_as_float(w.w & 0xffff0000u);
}
template <bool BASEF32> struct EpiRes {
    static constexpr bool PERM = true, AFTER_DRAIN = false;
    const void* base; bf16_t* hb; float* ssq;
    __device__ __forceinline__ void operator()(const f32x4 (&acc)[2][2][4][2], const Unit& u, int ui, int wr, int wc, int fr_, int fq_) const {
        int fr = fr_, fq = fq_; asm volatile("" : "+v"(fr), "+v"(fq));
        const int c0 = u.pn * BM + wc * 32 + 8 * fq; const int row0 = u.pm * BM + wr * 64 + fr; const unsigned eoff0 = (unsigned)(row0 * 1024 + c0);
#pragma unroll
        for (int ai = 0; ai < 2; ++ai) {
            f32x4 bl[4][2][2];
#pragma unroll
            for (int m = 0; m < 4; ++m)
#pragma unroll
                for (int bj = 0; bj < 2; ++bj) { const unsigned o2 = eoff0 + (unsigned)(ai * (HALF * 1024) + m * (16 * 1024) + bj * HALF);
                    if (BASEF32) { const char* bp = (const char*)base + (size_t)(o2 * 4u); bl[m][bj][0] = *(const f32x4*)bp; bl[m][bj][1] = *(const f32x4*)(bp + 16); }
                    else { const u32x4 pw = *(const u32x4*)((const char*)base + (size_t)(o2 * 2u)); bl[m][bj][0] = __builtin_bit_cast(f32x4, pw); } }
#pragma unroll
            for (int m = 0; m < 4; ++m) { const int row = row0 + ai * HALF + m * 16; float s = 0.f;
#pragma unroll
                for (int bj = 0; bj < 2; ++bj) { const unsigned o2 = eoff0 + (unsigned)(ai * (HALF * 1024) + m * (16 * 1024) + bj * HALF); f32x4 v0, v1;
                    if (BASEF32) { v0 = bl[m][bj][0]; v1 = bl[m][bj][1]; }
                    else { unpack8(__builtin_bit_cast(u32x4, bl[m][bj][0]), v0, v1); }
                    v0 = v0 + acc[ai][bj][m][0]; v1 = v1 + acc[ai][bj][m][1];
                    u32x4 w; w.x = cvt_pk_bf16(v0[0], v0[1]); w.y = cvt_pk_bf16(v0[2], v0[3]); w.z = cvt_pk_bf16(v1[0], v1[1]); w.w = cvt_pk_bf16(v1[2], v1[3]); *(u32x4*)((char*)hb + (size_t)(o2 * 2u)) = w;
                    s += ((v0[0] * v0[0] + v0[1] * v0[1]) + (v0[2] * v0[2] + v0[3] * v0[3])) + ((v1[0] * v1[0] + v1[1] * v1[1]) + (v1[2] * v1[2] + v1[3] * v1[3])); }
                s += __shfl_xor(s, 16); s += __shfl_xor(s, 32);
                if (fq == 0) ssq[(size_t)row * 16 + u.pn * 4 + wc] = s; }
        }
    }
};
template <bool LAST> struct EpiGate {
    static constexpr bool PERM = true, AFTER_DRAIN = false;
    const PG8_LAS unsigned char* lds; const bf16_t* base; float* out; bf16_t* pp; float* ssq_out;
    __device__ __forceinline__ void operator()(const f32x4 (&acc)[2][2][4][2], const Unit& u, int ui, int wr, int wc, int fr_, int fq_) const {
        int fr = fr_, fq = fq_; asm volatile("" : "+v"(fr), "+v"(fq));
        float rs[2][4]; load_rstd(lds, ui, wr, fr, rs);
        const int c0 = u.pn * BM + wc * 32 + 8 * fq; const int row0 = u.pm * BM + wr * 64 + fr; const unsigned eoff0 = (unsigned)(row0 * 1024 + c0);
#pragma unroll
        for (int ai = 0; ai < 2; ++ai) {
            u32x4 lp[4][2], lb[4][2];
#pragma unroll
            for (int m = 0; m < 4; ++m)
#pragma unroll
                for (int bj = 0; bj < 2; ++bj) { const unsigned o2 = eoff0 + (unsigned)(ai * (HALF * 1024) + m * (16 * 1024) + bj * HALF);
                    lp[m][bj] = *(const u32x4*)((const char*)pp + (size_t)(o2 * 2u)); lb[m][bj] = *(const u32x4*)((const char*)base + (size_t)(o2 * 2u)); }
#pragma unroll
            for (int m = 0; m < 4; ++m) { const int row = row0 + ai * HALF + m * 16; const float r = rs[ai][m]; float s = 0.f;
#pragma unroll
                for (int bj = 0; bj < 2; ++bj) { const unsigned o2 = eoff0 + (unsigned)(ai * (HALF * 1024) + m * (16 * 1024) + bj * HALF); const u32x4 pw = lp[m][bj], bw = lb[m][bj];
                    f32x4 p0, p1, v0, v1; unpack8(pw, p0, p1); unpack8(bw, v0, v1);
                    const f32x4 a0 = acc[ai][bj][m][0] * r, a1 = acc[ai][bj][m][1] * r;
#pragma unroll
                    for (int e = 0; e < 4; ++e) { v0[e] += sigmoidf_(a0[e]) * p0[e]; v1[e] += sigmoidf_(a1[e]) * p1[e]; }
                    if (LAST) { char* op = (char*)out + (size_t)(o2 * 4u); *(f32x4*)op = v0; *(f32x4*)(op + 16) = v1; }
                    else { u32x4 w; w.x = cvt_pk_bf16(v0[0], v0[1]); w.y = cvt_pk_bf16(v0[2], v0[3]); w.z = cvt_pk_bf16(v1[0], v1[1]); w.w = cvt_pk_bf16(v1[2], v1[3]); *(u32x4*)((char*)pp + (size_t)(o2 * 2u)) = w; }
                    s += ((v0[0] * v0[0] + v0[1] * v0[1]) + (v0[2] * v0[2] + v0[3] * v0[3])) + ((v1[0] * v1[0] + v1[1] * v1[1]) + (v1[2] * v1[2] + v1[3] * v1[3])); }
                s += __shfl_xor(s, 16); s += __shfl_xor(s, 32);
                if (fq == 0) ssq_out[(size_t)row * 16 + u.pn * 4 + wc] = s; }
        }
    }
};
struct EpiGateFinal {
    static constexpr bool PERM = true, AFTER_DRAIN = true;
    const PG8_LAS unsigned char* lds; const bf16_t* base; float* out; const bf16_t* pp; float* ssq; unsigned* cnt; const float* gfin; unsigned* tmo;
    __device__ __forceinline__ void operator()(const f32x4 (&)[2][2][4][2], const Unit&, int, int, int, int, int) const {}
    __device__ __forceinline__ void fused(const f32x4 (&acc)[2][2][4][2], const Unit& u, int wr, int wc, int fr_, int fq_, PG8_LAS unsigned char*, int, int) const {
        int fr = fr_, fq = fq_; asm volatile("" : "+v"(fr), "+v"(fq));
        float rs[2][4]; load_rstd(lds, 0, wr, fr, rs);
        const int c0 = u.pn * BM + wc * 32 + 8 * fq; const int row0 = u.pm * BM + wr * 64 + fr; const unsigned eoff0 = (unsigned)(row0 * 1024 + c0);
        f32x4 hv[2][4][2][2];
#pragma unroll
        for (int ai = 0; ai < 2; ++ai) {
            u32x4 lp[4][2], lb[4][2];
#pragma unroll
            for (int m = 0; m < 4; ++m)
#pragma unroll
                for (int bj = 0; bj < 2; ++bj) { const unsigned o2 = eoff0 + (unsigned)(ai * (HALF * 1024) + m * (16 * 1024) + bj * HALF);
                    lp[m][bj] = *(const u32x4*)((const char*)pp + (size_t)(o2 * 2u)); lb[m][bj] = *(const u32x4*)((const char*)base + (size_t)(o2 * 2u)); }
#pragma unroll
            for (int m = 0; m < 4; ++m) { const int row = row0 + ai * HALF + m * 16; const float r = rs[ai][m]; float s = 0.f;
#pragma unroll
                for (int bj = 0; bj < 2; ++bj) { const u32x4 pw = lp[m][bj], bw = lb[m][bj];
                    f32x4 p0, p1, v0, v1; unpack8(pw, p0, p1); unpack8(bw, v0, v1);
                    const f32x4 a0 = acc[ai][bj][m][0] * r, a1 = acc[ai][bj][m][1] * r;
#pragma unroll
                    for (int e = 0; e < 4; ++e) { v0[e] += sigmoidf_(a0[e]) * p0[e]; v1[e] += sigmoidf_(a1[e]) * p1[e]; }
                    hv[ai][m][bj][0] = v0; hv[ai][m][bj][1] = v1;
                    s += ((v0[0] * v0[0] + v0[1] * v0[1]) + (v0[2] * v0[2] + v0[3] * v0[3])) + ((v1[0] * v1[0] + v1[1] * v1[1]) + (v1[2] * v1[2] + v1[3] * v1[3])); }
                s += __shfl_xor(s, 16); s += __shfl_xor(s, 32);
                if (fq == 0) ssq[(size_t)row * 16 + u.pn * 4 + wc] = s; }
        }
        asm volatile("s_waitcnt vmcnt(0)" ::: "memory");
        __syncthreads();
        if (threadIdx.x == 0) {
            __builtin_amdgcn_fence(__ATOMIC_RELEASE, "agent");
            asm volatile("s_waitcnt vmcnt(0)" ::: "memory");
            unsigned* c = cnt + u.pm * 16;
            (void)__hip_atomic_fetch_add(c, 1u, __ATOMIC_RELAXED, __HIP_MEMORY_SCOPE_AGENT);
            unsigned sp = 0;
            while (__hip_atomic_load(c, __ATOMIC_RELAXED, __HIP_MEMORY_SCOPE_AGENT) < 4u) { __builtin_amdgcn_s_sleep(1); if (++sp > (1u << 22)) { atomicAdd(tmo, 1u); break; } }
            __builtin_amdgcn_fence(__ATOMIC_ACQUIRE, "agent");
            asm volatile("s_waitcnt vmcnt(0)" ::: "memory");
        }
        __syncthreads();
        f32x4 g[2][2];
#pragma unroll
        for (int bj = 0; bj < 2; ++bj) { g[bj][0] = *(const f32x4*)(gfin + c0 + bj * HALF); g[bj][1] = *(const f32x4*)(gfin + c0 + bj * HALF + 4); }
#pragma unroll
        for (int ai = 0; ai < 2; ++ai)
#pragma unroll
            for (int m = 0; m < 4; ++m) { const int row = row0 + ai * HALF + m * 16;
                const f32x4 q = *(const f32x4*)((const char*)ssq + (size_t)((unsigned)(row * 16 + fq * 4) * 4u));
                float t = (q[0] + q[1]) + (q[2] + q[3]); t += __shfl_xor(t, 16); t += __shfl_xor(t, 32);
                const float rr = rsqrtf(t * (1.0f / 1024.0f) + 1e-6f);
#pragma unroll
                for (int bj = 0; bj < 2; ++bj) { const unsigned o2 = eoff0 + (unsigned)(ai * (HALF * 1024) + m * (16 * 1024) + bj * HALF); char* op = (char*)out + (size_t)(o2 * 4u);
                    *(f32x4*)op = hv[ai][m][bj][0] * rr * g[bj][0]; *(f32x4*)(op + 16) = hv[ai][m][bj][1] * rr * g[bj][1]; } }
    }
};
struct EpiSlab {
    static constexpr bool PERM = true, AFTER_DRAIN = false;
    bf16_t* slab;
    __device__ __forceinline__ void operator()(const f32x4 (&acc)[2][2][4][2], const Unit& u, int ui, int wr, int wc, int fr_, int fq_) const {
        int fr = fr_, fq = fq_; asm volatile("" : "+v"(fr), "+v"(fq));
        const int c0 = wc * 32 + 8 * fq; const unsigned off0 = (unsigned)((wr * 64 + fr) * 256 + c0) * 2u;
#pragma unroll
        for (int ai = 0; ai < 2; ++ai)
#pragma unroll
            for (int m = 0; m < 4; ++m) {
#pragma unroll
                for (int bj = 0; bj < 2; ++bj) { const f32x4 v0 = acc[ai][bj][m][0], v1 = acc[ai][bj][m][1];
                    u32x4 w; w.x = cvt_pk_bf16(v0[0], v0[1]); w.y = cvt_pk_bf16(v0[2], v0[3]); w.z = cvt_pk_bf16(v1[0], v1[1]); w.w = cvt_pk_bf16(v1[2], v1[3]);
                    *(u32x4*)((char*)slab + (size_t)(off0 + ai * (HALF * 512) + m * (16 * 512) + bj * (HALF * 2))) = w; } }
    }
};

template <class Epi, class Sched, int LDA, int LDB, int KK, bool ALIGN_EPI = false, bool SP2 = false>
__device__ __forceinline__ void gemm_phase(PG8_LAS unsigned char* lds, const Gemm g, const Sched& S, const Epi& E) {
    int tid_ = threadIdx.x; asm volatile("" : "+v"(tid_));
    const int tid = tid_, wid = __builtin_amdgcn_readfirstlane(tid >> 6), lane = tid & 63, wr = wid >> 2, wc = wid & 3, fr = lane & 15, fq = lane >> 4;
    constexpr int K = KK, nt = K / BK;
    unsigned voffA[2], voffB[2];
#pragma unroll
    for (int i = 0; i < 2; ++i) { int R, C; stage_rc(tid * 16 + i * 8192, R, C); const int Rb = Epi::PERM ? ((R & ~31) + perm32(R & 31)) : R;
        voffA[i] = (unsigned)(R * LDA + C) * 2u; voffB[i] = (unsigned)(Rb * LDB + C) * 2u; }
    constexpr size_t kstep = (size_t)(BK * 2);
    constexpr size_t hstepA = (size_t)HALF * LDA * 2, hstepB = (size_t)HALF * LDB * 2;
    constexpr size_t tstepA = 2 * hstepA, tstepB = 2 * hstepB;
    const unsigned ldsw = (unsigned)wid * 1024u;
    const int aoff = lds_byte(wr * 64 + fr, fq * 8), boff = lds_byte(wc * 32 + fr, fq * 8);
#define PG8_SA(b, h) (((b) * 2 + (h)) * HTB)
#define PG8_SB(b, h) ((4 + (b) * 2 + (h)) * HTB)
#define PG8_STAGE_(bufoff, rsrc, soff, voff) do { _Pragma("unroll") for (int _i = 0; _i < 2; ++_i) \
        __builtin_amdgcn_raw_ptr_buffer_load_lds(rsrc, (PG8_LAS unsigned*)(lds + (bufoff) + ldsw + _i * 8192), 16, (int)(voff)[_i], (int)(soff), 0, 0); } while (0)
#define PG8_STAGEA(bufoff, soff) PG8_STAGE_(bufoff, rA, soff, voffA)
#define PG8_STAGEB(bufoff, soff) PG8_STAGE_(bufoff, rB, soff, voffB)
#define PG8_LDA(dst, b, h) do { _Pragma("unroll") for (int m = 0; m < 4; ++m) _Pragma("unroll") for (int k = 0; k < 2; ++k) dst[m][k] = *(const PG8_LAS bf16x8*)(lds + PG8_SA(b, h) + aoff + m * 2048 + k * 1024); } while (0)
#define PG8_LDB(dst, b, h) do { _Pragma("unroll") for (int n = 0; n < 2; ++n) _Pragma("unroll") for (int k = 0; k < 2; ++k) dst[n][k] = *(const PG8_LAS bf16x8*)(lds + PG8_SB(b, h) + boff + n * 2048 + k * 1024); } while (0)
#define PG8_MMA(ai, bj, At, Bt) do { __builtin_amdgcn_s_setprio(1); _Pragma("unroll") for (int m = 0; m < 4; ++m) _Pragma("unroll") for (int n = 0; n < 2; ++n) _Pragma("unroll") for (int k = 0; k < 2; ++k) \
        acc[ai][bj][m][n] = __builtin_amdgcn_mfma_f32_16x16x32_bf16(Bt[n][k], At[m][k], acc[ai][bj][m][n], 0, 0, 0); __builtin_amdgcn_s_setprio(0); } while (0)
#define PG8_WAIT_V(n) asm volatile("s_waitcnt vmcnt(" #n ")" ::: "memory")
#define PG8_WAIT_L(n) asm volatile("s_waitcnt lgkmcnt(" #n ")" ::: "memory")
#define PG8_BAR __builtin_amdgcn_s_barrier()
#define PG8_SCHED __builtin_amdgcn_sched_barrier(0)
    Unit cur, nxt; int ui = 0;
    if (!S.next(0, cur)) return;
    f32x4 acc[2][2][4][2];
#pragma unroll
    for (int a = 0; a < 2; ++a)
#pragma unroll
        for (int b = 0; b < 2; ++b)
#pragma unroll
            for (int m = 0; m < 4; ++m)
#pragma unroll
                for (int n = 0; n < 2; ++n) acc[a][b][m][n] = (f32x4){0.f, 0.f, 0.f, 0.f};
    bf16x8 At[4][2], B0[2][2], B1[2][2];
    const unsigned long long pA_ = (unsigned long long)g.A, pB_ = (unsigned long long)g.Bt;
    void* const uA = (void*)(((unsigned long long)(unsigned)__builtin_amdgcn_readfirstlane((int)(unsigned)(pA_ >> 32)) << 32) | (unsigned)__builtin_amdgcn_readfirstlane((int)(unsigned)pA_));
    void* const uB = (void*)(((unsigned long long)(unsigned)__builtin_amdgcn_readfirstlane((int)(unsigned)(pB_ >> 32)) << 32) | (unsigned)__builtin_amdgcn_readfirstlane((int)(unsigned)pB_));
    const __amdgpu_buffer_rsrc_t rA = __builtin_amdgcn_make_buffer_rsrc(uA, 0, 0x7ffffff0, 0x00020000), rB = __builtin_amdgcn_make_buffer_rsrc(uB, 0, 0x7ffffff0, 0x00020000);
    unsigned cA = (unsigned)cur.pm * (unsigned)tstepA, cB = (unsigned)cur.pn * (unsigned)tstepB;
    S.a_ready(cur);
    if constexpr (SP2) {
        PG8_STAGEB(PG8_SB(0, 0), cB); PG8_STAGEB(PG8_SB(0, 1), cB + hstepB); PG8_STAGEA(PG8_SA(0, 0), cA); PG8_STAGEA(PG8_SA(0, 1), cA + hstepA);
        if (wr == 1) PG8_BAR;
        PG8_WAIT_V(2); PG8_BAR;
        PG8_STAGEB(PG8_SB(1, 0), cB + kstep); PG8_STAGEA(PG8_SA(1, 0), cA + kstep); PG8_STAGEB(PG8_SB(1, 1), cB + hstepB + kstep);
        PG8_WAIT_V(6); PG8_BAR;
    } else {
        PG8_STAGEB(PG8_SB(0, 0), cB); PG8_STAGEA(PG8_SA(0, 0), cA); PG8_STAGEB(PG8_SB(0, 1), cB + hstepB); PG8_STAGEA(PG8_SA(0, 1), cA + hstepA);
        if (wr == 1) PG8_BAR;
        PG8_WAIT_V(4); PG8_BAR;
        PG8_STAGEB(PG8_SB(1, 0), cB + kstep); PG8_STAGEA(PG8_SA(1, 0), cA + kstep); PG8_STAGEB(PG8_SB(1, 1), cB + hstepB + kstep);
        PG8_WAIT_V(6); PG8_BAR;
    }
    for (;;) {
        const bool has_next = S.next(ui + 1, nxt);
        const unsigned nA = has_next ? (unsigned)nxt.pm * (unsigned)tstepA : cA, nB = has_next ? (unsigned)nxt.pn * (unsigned)tstepB : cB;
        for (int t = 0; t < nt; t += 2) {
            const bool last = (t == nt - 2);
            const unsigned a1 = cA + (unsigned)(t + 1) * (unsigned)kstep;
            const unsigned a2 = last ? nA : cA + (unsigned)(t + 2) * (unsigned)kstep, b2 = last ? nB : cB + (unsigned)(t + 2) * (unsigned)kstep;
            const unsigned a3 = a2 + (unsigned)kstep, b3 = b2 + (unsigned)kstep;
            if (last && has_next) S.a_ready(nxt);
            if constexpr (SP2) {
            PG8_LDB(B0, 0, 0); PG8_LDB(B1, 0, 1); PG8_SCHED; PG8_LDA(At, 0, 0); PG8_STAGEA(PG8_SA(1, 1), a1 + hstepA);
            PG8_WAIT_V(8); PG8_WAIT_L(0); PG8_BAR; PG8_MMA(0, 0, At, B0); PG8_MMA(0, 1, At, B1); PG8_BAR; PG8_SCHED;
            PG8_LDA(At, 0, 1); PG8_STAGEB(PG8_SB(0, 0), b2); PG8_STAGEB(PG8_SB(0, 1), b2 + hstepB); PG8_STAGEA(PG8_SA(0, 0), a2);
            PG8_WAIT_V(8); PG8_WAIT_L(0); PG8_BAR; PG8_MMA(1, 0, At, B0); PG8_MMA(1, 1, At, B1); PG8_BAR; PG8_SCHED;
            PG8_LDB(B0, 1, 0); PG8_LDB(B1, 1, 1); PG8_SCHED; PG8_LDA(At, 1, 0); PG8_STAGEA(PG8_SA(0, 1), a2 + hstepA);
            PG8_WAIT_V(8); PG8_WAIT_L(0); PG8_BAR; PG8_MMA(0, 0, At, B0); PG8_MMA(0, 1, At, B1); PG8_BAR; PG8_SCHED;
            PG8_LDA(At, 1, 1); PG8_STAGEB(PG8_SB(1, 0), b3); PG8_STAGEB(PG8_SB(1, 1), b3 + hstepB); PG8_STAGEA(PG8_SA(1, 0), a3);
            PG8_WAIT_V(8); PG8_WAIT_L(0); PG8_BAR; PG8_MMA(1, 0, At, B0); PG8_MMA(1, 1, At, B1); PG8_BAR; PG8_SCHED;
            } else {
            PG8_LDB(B0, 0, 0); PG8_SCHED; PG8_LDA(At, 0, 0); PG8_STAGEA(PG8_SA(1, 1), a1 + hstepA);
            PG8_WAIT_L(8); PG8_BAR; PG8_WAIT_L(0); PG8_MMA(0, 0, At, B0); PG8_BAR; PG8_SCHED;
            PG8_LDB(B1, 0, 1); PG8_STAGEB(PG8_SB(0, 0), b2);
            PG8_BAR; PG8_WAIT_L(0); PG8_MMA(0, 1, At, B1); PG8_BAR;
            PG8_LDA(At, 0, 1); PG8_STAGEA(PG8_SA(0, 0), a2);
            PG8_BAR; PG8_WAIT_L(0); PG8_MMA(1, 0, At, B0); PG8_BAR; PG8_SCHED;
            PG8_STAGEB(PG8_SB(0, 1), b2 + hstepB);
            PG8_WAIT_V(6); PG8_BAR; PG8_MMA(1, 1, At, B1); PG8_BAR;
            PG8_LDB(B0, 1, 0); PG8_SCHED; PG8_LDA(At, 1, 0); PG8_STAGEA(PG8_SA(0, 1), a2 + hstepA);
            PG8_WAIT_L(8); PG8_BAR; PG8_WAIT_L(0); PG8_MMA(0, 0, At, B0); PG8_BAR; PG8_SCHED;
            PG8_LDB(B1, 1, 1); PG8_STAGEB(PG8_SB(1, 0), b3);
            PG8_BAR; PG8_WAIT_L(0); PG8_MMA(0, 1, At, B1); PG8_BAR;
            PG8_LDA(At, 1, 1); PG8_STAGEA(PG8_SA(1, 0), a3);
            PG8_BAR; PG8_WAIT_L(0); PG8_MMA(1, 0, At, B0); PG8_BAR; PG8_SCHED;
            PG8_STAGEB(PG8_SB(1, 1), b3 + hstepB);
            PG8_WAIT_V(6); PG8_BAR; PG8_MMA(1, 1, At, B1); PG8_BAR;
            }
        }
        if constexpr (ALIGN_EPI) { if (wr == 0) PG8_BAR; }
        if constexpr (!Epi::AFTER_DRAIN) { E(acc, cur, ui, wr, wc, fr, fq); S.done(cur); }
        if (!has_next) break;
#pragma unroll
        for (int a = 0; a < 2; ++a)
#pragma unroll
            for (int b = 0; b < 2; ++b)
#pragma unroll
                for (int m = 0; m < 4; ++m)
#pragma unroll
                    for (int n = 0; n < 2; ++n) acc[a][b][m][n] = (f32x4){0.f, 0.f, 0.f, 0.f};
        cur = nxt; cA = nA; cB = nB; ++ui;
        if constexpr (ALIGN_EPI) { if (wr == 1) PG8_BAR; }
    }
    PG8_WAIT_V(0);
    if constexpr (!ALIGN_EPI) { if (wr == 0) PG8_BAR; }
    PG8_BAR;
    if constexpr (Epi::AFTER_DRAIN) { E.fused(acc, cur, wr, wc, fr, fq, lds, wid, lane); S.done(cur); }
#undef PG8_SA
#undef PG8_SB
#undef PG8_STAGE_
#undef PG8_STAGEA
#undef PG8_STAGEB
#undef PG8_LDA
#undef PG8_LDB
#undef PG8_MMA
#undef PG8_WAIT_V
#undef PG8_WAIT_L
#undef PG8_BAR
#undef PG8_SCHED
}
}
#ifndef PG8_SP2
#define PG8_SP2 true
#endif
#ifndef PG8_ALIGN
#define PG8_ALIGN true
#endif
constexpr int NWAVES = 8;
constexpr int BATCH = 2, T = 8192, D = 1024, H = 16, HD = 64, FF = 2816, HKV = 4;
constexpr int M = BATCH * T;
constexpr int NQKV = 3 * D, NNSA_SRC = 2608, NNSA = 2816, NFFI = 2 * FF, PLE = 256;
constexpr int NCMP = 511, CMPH = 256, CMPK = 2048;
constexpr float RMS_EPS = 1e-6f;
constexpr size_t MiB = 1u << 20;
constexpr size_t WS_CTL = 0, CTL_ZERO_BYTES = 1 * MiB;
constexpr size_t WS_WQKV = 2 * MiB;
constexpr size_t WS_WO0  = WS_WQKV + (size_t)NQKV * D * 2;
constexpr size_t WS_WFI0 = WS_WO0 + (size_t)D * D * 2;
constexpr size_t WS_WFO0 = WS_WFI0 + (size_t)NFFI * D * 2;
constexpr size_t WS_WG0  = WS_WFO0 + (size_t)D * FF * 2;
constexpr size_t WS_WP0  = WS_WG0 + (size_t)D * D * 2;
constexpr size_t WS_WNSA = WS_WP0 + (size_t)D * PLE * 2;
constexpr size_t WS_WO1  = WS_WNSA + (size_t)NNSA * D * 2;
constexpr size_t WS_WFI1 = WS_WO1 + (size_t)D * D * 2;
constexpr size_t WS_WFO1 = WS_WFI1 + (size_t)NFFI * D * 2;
constexpr size_t WS_WG1  = WS_WFO1 + (size_t)D * FF * 2;
constexpr size_t WS_WP1  = WS_WG1 + (size_t)D * D * 2;
constexpr size_t WS_WCK  = WS_WP1 + (size_t)D * PLE * 2;
constexpr size_t WS_WCV  = WS_WCK + (size_t)CMPH * CMPK * 2;
constexpr size_t WS_WEND = WS_WCV + (size_t)CMPH * CMPK * 2;
static_assert(WS_WEND <= 58 * MiB, "weights");
constexpr size_t WS_HB   = 58 * MiB;
constexpr size_t WS_KSELF = WS_HB, WS_VSELF = WS_HB + 8 * MiB;
constexpr size_t WS_SLAB = WS_HB + 16 * MiB;
constexpr size_t WS_PARKG = WS_HB + 16 * MiB;
constexpr size_t WS_KWINF = 110 * MiB, WS_VWINF = 118 * MiB;
constexpr size_t WS_KCF = 126 * MiB, WS_VCF = 126 * MiB + 512 * 1024;
constexpr size_t WS_SSQ0 = 90 * MiB, WS_SSQ1 = 91 * MiB;
constexpr size_t WS_MISC = 93 * MiB;
constexpr size_t WS_KCVC = 92 * MiB;
constexpr size_t WS_PB   = 94 * MiB;
constexpr size_t WS_QO   = 128 * MiB;
constexpr size_t WS_K0   = 160 * MiB, WS_V0 = 192 * MiB;
constexpr size_t WS_ACT  = 128 * MiB;
constexpr size_t WS_PP   = 224 * MiB;
constexpr size_t WS_KV1  = 160 * MiB;
constexpr size_t KVSZ    = (size_t)BATCH * HKV * T * HD;
constexpr size_t WS_GATES = 208 * MiB;
constexpr size_t WS_SPARE = 212 * MiB;
constexpr size_t WS_END  = 256 * MiB;
static_assert(WS_ACT + (size_t)M * FF * 2 <= WS_PP && WS_SPARE + 32 * MiB <= WS_END, "ws map");
constexpr int CW_TMO = 0, CW_CODE = 1;
constexpr int CW_BAR = 4096;
constexpr int CW_PANEL2 = 17408, CW_PANEL3 = 18432;
constexpr int CW_PANEL = 16384;
constexpr int RING_OFF = 0, RING_BYTES = 131072;
constexpr int LDS_BYTES = 148480;
constexpr int LDSCTL_OFF = LDS_BYTES - 512, MISC_OFF = LDSCTL_OFF + 320;
static_assert(MISC_OFF + 128 <= LDS_BYTES, "LDS map");

#define GAS __attribute__((address_space(1)))
#define LAS __attribute__((address_space(3)))
typedef unsigned short bf16;
typedef unsigned v4u __attribute__((ext_vector_type(4)));
typedef float f32x4 __attribute__((ext_vector_type(4)));
typedef short bf16x8 __attribute__((ext_vector_type(8)));
typedef unsigned u32x4_t __attribute__((ext_vector_type(4)));
typedef unsigned u32x2_t __attribute__((ext_vector_type(2)));
typedef GAS unsigned gu32;
typedef GAS unsigned long long gu64;
#define RLX_AGENT __ATOMIC_RELAXED, __HIP_MEMORY_SCOPE_AGENT
#define LDS_WAIT() asm volatile("s_waitcnt lgkmcnt(0)" ::: "memory")
#define VM_WAIT() asm volatile("s_waitcnt vmcnt(0)" ::: "memory")
__device__ __forceinline__ unsigned long long rt() { return __builtin_amdgcn_s_memrealtime(); }
__device__ __forceinline__ unsigned f2bf(float f) { unsigned u = __builtin_bit_cast(unsigned, f); return (u + 0x7fffu + ((u >> 16) & 1u)) >> 16; }
__device__ __forceinline__ unsigned pk2(float lo, float hi) { return f2bf(lo) | (f2bf(hi) << 16); }

#define XB_TMO      128
#define XB_XCNT(j)  (256  + 64 * (j))
#define XB_XSUB(j)  (1280 + 64 * (j))
#define XB_XGEN(j)  (2304 + 64 * (j))
#define XB_TOP      3328
#define XB_TOPGEN   3392
#define XCD_BAR_WORDS 3456
#define XB_SPIN_CAP (1u << 18)

__device__ __forceinline__ unsigned xb_ld(unsigned* p)              { return __hip_atomic_load(p, __ATOMIC_RELAXED, __HIP_MEMORY_SCOPE_AGENT); }
__device__ __forceinline__ unsigned xb_add(unsigned* p, unsigned v) { return __hip_atomic_fetch_add(p, v, __ATOMIC_RELAXED, __HIP_MEMORY_SCOPE_AGENT); }
__device__ __forceinline__ unsigned xb_xcc_id() { return (unsigned)__builtin_amdgcn_s_getreg((3 << 11) | 20) & 0xFu; }
#define XB_SPIN(cond, bar) do { unsigned _sp = 0; while (cond) { __builtin_amdgcn_s_sleep(1); \
    if ((++_sp & 255u) == 0u) { if (xb_ld(&(bar)[XB_TMO])) break; if (_sp > XB_SPIN_CAP) { atomicAdd(&(bar)[XB_TMO], 1u); break; } } } } while (0)

struct XcdBarrier {
    unsigned* bar; unsigned x;
    volatile LAS unsigned* st;
};

__device__ __forceinline__ XcdBarrier xcd_barrier_post(unsigned* bar, volatile LAS unsigned* st) {
    XcdBarrier b; b.bar = bar; b.x = xb_xcc_id(); b.st = st;
    if (threadIdx.x == 0) (void)xb_add(&bar[XB_XCNT(b.x)], 1u);
    return b;
}
__device__ __forceinline__ void xcd_barrier_complete(unsigned* bar, unsigned x, unsigned& nloc, unsigned& nx) {
    const unsigned G = gridDim.x * gridDim.y * gridDim.z;
    unsigned sum, cnt, mine, sp = 0u;
    for (;;) {
        sum = 0u; cnt = 0u; mine = 0u;
#pragma unroll
        for (unsigned j = 0; j < 16; ++j) { const unsigned c = xb_ld(&bar[XB_XCNT(j)]); sum += c; cnt += (c > 0u) ? 1u : 0u; }
        mine = xb_ld(&bar[XB_XCNT(x)]);
        if (sum == G) break;
        __builtin_amdgcn_s_sleep(1);
        if ((++sp & 255u) == 0u) { if (xb_ld(&bar[XB_TMO])) break; if (sp > XB_SPIN_CAP) { atomicAdd(&bar[XB_TMO], 1u); break; } }
    }
    nloc = mine > 0u ? mine : 1u; nx = cnt > 0u ? cnt : 1u;
}

__device__ __forceinline__ void xcd_barrier(const XcdBarrier& b) {
    asm volatile("s_waitcnt vmcnt(0)" ::: "memory");
    __syncthreads();
    if (threadIdx.x == 0) {
        unsigned* bar = b.bar;
        __builtin_amdgcn_s_waitcnt(0);
        unsigned nloc = b.st[0], nx = b.st[1];
        if (nloc == 0u) { xcd_barrier_complete(bar, b.x, nloc, nx); b.st[0] = nloc; b.st[1] = nx; }
        const unsigned old = xb_add(&bar[XB_XSUB(b.x)], 1u);
        const unsigned gen = old / nloc;
        if (old + 1u == (gen + 1u) * nloc) {
            __builtin_amdgcn_fence(__ATOMIC_RELEASE, "agent");
            asm volatile("s_waitcnt vmcnt(0)" ::: "memory");
            const unsigned og = xb_add(&bar[XB_TOP], 1u);
            const unsigned tg = og / nx;
            if (og + 1u == (tg + 1u) * nx) xb_add(&bar[XB_TOPGEN], 1u);
            else XB_SPIN(xb_ld(&bar[XB_TOPGEN]) == tg, bar);
            __builtin_amdgcn_fence(__ATOMIC_ACQUIRE, "agent");
            xb_add(&bar[XB_XGEN(b.x)], 1u);
            asm volatile("s_waitcnt vmcnt(0)" ::: "memory");
        } else {
            XB_SPIN(xb_ld(&bar[XB_XGEN(b.x)]) == gen, bar);
            __builtin_amdgcn_fence(__ATOMIC_ACQUIRE, "agent");
            asm volatile("s_waitcnt vmcnt(0)" ::: "memory");
        }
    }
    __syncthreads();
}
struct Frame {
    LAS unsigned char* lds;
    int tid, lane, wave;
    int vcu, G;
};
struct Args { const float* in[21]; float* out; unsigned char* ws; };
typedef const __attribute__((address_space(4))) Args* ArgsP;
__device__ __forceinline__ ArgsP kargs() { ArgsP p = (ArgsP)__builtin_amdgcn_kernarg_segment_ptr(); asm volatile("" : "+s"(p)); return p; }
__device__ __forceinline__ float wave_sum(float v) {
#pragma unroll
    for (int o = 1; o < 64; o <<= 1) v += __shfl_xor(v, o);
    return v;
}
__device__ __forceinline__ float wave_max(float v) {
#pragma unroll
    for (int o = 1; o < 64; o <<= 1) v = fmaxf(v, __shfl_xor(v, o));
    return v;
}
__device__ __forceinline__ unsigned long long wave_max_u64(unsigned long long v) {
#pragma unroll
    for (int o = 1; o < 64; o <<= 1) { const unsigned lo = __shfl_xor((unsigned)v, o), hi = __shfl_xor((unsigned)(v >> 32), o); const unsigned long long w = ((unsigned long long)hi << 32) | lo; v = w > v ? w : v; }
    return v;
}
__device__ __forceinline__ float dpp_xor1(float v) { return __uint_as_float(__builtin_amdgcn_update_dpp(0u, __float_as_uint(v), 0xB1, 0xF, 0xF, false)); }
__device__ __forceinline__ float dpp_xor2(float v) { return __uint_as_float(__builtin_amdgcn_update_dpp(0u, __float_as_uint(v), 0x4E, 0xF, 0xF, false)); }
__device__ __forceinline__ float swap32(float v) { auto rr = __builtin_amdgcn_permlane32_swap(__float_as_uint(v), __float_as_uint(v), false, false); return __uint_as_float((threadIdx.x & 32) ? rr[0] : rr[1]); }
__device__ __forceinline__ float bflo(unsigned u) { return __uint_as_float(u << 16); }
__device__ __forceinline__ float bfhi(unsigned u) { return __uint_as_float(u & 0xffff0000u); }
__device__ __forceinline__ float bf2f(bf16 u) { return __uint_as_float((unsigned)u << 16); }

template <int MAP> __device__ __forceinline__ void conv_item(const float* W, int K, int Nsrc, int Ndst, const float* gain, bf16* WT, LAS float* scr, int item, int lane) {
    const int nblk = Ndst / 32, kb = item / nblk, nb = item % nblk, k0 = 64 * kb, n0 = 32 * nb;
    const int u = lane & 7; int sc, r0;
    if (MAP == 2) { sc = ((n0 & 128) ? FF : 0) + 128 * (n0 >> 8) + (n0 & 127) + 4 * u; r0 = 4 * u; }
    else { sc = n0 + 4 * u; r0 = 4 * u; if (MAP == 1 && sc >= Nsrc) sc = -1; }
    f32x4 v[8];
#pragma unroll
    for (int i = 0; i < 8; ++i) { const int kk = (lane >> 3) + 8 * i; v[i] = sc >= 0 ? *(const GAS f32x4*)(W + (size_t)(k0 + kk) * Nsrc + sc) : (f32x4){0.f, 0.f, 0.f, 0.f}; }
    if (gain) {
#pragma unroll
        for (int i = 0; i < 8; ++i) v[i] = v[i] * gain[k0 + (lane >> 3) + 8 * i]; }
#pragma unroll
    for (int i = 0; i < 8; ++i) { const int kk = (lane >> 3) + 8 * i; LAS float* d = scr + kk * 33 + r0; d[0] = v[i].x; d[1] = v[i].y; d[2] = v[i].z; d[3] = v[i].w; }
    LDS_WAIT(); asm volatile("" ::: "memory");
    const int c = lane & 7;
#pragma unroll
    for (int j = 0; j < 4; ++j) { const int n = (lane >> 3) + 8 * j; const LAS float* s = scr + (8 * c) * 33 + n;
        v4u o; o.x = pk2(s[0 * 33], s[1 * 33]); o.y = pk2(s[2 * 33], s[3 * 33]); o.z = pk2(s[4 * 33], s[5 * 33]); o.w = pk2(s[6 * 33], s[7 * 33]);
        *(GAS v4u*)(WT + (size_t)(n0 + n) * K + k0 + 8 * c) = o; }
    LDS_WAIT(); asm volatile("" ::: "memory");
}
#define WSP(T_, off) ((T_*)(ap->ws + (off)))
__device__ __forceinline__ void p0_prologue(Frame& F) {
    ArgsP ap = kargs();
    LAS float* scr = (LAS float*)(F.lds + RING_OFF + F.wave * 16384);
    const int gw = F.vcu * NWAVES + F.wave, NGW = F.G * NWAVES;
    constexpr int I_QKV = (D / 64) * (NQKV / 32), I_DD = (D / 64) * (D / 32), I_FI = (D / 64) * (NFFI / 32), I_FO = (FF / 64) * (D / 32), I_P = (PLE / 64) * (D / 32),
                  I_NSA = (D / 64) * (NNSA / 32), I_C = (CMPK / 64) * (CMPH / 32);
    constexpr int NITEMS = I_QKV + I_DD + I_FI + I_FO + I_DD + I_P + I_NSA + I_DD + I_FI + I_FO + I_DD + I_P + I_C + I_C;
    for (int it = gw; it < NITEMS; it += NGW) {
        int r = it;
        if (r < I_QKV) { conv_item<0>(ap->in[7], D, NQKV, NQKV, ap->in[3], WSP(bf16, WS_WQKV), scr, r, F.lane); continue; } r -= I_QKV;
        if (r < I_DD)  { conv_item<0>(ap->in[8], D, D, D, nullptr, WSP(bf16, WS_WO0), scr, r, F.lane); continue; } r -= I_DD;
        if (r < I_FI)  { conv_item<2>(ap->in[17], D, NFFI, NFFI, ap->in[4], WSP(bf16, WS_WFI0), scr, r, F.lane); continue; } r -= I_FI;
        if (r < I_FO)  { conv_item<0>(ap->in[18], FF, D, D, nullptr, WSP(bf16, WS_WFO0), scr, r, F.lane); continue; } r -= I_FO;
        if (r < I_DD)  { conv_item<0>(ap->in[20], D, D, D, ap->in[5], WSP(bf16, WS_WG0), scr, r, F.lane); continue; } r -= I_DD;
        if (r < I_P)   { conv_item<0>(ap->in[19], PLE, D, D, nullptr, WSP(bf16, WS_WP0), scr, r, F.lane); continue; } r -= I_P;
        if (r < I_NSA) { conv_item<1>(ap->in[9], D, NNSA_SRC, NNSA, ap->in[3] + D, WSP(bf16, WS_WNSA), scr, r, F.lane); continue; } r -= I_NSA;
        if (r < I_DD)  { conv_item<0>(ap->in[10], D, D, D, nullptr, WSP(bf16, WS_WO1), scr, r, F.lane); continue; } r -= I_DD;
        if (r < I_FI)  { conv_item<2>(ap->in[17] + (size_t)D * NFFI, D, NFFI, NFFI, ap->in[4] + D, WSP(bf16, WS_WFI1), scr, r, F.lane); continue; } r -= I_FI;
        if (r < I_FO)  { conv_item<0>(ap->in[18] + (size_t)FF * D, FF, D, D, nullptr, WSP(bf16, WS_WFO1), scr, r, F.lane); continue; } r -= I_FO;
        if (r < I_DD)  { conv_item<0>(ap->in[20] + (size_t)D * D, D, D, D, ap->in[5] + D, WSP(bf16, WS_WG1), scr, r, F.lane); continue; } r -= I_DD;
        if (r < I_P)   { conv_item<0>(ap->in[19] + (size_t)PLE * D, PLE, D, D, nullptr, WSP(bf16, WS_WP1), scr, r, F.lane); continue; } r -= I_P;
        if (r < I_C)   { conv_item<0>(ap->in[13], CMPK, CMPH, CMPH, nullptr, WSP(bf16, WS_WCK), scr, r, F.lane); continue; } r -= I_C;
        conv_item<0>(ap->in[15], CMPK, CMPH, CMPH, nullptr, WSP(bf16, WS_WCV), scr, r, F.lane);
    }
    {
        bf16* hb = WSP(bf16, WS_HB); float* ssq = WSP(float, WS_SSQ0);
        for (int m = gw; m < M; m += NGW) {
            const GAS f32x4* xr = (const GAS f32x4*)(ap->in[0] + (size_t)m * D) + F.lane; f32x4 v[4]; float s = 0.f;
#pragma unroll
            for (int j = 0; j < 4; ++j) { v[j] = xr[64 * j]; s += (v[j].x * v[j].x + v[j].y * v[j].y) + (v[j].z * v[j].z + v[j].w * v[j].w); }
            s = wave_sum(s);
            GAS unsigned long long* o8 = (GAS unsigned long long*)(hb + (size_t)m * D) + F.lane;
#pragma unroll
            for (int j = 0; j < 4; ++j) o8[64 * j] = (unsigned long long)pk2(v[j].x, v[j].y) | ((unsigned long long)pk2(v[j].z, v[j].w) << 32);
            if (F.lane < 16) ssq[(size_t)m * 16 + F.lane] = F.lane == 0 ? s : 0.f;
        }
    }
    {
        const GAS f32x4* p4 = (const GAS f32x4*)ap->in[1]; GAS unsigned long long* o8 = (GAS unsigned long long*)WSP(bf16, WS_PB);
        const int NI = 2 * M * PLE / 4; const int gt = F.vcu * (NWAVES * 64) + F.tid, NTH = F.G * NWAVES * 64;
        for (int i = gt; i < NI; i += NTH) { const f32x4 v = p4[i]; o8[i] = (unsigned long long)pk2(v.x, v.y) | ((unsigned long long)pk2(v.z, v.w) << 32); }
    }
    {
        float* b1p = WSP(float, WS_MISC);
        for (int it = gw; it < 64; it += NGW) { const int which = it >> 5, c = (it >> 2) & 7, jb = it & 3, j = jb * 64 + F.lane;
            const float* pe = which ? ap->in[12] : ap->in[11]; const float* w1 = which ? ap->in[15] : ap->in[13]; float a = 0.f;
            for (int kk = c * 256; kk < c * 256 + 256; ++kk) a += pe[kk] * w1[(size_t)kk * CMPH + j];
            b1p[(which * 8 + c) * 256 + j] = a; }
    }
}

__device__ __forceinline__ int t5_bucket(int n) {
    if (n < 16) return n < 0 ? 0 : n;
    if (n >= 113) return 31;
    return 16 + (n >= 19) + (n >= 21) + (n >= 24) + (n >= 27) + (n >= 31) + (n >= 35) + (n >= 40) + (n >= 46) + (n >= 52) + (n >= 59) + (n >= 67) + (n >= 77) + (n >= 87) + (n >= 99);
}
__device__ __forceinline__ void load_q64(float (&q)[64], const bf16* p) {
    const uint4* p4 = (const uint4*)p;
#pragma unroll
    for (int i = 0; i < 8; ++i) { const uint4 w = p4[i]; q[8 * i + 0] = bflo(w.x); q[8 * i + 1] = bfhi(w.x); q[8 * i + 2] = bflo(w.y); q[8 * i + 3] = bfhi(w.y);
        q[8 * i + 4] = bflo(w.z); q[8 * i + 5] = bfhi(w.z); q[8 * i + 6] = bflo(w.w); q[8 * i + 7] = bfhi(w.w); }
}
__device__ __forceinline__ float dot64(const float (&q)[64], const bf16* p) {
    const uint4* p4 = (const uint4*)p; float a = 0.f;
#pragma unroll
    for (int i = 0; i < 8; ++i) { const uint4 w = p4[i];
        a += q[8 * i + 0] * bflo(w.x); a += q[8 * i + 1] * bfhi(w.x); a += q[8 * i + 2] * bflo(w.y); a += q[8 * i + 3] * bfhi(w.y);
        a += q[8 * i + 4] * bflo(w.z); a += q[8 * i + 5] * bfhi(w.z); a += q[8 * i + 6] * bflo(w.w); a += q[8 * i + 7] * bfhi(w.w); }
    return a;
}
__device__ __forceinline__ void sb_simple(Frame& F) {
    ArgsP ap = kargs();
    bf16* QO = WSP(bf16, WS_QO); const bf16* Kh = WSP(bf16, WS_K0); const bf16* Vh = WSP(bf16, WS_V0);
    const int gt = F.vcu * (NWAVES * 64) + F.tid, NTH = F.G * NWAVES * 64;
    for (int it = gt; it < BATCH * H * T; it += NTH) {
        const int t = it & (T - 1), h = (it >> 13) & 15, b = it >> 17;
        bf16* qp = QO + ((size_t)(b * T + t)) * D + h * HD;
        float q[64]; load_q64(q, qp);
        float o[64];
#pragma unroll
        for (int d = 0; d < 64; ++d) o[d] = 0.f;
        const bf16* kp = Kh + ((size_t)(b * H + h) * T) * HD; const bf16* vp = Vh + ((size_t)(b * H + h) * T) * HD;
        float carry = 0.f;
        for (int s = t - 1; s >= 0; --s) {
            const float z = dot64(q, kp + (size_t)s * HD);
            const float sp = fmaxf(z, 0.f) + log1pf(expf(-fabsf(z)));
            const float a = expf((z - sp) + carry);
            const uint4* v4 = (const uint4*)(vp + (size_t)s * HD);
#pragma unroll
            for (int i = 0; i < 8; ++i) { const uint4 w = v4[i];
                o[8 * i + 0] += a * bflo(w.x); o[8 * i + 1] += a * bfhi(w.x); o[8 * i + 2] += a * bflo(w.y); o[8 * i + 3] += a * bfhi(w.y);
                o[8 * i + 4] += a * bflo(w.z); o[8 * i + 5] += a * bfhi(w.z); o[8 * i + 6] += a * bflo(w.w); o[8 * i + 7] += a * bfhi(w.w); }
            carry -= sp;
            if (carry < -104.f) break;
        }
        uint4* o4 = (uint4*)qp;
#pragma unroll
        for (int i = 0; i < 8; ++i) { uint4 w; w.x = pk2(o[8 * i + 0], o[8 * i + 1]); w.y = pk2(o[8 * i + 2], o[8 * i + 3]); w.z = pk2(o[8 * i + 4], o[8 * i + 5]); w.w = pk2(o[8 * i + 6], o[8 * i + 7]); o4[i] = w; }
    }
}
typedef _Float16 f16x8 __attribute__((ext_vector_type(8)));
typedef float f32x16 __attribute__((ext_vector_type(16)));
typedef short v4i16_t __attribute__((ext_vector_type(4)));
__device__ __forceinline__ bf16x8 tr_pair(const LAS unsigned char* p0, const LAS unsigned char* p1) {
    const v4i16_t lo = __builtin_amdgcn_ds_read_tr16_b64_v4i16((LAS v4i16_t*)p0), hi = __builtin_amdgcn_ds_read_tr16_b64_v4i16((LAS v4i16_t*)p1);
    return (bf16x8){lo[0], lo[1], lo[2], lo[3], hi[0], hi[1], hi[2], hi[3]};
}
__device__ __forceinline__ unsigned pkbf(float lo, float hi) { typedef float f2 __attribute__((ext_vector_type(2))); typedef __bf16 b2 __attribute__((ext_vector_type(2))); f2 v = {lo, hi}; b2 b = __builtin_convertvector(v, b2); return __builtin_bit_cast(unsigned, b); }
__device__ __forceinline__ void sb_mfma(Frame& F, size_t out_off = WS_QO) {
    ArgsP ap = kargs();
    LAS unsigned char* vl = F.lds + RING_OFF + F.wave * 16384;
    const int lane = F.lane, c = lane & 31, hh = lane >> 5;
    bf16* QO = WSP(bf16, WS_QO); const bf16* Kh = WSP(bf16, WS_K0); const bf16* Vh = WSP(bf16, WS_V0);
    f16x8 U0, U1;
    { u32x4_t w0, w1; unsigned short e0[8], e1[8];
#pragma unroll
      for (int j = 0; j < 8; ++j) { const int k0 = 8 * (j >> 2) + 4 * hh + (j & 3); e0[j] = (k0 > c) ? 0x3C00 : 0; e1[j] = (16 + k0 > c) ? 0x3C00 : 0; }
      w0.x = e0[0] | ((unsigned)e0[1] << 16); w0.y = e0[2] | ((unsigned)e0[3] << 16); w0.z = e0[4] | ((unsigned)e0[5] << 16); w0.w = e0[6] | ((unsigned)e0[7] << 16);
      w1.x = e1[0] | ((unsigned)e1[1] << 16); w1.y = e1[2] | ((unsigned)e1[3] << 16); w1.z = e1[4] | ((unsigned)e1[5] << 16); w1.w = e1[6] | ((unsigned)e1[7] << 16);
      U0 = __builtin_bit_cast(f16x8, w0); U1 = __builtin_bit_cast(f16x8, w1); }
    const LAS unsigned char* vrd = vl + (4 * hh + ((lane & 15) >> 2)) * 128 + (16 * ((lane >> 4) & 1) + 4 * (lane & 3)) * 2;
    LAS unsigned char* vwr = vl + (lane >> 1) * 128 + (lane & 1) * 64;
    const int gw = F.vcu * NWAVES + F.wave, NGW = F.G * NWAVES;
    constexpr float L2E = 1.4426950408889634f, LN2 = 0.6931471805599453f;
    for (int it = gw; it < BATCH * H * (T / 32); it += NGW) {
        const int qt = it & 255, hd = (it >> 8) & 15, b = it >> 12;
        bf16* Qp = QO + ((size_t)(b * T + 32 * qt + c)) * D + hd * HD;
        bf16x8 Qf[4];
#pragma unroll
        for (int ks = 0; ks < 4; ++ks) Qf[ks] = *(const bf16x8*)(Qp + 16 * ks + 8 * hh);
        const bf16* Kb = Kh + ((size_t)(b * H + hd) * T) * HD; const bf16* Vb = Vh + ((size_t)(b * H + hd) * T) * HD;
        f32x16 O0, O1;
#pragma unroll
        for (int r = 0; r < 16; ++r) { O0[r] = 0.f; O1[r] = 0.f; }
        float carry = 0.f;
        bf16x8 Kn[4]; u32x4_t Vn[4];
        { const bf16* kp = Kb + (size_t)(32 * qt + c) * HD + 8 * hh; const bf16* vp = Vb + (size_t)(32 * qt + (lane >> 1)) * HD + (lane & 1) * 32;
#pragma unroll
          for (int i = 0; i < 4; ++i) { Kn[i] = *(const bf16x8*)(kp + 16 * i); Vn[i] = *(const u32x4_t*)(vp + 8 * i); } }
        for (int kt = qt; kt >= 0; --kt) {
            bf16x8 Kc[4]; u32x4_t Vc[4];
#pragma unroll
            for (int i = 0; i < 4; ++i) { Kc[i] = Kn[i]; Vc[i] = Vn[i]; }
            { const int kn = kt > 0 ? kt - 1 : 0; const bf16* kp = Kb + (size_t)(32 * kn + c) * HD + 8 * hh; const bf16* vp = Vb + (size_t)(32 * kn + (lane >> 1)) * HD + (lane & 1) * 32;
#pragma unroll
                for (int i = 0; i < 4; ++i) { Kn[i] = *(const bf16x8*)(kp + 16 * i); Vn[i] = *(const u32x4_t*)(vp + 8 * i); } }
#pragma unroll
            for (int i = 0; i < 4; ++i) *(LAS u32x4_t*)(vwr + 16 * i) = Vc[i];
            f32x16 z;
#pragma unroll
            for (int r = 0; r < 16; ++r) z[r] = 0.f;
#pragma unroll
            for (int ks = 0; ks < 4; ++ks) z = __builtin_amdgcn_mfma_f32_32x32x16_bf16(Kc[ks], Qf[ks], z, 0, 0, 0);
            const bool diag = kt == qt;
            float lf[16], ls[16]; float tot = 0.f;
#pragma unroll
            for (int r = 0; r < 16; ++r) { const int key = (r & 3) + 8 * (r >> 2) + 4 * hh; const bool valid = !diag || key < c; const float zz = z[r];
                const float sp = fmaxf(zz, 0.f) + LN2 * __builtin_amdgcn_logf(1.0f + __builtin_amdgcn_exp2f(-fabsf(zz) * L2E));
                lf[r] = valid ? -sp : 0.f; ls[r] = valid ? zz - sp : -INFINITY; tot += lf[r]; }
            const f16x8 X0 = {(_Float16)lf[0], (_Float16)lf[1], (_Float16)lf[2], (_Float16)lf[3], (_Float16)lf[4], (_Float16)lf[5], (_Float16)lf[6], (_Float16)lf[7]};
            const f16x8 X1 = {(_Float16)lf[8], (_Float16)lf[9], (_Float16)lf[10], (_Float16)lf[11], (_Float16)lf[12], (_Float16)lf[13], (_Float16)lf[14], (_Float16)lf[15]};
            f32x16 Y;
#pragma unroll
            for (int r = 0; r < 16; ++r) Y[r] = 0.f;
            Y = __builtin_amdgcn_mfma_f32_32x32x16_f16(U0, X0, Y, 0, 0, 0); Y = __builtin_amdgcn_mfma_f32_32x32x16_f16(U1, X1, Y, 0, 0, 0);
            tot += __shfl_xor(tot, 32);
            float a[16];
#pragma unroll
            for (int r = 0; r < 16; ++r) a[r] = __builtin_amdgcn_exp2f((ls[r] + Y[r] + carry) * L2E);
            bf16x8 P0, P1; { u32x4_t w0, w1; w0.x = pkbf(a[0], a[1]); w0.y = pkbf(a[2], a[3]); w0.z = pkbf(a[4], a[5]); w0.w = pkbf(a[6], a[7]); w1.x = pkbf(a[8], a[9]); w1.y = pkbf(a[10], a[11]); w1.z = pkbf(a[12], a[13]); w1.w = pkbf(a[14], a[15]);
                P0 = __builtin_bit_cast(bf16x8, w0); P1 = __builtin_bit_cast(bf16x8, w1); }
            O0 = __builtin_amdgcn_mfma_f32_32x32x16_bf16(tr_pair(vrd, vrd + 8 * 128), P0, O0, 0, 0, 0);
            O0 = __builtin_amdgcn_mfma_f32_32x32x16_bf16(tr_pair(vrd + 16 * 128, vrd + 24 * 128), P1, O0, 0, 0, 0);
            O1 = __builtin_amdgcn_mfma_f32_32x32x16_bf16(tr_pair(vrd + 64, vrd + 64 + 8 * 128), P0, O1, 0, 0, 0);
            O1 = __builtin_amdgcn_mfma_f32_32x32x16_bf16(tr_pair(vrd + 64 + 16 * 128, vrd + 64 + 24 * 128), P1, O1, 0, 0, 0);
            carry += tot;
            if (__all(carry < -104.0f)) break;
        }
#pragma unroll
        for (int rg = 0; rg < 4; ++rg) { u32x2_t w0, w1; w0.x = pkbf(O0[4 * rg], O0[4 * rg + 1]); w0.y = pkbf(O0[4 * rg + 2], O0[4 * rg + 3]); w1.x = pkbf(O1[4 * rg], O1[4 * rg + 1]); w1.y = pkbf(O1[4 * rg + 2], O1[4 * rg + 3]);
            bf16* Op = WSP(bf16, out_off) + ((size_t)(b * T + 32 * qt + c)) * D + hd * HD;
            *(u32x2_t*)(Op + 8 * rg + 4 * hh) = w0; *(u32x2_t*)(Op + 32 + 8 * rg + 4 * hh) = w1; }
    }
}
__device__ __forceinline__ float gelu_tanh(float x) { const float u = 0.7978845608028654f * (x + 0.044715f * x * x * x); return 0.5f * x * (1.0f + tanhf(u)); }
__device__ __forceinline__ void cmp_stage2(Frame& F) {
    ArgsP ap = kargs();
    LAS float* hbuf = (LAS float*)(F.lds + RING_OFF + F.wave * 16384);
    const int gw = F.vcu * NWAVES + F.wave, NGW = F.G * NWAVES;
    const bf16* slab = WSP(bf16, WS_SLAB); const float* b1p = WSP(float, WS_MISC); bf16* kcvc = WSP(bf16, WS_KCVC);
    for (int it = gw; it < 2 * 1024; it += NGW) {
        const int which = it >> 10, r0 = (it & 1023) * 4, tile = r0 >> 8;
        const float* w2 = which ? ap->in[16] : ap->in[14];
        float bias[4];
#pragma unroll
        for (int q = 0; q < 4; ++q) { const int j = F.lane + 64 * q; float bsum = 0.f;
#pragma unroll
            for (int c = 0; c < 8; ++c) bsum += b1p[(which * 8 + c) * 256 + j];
            bias[q] = bsum; }
#pragma unroll
        for (int rw = 0; rw < 4; ++rw) { const int rr = (r0 + rw) & 255;
#pragma unroll
            for (int q = 0; q < 4; ++q) { const int j = F.lane + 64 * q; float pre = bias[q];
#pragma unroll
                for (int ks = 0; ks < 4; ++ks) pre += bf2f(slab[((size_t)((ks * 2 + which) * 16 + tile) * 256 + rr) * 256 + j]);
                hbuf[rw * 256 + j] = gelu_tanh(pre); } }
        LDS_WAIT(); asm volatile("" ::: "memory");
        float a[4] = {0.f, 0.f, 0.f, 0.f};
        const float* w2l = w2 + F.lane;
        float wv[32], wn[32];
#pragma unroll
        for (int u = 0; u < 32; ++u) wv[u] = w2l[u * 64];
#pragma unroll 1
        for (int j0 = 0; j0 < 256; j0 += 32) {
            const int jn = j0 + 32 < 256 ? j0 + 32 : j0;
#pragma unroll
            for (int u = 0; u < 32; ++u) wn[u] = w2l[(jn + u) * 64];
#pragma unroll
            for (int u4 = 0; u4 < 8; ++u4) {
#pragma unroll
                for (int rw = 0; rw < 4; ++rw) { const f32x4 h4 = *(const LAS f32x4*)(hbuf + rw * 256 + j0 + 4 * u4);
                    a[rw] += h4[0] * wv[4 * u4 + 0]; a[rw] += h4[1] * wv[4 * u4 + 1]; a[rw] += h4[2] * wv[4 * u4 + 2]; a[rw] += h4[3] * wv[4 * u4 + 3]; } }
#pragma unroll
            for (int u = 0; u < 32; ++u) wv[u] = wn[u];
        }
#pragma unroll
        for (int rw = 0; rw < 4; ++rw) { const int r = r0 + rw, i = r & 511; const float av = i >= NCMP ? 0.f : a[rw];
            kcvc[((size_t)which * 4096 + r) * 64 + F.lane] = (bf16)f2bf(av);
            const int bh_ = r >> 9, blk = i >> 6, nn = i & 63, d = F.lane;
            if (which == 0) { const int tl = nn >> 5, r32 = nn & 31, ks = d >> 4, h = (d >> 3) & 1, e = d & 7; WSP(bf16, WS_KCF)[(((size_t)(bh_ * 8 + blk) * 8 + 4 * tl + ks) * 64 + r32 + 32 * h) * 8 + e] = (bf16)f2bf(av); }
            else { const int k4 = nn >> 4, kk = nn & 15, e = ((kk >> 3) << 2) | (kk & 3), hA = (kk >> 2) & 1, dt = d >> 5, dp = d & 31; WSP(bf16, WS_VCF)[(((size_t)(bh_ * 8 + blk) * 8 + 4 * dt + k4) * 64 + dp + 32 * hA) * 8 + e] = (bf16)f2bf(av); } }
        LDS_WAIT(); asm volatile("" ::: "memory");
    }
}
__device__ __forceinline__ void nsa_simple(Frame& F, size_t out_off = WS_QO) {
    ArgsP ap = kargs();
    LAS float* pbuf = (LAS float*)(F.lds + RING_OFF + F.wave * 16384);
    LAS float* pg = pbuf + 1024;
    LAS float* obuf = pbuf + 1536;
    LAS int* selb = (LAS int*)(pbuf + 2304);
    const int gw = F.vcu * NWAVES + F.wave, NGW = F.G * NWAVES, lane = F.lane;
    bf16* NQ = WSP(bf16, WS_QO); const bf16* KV = WSP(bf16, WS_KV1); const bf16* KCVC = WSP(bf16, WS_KCVC);
    const float* gates = WSP(float, WS_GATES); const float* rel_bias = ap->in[2];
    for (int it = gw; it < BATCH * HKV * T; it += NGW) {
        const int t = it & (T - 1), hkv = (it >> 13) & 3, b = it >> 15, bh = b * 4 + hkv, cur = t >> 6;
        const bf16* kc = KCVC + (size_t)bh * 512 * 64; const bf16* vc = KCVC + (size_t)4096 * 64 + (size_t)bh * 512 * 64;
        const bf16* ksel = KV + 2 * KVSZ + (size_t)bh * T * HD; const bf16* vsel = KV + 3 * KVSZ + (size_t)bh * T * HD;
        const bf16* kwin = KV + 4 * KVSZ + (size_t)bh * T * HD; const bf16* vwin = KV + 5 * KVSZ + (size_t)bh * T * HD;
        bf16* qrow = NQ + (size_t)(b * T + t) * D + hkv * 256;
        const int nv = t >= 31 ? ((t - 31) >> 4) + 1 : 0;
#pragma unroll 1
        for (int i = 0; i < 8; ++i) pg[lane + 64 * i] = 0.f;
#pragma unroll 1
        for (int g = 0; g < 4; ++g) {
            const int hq = hkv * 4 + g; float qv[64]; load_q64(qv, qrow + g * 64);
            float mx = -INFINITY;
#pragma unroll 1
            for (int i = 0; i < 8; ++i) { const int n = lane + 64 * i;
                const float sc = n < nv ? dot64(qv, kc + (size_t)n * 64) + rel_bias[t5_bucket(t - 16 * n - 31) * 16 + hq] : -INFINITY; pbuf[n] = sc; mx = fmaxf(mx, sc); }
            mx = wave_max(mx); const float mm = mx == -INFINITY ? 0.f : mx; float sum = 0.f;
#pragma unroll 1
            for (int i = 0; i < 8; ++i) { const int n = lane + 64 * i; const float e = n < nv ? expf(pbuf[n] - mm) : 0.f; pbuf[n] = e; sum += e; }
            sum = wave_sum(sum); const float inv = 1.0f / (sum > 0.f ? sum : 1.0f);
#pragma unroll 1
            for (int i = 0; i < 8; ++i) { const int n = lane + 64 * i; const float p = pbuf[n] * inv; pbuf[n] = p; pg[n] += p; }
            LDS_WAIT(); asm volatile("" ::: "memory");
            float a = 0.f;
            for (int n = 0; n < nv; ++n) a += pbuf[n] * bf2f(vc[(size_t)n * 64 + lane]);
            obuf[g * 64 + lane] = a;
            LDS_WAIT(); asm volatile("" ::: "memory");
        }
        unsigned long long key[2];
#pragma unroll
        for (int q = 0; q < 2; ++q) { const int j = lane + 64 * q; float imp = 0.f;
#pragma unroll
            for (int dn = -1; dn <= 3; ++dn) { const int n = 4 * j + dn; if (n >= 0 && n < 512) imp += pg[n]; }
            const bool forced = (j == 0) || (j == cur) || (j == cur - 1); const float val = forced ? 100.0f : imp;
            key[q] = j <= cur ? (((unsigned long long)__float_as_uint(val) << 32) | (unsigned)(128 - j)) : 0ull; }
#pragma unroll 1
        for (int r = 0; r < 16; ++r) { unsigned long long k = key[0] > key[1] ? key[0] : key[1]; k = wave_max_u64(k);
            const int sj = k ? 128 - (int)(unsigned)(k & 0xffffffffull) : -1; if (lane == 0) selb[r] = sj;
            if (k) { if (key[0] == k) key[0] = 0ull; if (key[1] == k) key[1] = 0ull; } }
        LDS_WAIT(); asm volatile("" ::: "memory");
#pragma unroll 1
        for (int g = 0; g < 4; ++g) {
            const int hq = hkv * 4 + g; float qv[64]; load_q64(qv, qrow + g * 64);
            float mx = -INFINITY;
#pragma unroll 1
            for (int r = 0; r < 16; ++r) { const int sj = selb[r]; const int pos = sj * 64 + lane, dist = t - pos;
                const float sc = (sj >= 0 && dist >= 0) ? dot64(qv, ksel + (size_t)pos * 64) + rel_bias[t5_bucket(dist) * 16 + hq] : -INFINITY; pbuf[r * 64 + lane] = sc; mx = fmaxf(mx, sc); }
            mx = wave_max(mx); float sum = 0.f;
#pragma unroll 1
            for (int r = 0; r < 16; ++r) { const float sc = pbuf[r * 64 + lane]; const float e = sc == -INFINITY ? 0.f : expf(sc - mx); pbuf[r * 64 + lane] = e; sum += e; }
            sum = wave_sum(sum); const float inv = 1.0f / sum;
            LDS_WAIT(); asm volatile("" ::: "memory");
            float a = 0.f;
#pragma unroll 1
            for (int r = 0; r < 16; ++r) { const int sj = selb[r]; if (sj < 0) continue; const bf16* vb = vsel + (size_t)sj * 64 * 64 + lane;
                for (int kk = 0; kk < 64; ++kk) a += pbuf[r * 64 + kk] * bf2f(vb[kk * 64]); }
            obuf[256 + g * 64 + lane] = a * inv;
            LDS_WAIT(); asm volatile("" ::: "memory");
            mx = -INFINITY;
#pragma unroll 1
            for (int i = 0; i < 8; ++i) { const int kk = lane + 64 * i, pos = t - 511 + kk;
                const float sc = pos >= 0 ? dot64(qv, kwin + (size_t)pos * 64) + rel_bias[t5_bucket(511 - kk) * 16 + hq] : -INFINITY; pbuf[kk] = sc; mx = fmaxf(mx, sc); }
            mx = wave_max(mx); sum = 0.f;
#pragma unroll 1
            for (int i = 0; i < 8; ++i) { const int kk = lane + 64 * i; const float sc = pbuf[kk]; const float e = sc == -INFINITY ? 0.f : expf(sc - mx); pbuf[kk] = e; sum += e; }
            sum = wave_sum(sum); const float inv2 = 1.0f / sum;
            LDS_WAIT(); asm volatile("" ::: "memory");
            a = 0.f;
            for (int kk = (t >= 511 ? 0 : 511 - t); kk < 512; ++kk) a += pbuf[kk] * bf2f(vwin[(size_t)(t - 511 + kk) * 64 + lane]);
            obuf[512 + g * 64 + lane] = a * inv2;
            LDS_WAIT(); asm volatile("" ::: "memory");
        }
        const float* gr = gates + (size_t)(b * T + t) * 64 + hkv * 4;
#pragma unroll
        for (int g = 0; g < 4; ++g) { const float v = gr[g] * obuf[g * 64 + lane] + gr[16 + g] * obuf[256 + g * 64 + lane] + gr[32 + g] * obuf[512 + g * 64 + lane]; (WSP(bf16, out_off) + (size_t)(b * T + t) * D + hkv * 256)[g * 64 + lane] = (bf16)f2bf(v); }
        LDS_WAIT(); asm volatile("" ::: "memory");
    }
}

constexpr int NSA_KP = 144, NSA_VP = 192;
constexpr int NSA_KBUF = 64 * NSA_KP, NSA_VBUF = 64 * NSA_VP, NSA_BUF = NSA_KBUF + NSA_VBUF;
constexpr int NSA_OFF_IMP = 2 * NSA_BUF;
constexpr int NSA_OFF_BIAS = 126976;
constexpr int NSA_OFF_SEL = NSA_OFF_BIAS + 4 * 128 * 4;
constexpr int NSA_OFF_T1 = NSA_OFF_SEL + 64 * 16;
static_assert(NSA_OFF_IMP + 64 * 128 * 4 <= NSA_OFF_BIAS && NSA_OFF_T1 + 4 * 256 * 4 <= LDSCTL_OFF, "NSA LDS map");
constexpr float NSA_L2E = 1.4426950408889634f;
struct NsaState { f32x16 O0, O1; float m, l; };
__device__ __forceinline__ void nsa_reset(NsaState& s) {
#pragma unroll
    for (int r = 0; r < 16; ++r) { s.O0[r] = 0.f; s.O1[r] = 0.f; }
    s.m = -INFINITY; s.l = 0.f;
}
template <bool NEAR, int MASK, int PASS, bool TB = false, bool KPF = false>
__device__ __forceinline__ void nsa_step_r(NsaState& st, bf16x8 (&Kc)[8], const bf16x8 (&Vc)[8], const LAS unsigned char* Qrow  , int lane, float cbias2, int dbase, int dstep,
                                         const LAS float* biasg, float minv  , float linv  , float (&gs)[8], float (&lastv)[8], const char* knext = nullptr) {
    const int hh = lane >> 5;
    bf16x8 Qf[4];
#pragma unroll
    for (int ks = 0; ks < 4; ++ks) Qf[ks] = *(const LAS bf16x8*)(Qrow + 32 * ks);
    f32x16 S[2];
#pragma unroll
    for (int tl = 0; tl < 2; ++tl) {
#pragma unroll
        for (int r = 0; r < 16; ++r) S[tl][r] = 0.f;
#pragma unroll
        for (int ks = 0; ks < 4; ++ks) S[tl] = __builtin_amdgcn_mfma_f32_32x32x16_bf16(Kc[tl * 4 + ks], Qf[ks], S[tl], 0, 0, 0);
    }
    if (KPF) { const unsigned vo_ = (unsigned)lane * 16u;
#pragma unroll
        for (int f_ = 0; f_ < 8; ++f_) Kc[f_] = *(const bf16x8*)(knext + (vo_ + (unsigned)f_ * 1024u)); }
    { asm volatile("" : "+v"(dbase)); }
    float mx = -INFINITY, mx2 = -INFINITY; constexpr bool PLAIN = !NEAR && MASK == 0;
    if (PLAIN) {
        float m0 = fmaxf(S[0][0], S[1][0]), m1 = fmaxf(S[0][1], S[1][1]);
#pragma unroll
        for (int r = 2; r < 16; r += 2) { m0 = fmaxf(m0, fmaxf(S[0][r], S[1][r])); m1 = fmaxf(m1, fmaxf(S[0][r + 1], S[1][r + 1])); }
        mx = fmaxf(m0, m1) * NSA_L2E + cbias2;
    } else if (TB) {
        const LAS float* tb = biasg + (dbase + 1 - 4 * hh);
#pragma unroll
        for (int tl = 0; tl < 2; ++tl) {
            if (tl == 1) asm volatile("" ::: "memory");
#pragma unroll
            for (int r = 0; r < 16; ++r) { const float v = __builtin_fmaf(S[tl][r], NSA_L2E, tb[63 - (32 * tl + (r & 3) + 8 * (r >> 2))]); S[tl][r] = v; if (r & 1) mx = fmaxf(mx, v); else mx2 = fmaxf(mx2, v); }
        }
        mx = fmaxf(mx, mx2);
    } else {
#pragma unroll
    for (int tl = 0; tl < 2; ++tl) {
        if (NEAR && tl == 1) asm volatile("" ::: "memory");
#pragma unroll
        for (int r = 0; r < 16; ++r) {
            float v;
            if (NEAR) { const int key = 32 * tl + (r & 3) + 8 * (r >> 2) + 4 * hh; const int dist = dbase - dstep * key; int idx = dist < 0 ? 0 : dist; idx = idx > 127 ? 127 : idx;
                v = (S[tl][r] + biasg[idx]) * NSA_L2E + cbias2;
                bool ok = true; if (MASK == 1 || MASK == 3) ok = dist >= 0; if (MASK == 2) ok = dist >= 0 && dist < 512;
                v = ok ? v : -INFINITY;
            } else {
                v = S[tl][r] * NSA_L2E + cbias2;
                if (MASK == 2) { const int key = 32 * tl + (r & 3) + 8 * (r >> 2) + 4 * hh; const int dist = dbase - dstep * key; v = (dist >= 0 && dist < 512) ? v : -INFINITY; }
            }
            S[tl][r] = v; mx = fmaxf(mx, v);
        }
    }
    }
    if (PASS == 2) {
        { auto rr = __builtin_amdgcn_permlane32_swap(__float_as_uint(mx), __float_as_uint(mx), false, false); mx = fmaxf(__uint_as_float(rr[0]), __uint_as_float(rr[1])); }
        st.m = fmaxf(st.m, mx);
    } else if (PASS == 0) {
        { auto rr = __builtin_amdgcn_permlane32_swap(__float_as_uint(mx), __float_as_uint(mx), false, false); mx = fmaxf(__uint_as_float(rr[0]), __uint_as_float(rr[1])); }
        const float mn = fmaxf(st.m, mx), mref = mn == -INFINITY ? 0.f : mn;
        if (__any(mn != st.m)) {
            const float alpha = __builtin_amdgcn_exp2f(st.m - mref);
#pragma unroll
            for (int r = 0; r < 16; ++r) { st.O0[r] *= alpha; st.O1[r] *= alpha; }
            st.l *= alpha; st.m = mn;
        }
        float ls = 0.f;
        if (PLAIN) { const float off = cbias2 - mref;
#pragma unroll
            for (int tl = 0; tl < 2; ++tl)
#pragma unroll
                for (int r = 0; r < 16; ++r) { const float p = __builtin_amdgcn_exp2f(__builtin_fmaf(S[tl][r], NSA_L2E, off)); S[tl][r] = p; ls += p; }
        } else {
#pragma unroll
        for (int tl = 0; tl < 2; ++tl)
#pragma unroll
            for (int r = 0; r < 16; ++r) { const float p = __builtin_amdgcn_exp2f(S[tl][r] - mref); S[tl][r] = p; ls += p; }
        }
        st.l += ls;
#pragma unroll
        for (int tl = 0; tl < 2; ++tl)
#pragma unroll
            for (int s = 0; s < 2; ++s) { u32x4_t w; w.x = pkbf(S[tl][8 * s + 0], S[tl][8 * s + 1]); w.y = pkbf(S[tl][8 * s + 2], S[tl][8 * s + 3]); w.z = pkbf(S[tl][8 * s + 4], S[tl][8 * s + 5]); w.w = pkbf(S[tl][8 * s + 6], S[tl][8 * s + 7]);
                const bf16x8 P = __builtin_bit_cast(bf16x8, w);
                st.O0 = __builtin_amdgcn_mfma_f32_32x32x16_bf16(Vc[2 * tl + s], P, st.O0, 0, 0, 0);
                st.O1 = __builtin_amdgcn_mfma_f32_32x32x16_bf16(Vc[4 + 2 * tl + s], P, st.O1, 0, 0, 0); }
    } else {
        const float mref = minv == -INFINITY ? 0.f : minv;
        if (PLAIN) {
#pragma unroll
            for (int tl = 0; tl < 2; ++tl)
#pragma unroll
                for (int r = 0; r < 16; ++r) S[tl][r] = __builtin_fmaf(S[tl][r], NSA_L2E, cbias2);
        }
#pragma unroll
        for (int tl = 0; tl < 2; ++tl)
#pragma unroll
            for (int rg = 0; rg < 4; ++rg) { const float p0 = __builtin_amdgcn_exp2f(S[tl][4 * rg + 0] - mref) * linv, p1 = __builtin_amdgcn_exp2f(S[tl][4 * rg + 1] - mref) * linv,
                                                         p2 = __builtin_amdgcn_exp2f(S[tl][4 * rg + 2] - mref) * linv, p3 = __builtin_amdgcn_exp2f(S[tl][4 * rg + 3] - mref) * linv;
                gs[4 * tl + rg] = (p0 + p1) + (p2 + p3); lastv[4 * tl + rg] = p3; }
    }
}
#define NSA_BAR() do { asm volatile("s_waitcnt lgkmcnt(0)" ::: "memory"); __builtin_amdgcn_s_barrier(); asm volatile("" ::: "memory"); } while (0)

__device__ __forceinline__ void nsa_relayout(Frame& F) {
    ArgsP ap = kargs();
    LAS unsigned char* vt = F.lds + RING_OFF + F.wave * 16384 + 2048;
    const int gw = F.vcu * NWAVES + F.wave, NGW = F.G * NWAVES, lane = F.lane, hh = lane >> 5;
    const bf16* KV = WSP(bf16, WS_KV1); bf16* KF = WSP(bf16, WS_KSELF); bf16* VF = WSP(bf16, WS_VSELF);
    const LAS unsigned char* vrd = vt + (4 * hh + ((lane & 15) >> 2)) * 192 + (16 * ((lane >> 4) & 1) + 4 * (lane & 3)) * 2;
    for (int it = gw; it < 2 * 8 * 128; it += NGW) {
        const int pair = it >> 10, bh = (it >> 7) & 7, j = it & 127;
        const bf16* ks = KV + (size_t)(2 + 2 * pair) * KVSZ + ((size_t)bh * T + 64 * j) * HD; const bf16* vs = ks + KVSZ;
        bf16* kf = (pair ? WSP(bf16, WS_KWINF) : KF) + (size_t)(bh * 128 + j) * 4096; bf16* vf = (pair ? WSP(bf16, WS_VWINF) : VF) + (size_t)(bh * 128 + j) * 4096;
        u32x4_t kv_[8], vv_[8];
#pragma unroll
        for (int f = 0; f < 8; ++f) { kv_[f] = *(const u32x4_t*)(ks + (32 * (f >> 2) + (lane & 31)) * HD + 16 * (f & 3) + 8 * hh); const int id = lane + 64 * f; vv_[f] = *(const u32x4_t*)(vs + (id >> 3) * HD + (id & 7) * 8); }
#pragma unroll
        for (int f = 0; f < 8; ++f) { *(u32x4_t*)(kf + (f * 64 + lane) * 8) = kv_[f]; const int id = lane + 64 * f; *(LAS u32x4_t*)(vt + (id >> 3) * 192 + (id & 7) * 16) = vv_[f]; }
        LDS_WAIT(); asm volatile("" ::: "memory");
#pragma unroll
        for (int f = 0; f < 8; ++f) { const int dt = f >> 2, k4 = f & 3; const LAS unsigned char* p = vrd + dt * 64 + 16 * k4 * 192; const bf16x8 fr = tr_pair(p, p + 8 * 192); *(bf16x8*)(vf + (f * 64 + lane) * 8) = fr; }
        LDS_WAIT(); asm volatile("" ::: "memory");
    }
}
constexpr int SC_OACC = 0;
constexpr int SC_M = 66560, SC_L = SC_M + 1024;
constexpr int SC_QS = 75776;
constexpr float SC_SHIFT = 10.0f, SC_LSMAX = 262144.0f;
constexpr int SC_FLAG = SC_L + 1024;
constexpr int SC_LIST = SC_QS + 256 * 144;
constexpr int SC_CAP = 136;
static_assert(SC_LIST + 8 * SC_CAP * 12 <= NSA_OFF_BIAS, "selected-branch LDS map");
__device__ __forceinline__ unsigned f2ord(float f) { const unsigned u = __float_as_uint(f); return (u & 0x80000000u) ? ~u : (u | 0x80000000u); }
__device__ __forceinline__ float ord2f(unsigned u) { return u == 0u ? -INFINITY : ((u & 0x80000000u) ? __uint_as_float(u & 0x7fffffffu) : __uint_as_float(~u)); }
template <int PB> __device__ __forceinline__ void sc_item(LAS unsigned char* L, const bf16x8 (&Kc)[8], const bf16x8 (&Vc)[8], const bf16x8 (&Qg)[4], int lane, int col, bool valid, int tcol, int j, int qb, float b31, const LAS float* biasg) {
    const int hh = lane >> 5;
    f32x16 S[2];
#pragma unroll
    for (int tl = 0; tl < 2; ++tl) {
#pragma unroll
        for (int r = 0; r < 16; ++r) S[tl][r] = 0.f;
#pragma unroll
        for (int ks = 0; ks < 4; ++ks) S[tl] = __builtin_amdgcn_mfma_f32_32x32x16_bf16(Kc[tl * 4 + ks], Qg[ks], S[tl], 0, 0, 0);
    }
    LAS unsigned* Mx = (LAS unsigned*)(L + SC_M); LAS int* Ls = (LAS int*)(L + SC_L); LAS int* Oa = (LAS int*)(L + SC_OACC);
    const bool nearb = j >= qb - 2;
    float mx = -INFINITY; const float cb = valid ? b31 : -INFINITY;
    if (nearb) {
        int dbase = tcol - 64 * j; asm volatile("" : "+v"(dbase));
#pragma unroll
        for (int tl = 0; tl < 2; ++tl)
#pragma unroll
            for (int r = 0; r < 16; ++r) { const int key = 32 * tl + (r & 3) + 8 * (r >> 2) + 4 * hh; const int dist = dbase - key; int idx = dist < 0 ? 0 : dist; idx = idx > 127 ? 127 : idx;
                float v = (S[tl][r] + biasg[idx]) * NSA_L2E; v = (dist >= 0 && valid) ? v : -INFINITY; S[tl][r] = v; mx = fmaxf(mx, v); }
    } else if (PB == 0) {
        float m0 = fmaxf(S[0][0], S[1][0]), m1 = fmaxf(S[0][1], S[1][1]);
#pragma unroll
        for (int r = 2; r < 16; r += 2) { m0 = fmaxf(m0, fmaxf(S[0][r], S[1][r])); m1 = fmaxf(m1, fmaxf(S[0][r + 1], S[1][r + 1])); }
        mx = __builtin_fmaf(fmaxf(m0, m1), NSA_L2E, cb);
    }
    if (PB == 0) {
        { auto rr = __builtin_amdgcn_permlane32_swap(__float_as_uint(mx), __float_as_uint(mx), false, false); mx = fmaxf(__uint_as_float(rr[0]), __uint_as_float(rr[1])); }
        if (valid && hh == 0) __hip_atomic_fetch_max(Mx + col, f2ord(mx), __ATOMIC_RELAXED, __HIP_MEMORY_SCOPE_WORKGROUP);
    } else {
        const float mref = (valid ? ord2f(Mx[col]) : 0.f) - SC_SHIFT;
        float ls = 0.f;
        if (nearb) {
#pragma unroll
            for (int tl = 0; tl < 2; ++tl)
#pragma unroll
                for (int r = 0; r < 16; ++r) { const float p = __builtin_amdgcn_exp2f(S[tl][r] - mref); S[tl][r] = p; ls += p; }
        } else { const float off = cb - mref;
#pragma unroll
            for (int tl = 0; tl < 2; ++tl)
#pragma unroll
                for (int r = 0; r < 16; ++r) { const float p = __builtin_amdgcn_exp2f(__builtin_fmaf(S[tl][r], NSA_L2E, off)); S[tl][r] = p; ls += p; }
        }
        { auto rr = __builtin_amdgcn_permlane32_swap(__float_as_uint(ls), __float_as_uint(ls), false, false); ls = __uint_as_float(rr[0]) + __uint_as_float(rr[1]); }
        if (valid && hh == 0) __hip_atomic_fetch_add(Ls + col, (int)ls, __ATOMIC_RELAXED, __HIP_MEMORY_SCOPE_WORKGROUP);
        if (valid && ls > SC_LSMAX) *(volatile LAS unsigned*)(L + SC_FLAG) = 1u;
        bf16x8 P[4];
#pragma unroll
        for (int k4 = 0; k4 < 4; ++k4) { const int tl = k4 >> 1, s8 = 8 * (k4 & 1); u32x4_t w; w.x = pkbf(S[tl][s8 + 0], S[tl][s8 + 1]); w.y = pkbf(S[tl][s8 + 2], S[tl][s8 + 3]); w.z = pkbf(S[tl][s8 + 4], S[tl][s8 + 5]); w.w = pkbf(S[tl][s8 + 6], S[tl][s8 + 7]); P[k4] = __builtin_bit_cast(bf16x8, w); }
        f32x16 O0, O1;
#pragma unroll
        for (int r = 0; r < 16; ++r) { O0[r] = 0.f; O1[r] = 0.f; }
#pragma unroll
        for (int k4 = 0; k4 < 4; ++k4) { O0 = __builtin_amdgcn_mfma_f32_32x32x16_bf16(Vc[k4], P[k4], O0, 0, 0, 0); O1 = __builtin_amdgcn_mfma_f32_32x32x16_bf16(Vc[4 + k4], P[k4], O1, 0, 0, 0); }
        if (valid) { LAS int* o = Oa + col * 65 + 4 * hh;
#pragma unroll
            for (int r = 0; r < 16; ++r) __hip_atomic_fetch_add(o + (r & 3) + 8 * (r >> 2), (int)O0[r], __ATOMIC_RELAXED, __HIP_MEMORY_SCOPE_WORKGROUP);
#pragma unroll
            for (int r = 0; r < 16; ++r) __hip_atomic_fetch_add(o + 32 + (r & 3) + 8 * (r >> 2), (int)O1[r], __ATOMIC_RELAXED, __HIP_MEMORY_SCOPE_WORKGROUP); }
    }
}
__device__ __forceinline__ int sc_build(LAS unsigned char* L, int lane, int w, int qb, unsigned ws0, unsigned ws1, unsigned ws2, unsigned ws3) {
    LAS int* il = (LAS int*)(L + SC_LIST) + w * SC_CAP; LAS unsigned char* iq = L + SC_LIST + 8 * SC_CAP * 4 + w * SC_CAP * 8; int n = 0;
#pragma unroll 1
    for (int j = w; j <= qb; j += 8) {
        if (j == 0 || j >= qb - 1) continue;
        const unsigned wsel = j < 32 ? ws0 : j < 64 ? ws1 : j < 96 ? ws2 : ws3; const bool bit = (wsel >> (j & 31)) & 1u; const unsigned long long mask = __ballot(bit); const int cnt = __popcll(mask);
        const int ntl = (cnt + 7) >> 3; if (ntl == 0) continue;
        const int rank = __popcll(mask & ((1ull << lane) - 1ull));
        if (bit) iq[n * 8 + rank] = (unsigned char)lane;
        if (lane < 8 * ntl - cnt) iq[n * 8 + cnt + lane] = 0xFF;
        if (lane < ntl) il[n + lane] = j;
        n += ntl;
    }
    asm volatile("s_waitcnt lgkmcnt(0)" ::: "memory");
    return n;
}
template <int PB> __device__ __forceinline__ void sc_pass(LAS unsigned char* L, const bf16* KF, const bf16* VF, int lane, int w, int qb, int nitems, float b31, const LAS float* biasg) {
    const int c = lane & 31, hh = lane >> 5;
    const LAS int* il = (const LAS int*)(L + SC_LIST) + w * SC_CAP; const LAS unsigned char* iq = L + SC_LIST + 8 * SC_CAP * 4 + w * SC_CAP * 8; const LAS unsigned char* Qs = L + SC_QS;
    bf16x8 Kc[8], Vc[8], Kn[8], Vn[8];
    int it = __builtin_amdgcn_readfirstlane(il[0]);
    { const int j0 = it & 255;
#pragma unroll
      for (int f = 0; f < 8; ++f) { Kc[f] = *(const bf16x8*)((const char*)KF + (size_t)j0 * 8192 + ((unsigned)lane * 16u + (unsigned)f * 1024u)); if (PB == 1) Vc[f] = *(const bf16x8*)((const char*)VF + (size_t)j0 * 8192 + ((unsigned)lane * 16u + (unsigned)f * 1024u)); } }
#pragma unroll 1
    for (int i = 0; i < nitems; ++i) {
        const int inx = __builtin_amdgcn_readfirstlane(il[i + 1 < nitems ? i + 1 : i]);
        const int j = it & 255, jn = inx & 255;
        const int qraw = iq[i * 8 + (c >> 2)];
        const bool ld = jn != j;
        if (ld) {
#pragma unroll
            for (int f = 0; f < 8; ++f) Kn[f] = *(const bf16x8*)((const char*)KF + (size_t)jn * 8192 + ((unsigned)lane * 16u + (unsigned)f * 1024u)); }
        const bool valid = qraw != 0xFF; const int q = valid ? qraw : 0; const int col = 4 * q + (c & 3), tcol = 64 * qb + q;
        bf16x8 Qg[4];
#pragma unroll
        for (int ks = 0; ks < 4; ++ks) Qg[ks] = *(const LAS bf16x8*)(Qs + col * 144 + (16 * ks + 8 * hh) * 2);
        if (PB == 1 && ld) {
#pragma unroll
            for (int f = 0; f < 8; ++f) Vn[f] = *(const bf16x8*)((const char*)VF + (size_t)jn * 8192 + ((unsigned)lane * 16u + (unsigned)f * 1024u)); }
        sc_item<PB>(L, Kc, Vc, Qg, lane, col, valid, tcol, j, qb, b31, biasg);
        if (ld) {
#pragma unroll
            for (int f = 0; f < 8; ++f) { Kc[f] = Kn[f]; if (PB == 1) Vc[f] = Vn[f]; } }
        it = inx;
    }
}
template <int VAR = 0> __device__ __forceinline__ void nsa_mfma(Frame& F, size_t out_off = WS_QO) {
    ArgsP ap = kargs();
    LAS unsigned char* L = F.lds + RING_OFF;
    LAS float* impL = (LAS float*)(L + NSA_OFF_IMP); LAS float* biasL = (LAS float*)(L + NSA_OFF_BIAS); LAS unsigned* selL = (LAS unsigned*)(L + NSA_OFF_SEL);
    const int tid_outer = F.tid, w = F.wave;
    const float* rel_bias = ap->in[2];
    const int bh = F.vcu >> 5, b = bh >> 2, hkv = bh & 3, ui = F.vcu & 31;
    if (F.G != 256) return;
    { const int gg = tid_outer >> 7, dd = tid_outer & 127; biasL[gg * 128 + dd] = rel_bias[t5_bucket(dd) * 16 + hkv * 4 + gg];
      LAS float* T1 = (LAS float*)(L + NSA_OFF_T1);
#pragma unroll
      for (int e = 0; e < 2; ++e) { const int x = (tid_outer & 127) + 128 * e, dist = x - 64; T1[gg * 256 + x] = dist < 0 ? -INFINITY : rel_bias[t5_bucket(dist) * 16 + hkv * 4 + gg] * NSA_L2E; } }
#define NSA_PTRS_C() ArgsP ap2 = kargs(); const bf16* kc = (const bf16*)(ap2->ws + WS_KCVC) + (size_t)bh * 512 * 64; const bf16* vc = kc + (size_t)4096 * 64
#define NSA_PTRS_KV(kname, vname, idx) ArgsP ap3 = kargs(); const bf16* kname = (const bf16*)(ap3->ws + WS_KV1) + (size_t)(idx) * KVSZ + (size_t)bh * T * HD; const bf16* vname = kname + KVSZ
#define NSA_PARK_ADD() do { _Pragma("unroll") for (int s_ = 0; s_ < 2; ++s_) _Pragma("unroll") for (int r8 = 0; r8 < 2; ++r8) { const u32x4_t a_ = ((const u32x4_t*)park)[4 * s_ + r8], b_ = ((const u32x4_t*)park)[4 * s_ + 2 + r8]; const unsigned* ap_ = (const unsigned*)&a_; const unsigned* bp_ = (const unsigned*)&b_; \
        _Pragma("unroll") for (int e = 0; e < 4; ++e) { st.O0[8 * r8 + 2 * e] += bflo(ap_[e]); st.O0[8 * r8 + 2 * e + 1] += bfhi(ap_[e]); st.O1[8 * r8 + 2 * e] += bflo(bp_[e]); st.O1[8 * r8 + 2 * e + 1] += bfhi(bp_[e]); } } } while (0)
#define NSA_LSUM(dst, src) do { auto rr_ = __builtin_amdgcn_permlane32_swap(__float_as_uint(src), __float_as_uint(src), false, false); dst = __uint_as_float(rr_[0]) + __uint_as_float(rr_[1]); } while (0)
    NSA_BAR();
    float gs[8], lastv[8];
#pragma unroll 1
    for (int un = 0; un < 4; ++un) {
        int tid = tid_outer; asm volatile("" : "+v"(tid)); const int lane = tid & 63, c = lane & 31, hh = lane >> 5, g = c & 3, hq = hkv * 4 + g;
        const float b31 = kargs()->in[2][31 * 16 + hq] * NSA_L2E; const LAS float* biasg = biasL + g * 128; const LAS float* t1g = (const LAS float*)(L + NSA_OFF_T1) + g * 256;
        const int qb = un == 0 ? ui : un == 1 ? 63 - ui : un == 2 ? 64 + ui : 127 - ui;
        const int ql = 8 * w + (c >> 2), t = 64 * qb + ql;
        bf16* qrow; float gate_c, gate_s, gate_w; float* park;
        { ArgsP ap1 = kargs(); qrow = (bf16*)(ap1->ws + WS_QO) + (size_t)(b * T + t) * D + hq * HD; const float* gr = (const float*)(ap1->ws + WS_GATES) + (size_t)(b * T + t) * 64 + hq; gate_c = gr[0]; gate_s = gr[16]; gate_w = gr[32];
          park = (float*)(ap1->ws + WS_PARKG) + ((size_t)blockIdx.x * 512 + tid) * 32; }
        const LAS unsigned char* Qrow = L + SC_QS + (32 * w + c) * 144 + 16 * hh;
        {
#pragma unroll
          for (int ks = 0; ks < 4; ++ks) *(LAS bf16x8*)(L + SC_QS + (32 * w + c) * 144 + (16 * ks + 8 * hh) * 2) = *(const bf16x8*)(qrow + 16 * ks + 8 * hh); }
        asm volatile("s_waitcnt lgkmcnt(0)" ::: "memory");
        NsaState st;
#define NSA_LDK(dst, base, blk) do { const char* bb_ = (const char*)(base) + (size_t)(blk) * 8192; const unsigned vo_ = (unsigned)lane * 16u;   \
        _Pragma("unroll") for (int f_ = 0; f_ < 8; ++f_) dst[f_] = *(const bf16x8*)(bb_ + (vo_ + (unsigned)f_ * 1024u)); } while (0)
        nsa_reset(st);
        const int jb0 = qb >= 8 ? qb - 8 : 0;
        if (!(VAR & 4)) {
            ArgsP ap3 = kargs(); const bf16* KFw = (const bf16*)(ap3->ws + WS_KWINF) + (size_t)bh * 128 * 4096; const bf16* VFw = (const bf16*)(ap3->ws + WS_VWINF) + (size_t)bh * 128 * 4096;
            bf16x8 Kc[8];
            NSA_LDK(Kc, KFw, jb0);
#pragma unroll 1
            for (int jb = jb0; jb <= qb; ++jb) {
                bf16x8 Vc[8];
                NSA_LDK(Vc, VFw, jb);
                const char* kn = (const char*)KFw + (size_t)(jb + 1) * 8192;
                if (jb >= qb - 2) { if (jb > jb0 && jb > qb - 2) NSA_LDK(Kc, KFw, jb);
                    nsa_step_r<true, 1, 0, true>(st, Kc, Vc, Qrow, lane, 0.f, t - 64 * jb, 1, t1g, 0.f, 0.f, gs, lastv); }
                else if (jb == qb - 8) nsa_step_r<false, 2, 0>(st, Kc, Vc, Qrow, lane, b31, t - 64 * jb, 1, biasg, 0.f, 0.f, gs, lastv);
                else { if (jb > jb0 && jb == qb - 7) NSA_LDK(Kc, KFw, jb);
                    nsa_step_r<false, 0, 0, false, true>(st, Kc, Vc, Qrow, lane, b31, 0, 0, biasg, 0.f, 0.f, gs, lastv, kn); }
            }
        }
        { float ltot; NSA_LSUM(ltot, st.l); const float sc = ltot > 0.f ? gate_w / ltot : 0.f;
#pragma unroll
          for (int r8 = 0; r8 < 2; ++r8) { u32x4_t a, b2; unsigned* ap_ = (unsigned*)&a; unsigned* bp_ = (unsigned*)&b2; for (int e = 0; e < 4; ++e) { ap_[e] = pkbf(sc * st.O0[8 * r8 + 2 * e], sc * st.O0[8 * r8 + 2 * e + 1]); bp_[e] = pkbf(sc * st.O1[8 * r8 + 2 * e], sc * st.O1[8 * r8 + 2 * e + 1]); } ((u32x4_t*)park)[r8] = a; ((u32x4_t*)park)[2 + r8] = b2; } }
        const int nbc = (VAR & 1) ? 0 : (4 * qb + 3 + 63) >> 6;
        const int dbc = t - 31;
        nsa_reset(st);
        const bf16* KFc; const bf16* VFc; { ArgsP ap2 = kargs(); KFc = (const bf16*)(ap2->ws + WS_KCF) + (size_t)bh * 8 * 4096; VFc = (const bf16*)(ap2->ws + WS_VCF) + (size_t)bh * 8 * 4096; }
        {
#pragma unroll 1
            for (int i = 0; i < nbc; ++i) {
                bf16x8 Kc[8], Vc[8];
                NSA_LDK(Kc, KFc, i); NSA_LDK(Vc, VFc, i);
                const bool near_ = 64 * i + 63 >= 4 * qb - 8;
                if (near_) nsa_step_r<true, 3, 0>(st, Kc, Vc, Qrow, lane, 0.f, dbc - 16 * 64 * i, 16, biasg, 0.f, 0.f, gs, lastv);
                else nsa_step_r<false, 0, 0>(st, Kc, Vc, Qrow, lane, b31, 0, 0, biasg, 0.f, 0.f, gs, lastv);
            }
        }
        const float mfin = st.m; float lfin; NSA_LSUM(lfin, st.l);
        { const float inv = lfin > 0.f ? 1.0f / lfin : 0.f; const float sc = gate_c * inv;
#pragma unroll
          for (int r8 = 0; r8 < 2; ++r8) { u32x4_t a, b2; unsigned* ap_ = (unsigned*)&a; unsigned* bp_ = (unsigned*)&b2; for (int e = 0; e < 4; ++e) { ap_[e] = pkbf(sc * st.O0[8 * r8 + 2 * e], sc * st.O0[8 * r8 + 2 * e + 1]); bp_[e] = pkbf(sc * st.O1[8 * r8 + 2 * e], sc * st.O1[8 * r8 + 2 * e + 1]); } ((u32x4_t*)park)[4 + r8] = a; ((u32x4_t*)park)[6 + r8] = b2; } }
        if (nbc > 0) {
            const float linv = lfin > 0.f ? 1.0f / lfin : 0.f; float carry_last = 0.f;
#pragma unroll 1
            for (int i = 0; i < nbc; ++i) {
                bf16x8 Kc[8];
                NSA_LDK(Kc, KFc, i);
                const bool near_ = 64 * i + 63 >= 4 * qb - 8;
                if (near_) nsa_step_r<true, 3, 1>(st, Kc, Kc, Qrow, lane, 0.f, dbc - 16 * 64 * i, 16, biasg, mfin, linv, gs, lastv);
                else nsa_step_r<false, 0, 1>(st, Kc, Kc, Qrow, lane, b31, 0, 0, biasg, mfin, linv, gs, lastv);
                float plp = carry_last;
#pragma unroll
                for (int k8 = 0; k8 < 8; ++k8) {
                    const float pl = swap32(lastv[k8]);
                    const float prev = hh ? pl : plp;
                    float v = gs[k8] + prev;
                    v += dpp_xor1(v); v += dpp_xor2(v);
                    if (g == 0) impL[ql * 128 + 16 * i + 2 * k8 + hh] = v;
                    plp = pl;
                }
                carry_last = plp;
            }
        }
        asm volatile("s_waitcnt lgkmcnt(0)" ::: "memory");
#pragma unroll 1
        for (int qi = 0; qi < ((VAR & 8) ? 0 : 8); qi += 4) {
            unsigned k0[4], k1[4];
#pragma unroll
            for (int u = 0; u < 4; ++u) { const int q2 = 8 * w + qi + u; const int ja = lane, jb_ = lane + 64;
                const bool fa = (ja == 0) || (ja == qb) || (ja == qb - 1), fb = (jb_ == qb) || (jb_ == qb - 1);
                const float i0 = ja <= qb ? impL[q2 * 128 + ja] : 0.f, i1 = jb_ <= qb ? impL[q2 * 128 + jb_] : 0.f;
                k0[u] = ja <= qb ? __float_as_uint(fa ? 100.0f : i0) + 1u : 0u; k1[u] = jb_ <= qb ? __float_as_uint(fb ? 100.0f : i1) + 1u : 0u; }
            unsigned pf[4] = {0u, 0u, 0u, 0u};
            if (qb >= 16) {
                int exact = 0;
#pragma unroll 1
                for (int bit = 30; bit >= 0 && exact != 15; --bit) {
#pragma unroll
                    for (int u = 0; u < 4; ++u) { const unsigned cand = pf[u] | (1u << bit); const int n = __popcll(__ballot(k0[u] >= cand)) + __popcll(__ballot(k1[u] >= cand)); pf[u] = n >= 16 ? cand : pf[u]; exact |= (n == 16) ? (1 << u) : 0; }
                }
            } else { pf[0] = pf[1] = pf[2] = pf[3] = 1u; }
#pragma unroll
            for (int u = 0; u < 4; ++u) {
                unsigned long long g0 = __ballot(k0[u] > pf[u]), g1 = __ballot(k1[u] > pf[u]), t0 = __ballot(k0[u] == pf[u]), t1 = __ballot(k1[u] == pf[u]);
                int need = 16 - (__popcll(g0) + __popcll(g1));
                if (qb < 16) { g0 |= t0; g1 |= t1; need = 0; }
#pragma unroll 1
                while (need > 0 && (t0 | t1)) { if (t0) { const unsigned long long lb = t0 & (0ull - t0); g0 |= lb; t0 ^= lb; } else { const unsigned long long lb = t1 & (0ull - t1); g1 |= lb; t1 ^= lb; } --need; }
                if (lane == 0) { const int q2 = 8 * w + qi + u; selL[q2 * 4 + 0] = (unsigned)g0; selL[q2 * 4 + 1] = (unsigned)(g0 >> 32); selL[q2 * 4 + 2] = (unsigned)g1; selL[q2 * 4 + 3] = (unsigned)(g1 >> 32); }
            }
        }
        NSA_BAR();
        if (!(VAR & 2)) {
            { LAS float* Oa = (LAS float*)(L + SC_OACC) + (32 * w + c) * 65 + 32 * hh;
#pragma unroll
              for (int i = 0; i < 32; ++i) Oa[i] = 0.f;
              if (hh == 0) { ((LAS unsigned*)(L + SC_M))[32 * w + c] = 0u; ((LAS float*)(L + SC_L))[32 * w + c] = 0.f; }
              if (tid == 0) *(volatile LAS unsigned*)(L + SC_FLAG) = 0u;
            }
            const unsigned ws0 = selL[lane * 4 + 0], ws1 = selL[lane * 4 + 1], ws2 = selL[lane * 4 + 2], ws3 = selL[lane * 4 + 3];
            NSA_BAR();
            ArgsP ap4 = kargs(); const bf16* KFb = (const bf16*)(ap4->ws + WS_KSELF) + (size_t)bh * 128 * 4096; const bf16* VFb = (const bf16*)(ap4->ws + WS_VSELF) + (size_t)bh * 128 * 4096;
            const int nitems = sc_build(L, lane, w, qb, ws0, ws1, ws2, ws3);
#define NSA_FORCED(PASSNO) do { _Pragma("unroll 1") for (int fi = 0; fi < 3; ++fi) { const int j = fi == 0 ? qb : fi == 1 ? qb - 1 : 0; if (j < 0 || (fi == 2 && qb <= 1)) continue; \
                bf16x8 Kc[8], Vc[8]; NSA_LDK(Kc, KFb, j); if (PASSNO == 0) NSA_LDK(Vc, VFb, j); \
                if (j >= qb - 2) nsa_step_r<true, 1, PASSNO, true>(st, Kc, (PASSNO == 0 ? Vc : Kc), Qrow, lane, 0.f, t - 64 * j, 1, t1g, 0.f, 0.f, gs, lastv); \
                else nsa_step_r<false, 0, PASSNO>(st, Kc, (PASSNO == 0 ? Vc : Kc), Qrow, lane, b31, 0, 0, biasg, 0.f, 0.f, gs, lastv); } } while (0)
            nsa_reset(st);
            NSA_FORCED(2);
            if (hh == 0) ((LAS unsigned*)(L + SC_M))[32 * w + c] = f2ord(st.m);
            NSA_BAR();
            if (nitems > 0) sc_pass<1>(L, KFb, VFb, lane, w, qb, nitems, b31, biasg);
            NSA_BAR();
#ifdef PROBE_FORCE_FALLBACK
            const bool redo = true;
#else
            const bool redo = *(volatile LAS unsigned*)(L + SC_FLAG) != 0u;
#endif
            if (redo) {
                NSA_BAR();
                { LAS float* Oz = (LAS float*)(L + SC_OACC) + (32 * w + c) * 65 + 32 * hh;
#pragma unroll
                  for (int i = 0; i < 32; ++i) Oz[i] = 0.f;
                  if (hh == 0) { ((LAS unsigned*)(L + SC_M))[32 * w + c] = 0u; ((LAS float*)(L + SC_L))[32 * w + c] = 0.f; }
                  if (tid == 0) *(volatile LAS unsigned*)(L + SC_FLAG) = 0u; }
                NSA_BAR();
                if (nitems > 0) sc_pass<0>(L, KFb, VFb, lane, w, qb, nitems, b31, biasg);
                NSA_BAR();
                if (nitems > 0) sc_pass<1>(L, KFb, VFb, lane, w, qb, nitems, b31, biasg);
                NSA_BAR();
            }
            nsa_reset(st);
            NSA_FORCED(0);
            { const LAS int* Oa = (const LAS int*)(L + SC_OACC) + (32 * w + c) * 65 + 4 * hh; const float lrest = (float)((const LAS int*)(L + SC_L))[32 * w + c]; const float mrest = ord2f(((const LAS unsigned*)(L + SC_M))[32 * w + c]);
              float lf; NSA_LSUM(lf, st.l); const float Mx_ = fmaxf(st.m, mrest);
              const float af = __builtin_amdgcn_exp2f(st.m - Mx_), ar = (mrest == -INFINITY || lrest == 0.f) ? 0.f : __builtin_amdgcn_exp2f(mrest - Mx_ - SC_SHIFT);
              const float sc = gate_s / (lf * af + lrest * ar), sf = sc * af, sr = sc * ar;
#pragma unroll
              for (int r = 0; r < 16; ++r) { const int d = (r & 3) + 8 * (r >> 2); st.O0[r] = sf * st.O0[r] + sr * (float)Oa[d]; st.O1[r] = sf * st.O1[r] + sr * (float)Oa[32 + d]; } }
            NSA_PARK_ADD();
        } else {
#pragma unroll
            for (int r = 0; r < 16; ++r) { st.O0[r] = 0.f; st.O1[r] = 0.f; }
            NSA_PARK_ADD();
        }
#pragma unroll
        for (int rg = 0; rg < 4; ++rg) { u32x2_t w0, w1; w0.x = pkbf(st.O0[4 * rg], st.O0[4 * rg + 1]); w0.y = pkbf(st.O0[4 * rg + 2], st.O0[4 * rg + 3]); w1.x = pkbf(st.O1[4 * rg], st.O1[4 * rg + 1]); w1.y = pkbf(st.O1[4 * rg + 2], st.O1[4 * rg + 3]);
            bf16* orow = (bf16*)(kargs()->ws + out_off) + (size_t)(b * T + t) * D + hq * HD;
            if (VAR == 0 || out_off == WS_QO) { *(u32x2_t*)(orow + 8 * rg + 4 * hh) = w0; *(u32x2_t*)(orow + 32 + 8 * rg + 4 * hh) = w1; }
            else { asm volatile("" :: "v"(w0.x), "v"(w0.y), "v"(w1.x), "v"(w1.y)); } }
        NSA_BAR();
    }
}

__device__ __forceinline__ void panel_sync(int cw_base) {
    ArgsP ap = kargs();
    int bx = blockIdx.x, G = gridDim.x; asm volatile("" : "+s"(bx), "+s"(G));
    pg8::StaticOrder S; S.init(M, D, G, bx); pg8::Unit u; S.next(0, u);
    asm volatile("s_waitcnt vmcnt(0)" ::: "memory");
    __syncthreads();
    if (threadIdx.x == 0) {
        __builtin_amdgcn_fence(__ATOMIC_RELEASE, "agent");
        asm volatile("s_waitcnt vmcnt(0)" ::: "memory");
        unsigned* c = (unsigned*)(ap->ws + WS_CTL) + cw_base + u.pm * 16;
        (void)__hip_atomic_fetch_add(c, 1u, __ATOMIC_RELAXED, __HIP_MEMORY_SCOPE_AGENT);
        unsigned sp = 0;
        while (__hip_atomic_load(c, __ATOMIC_RELAXED, __HIP_MEMORY_SCOPE_AGENT) < 4u) { __builtin_amdgcn_s_sleep(1); if (++sp > (1u << 22)) { atomicAdd((unsigned*)(ap->ws + WS_CTL) + CW_TMO, 1u); break; } }
        __builtin_amdgcn_fence(__ATOMIC_ACQUIRE, "agent");
        asm volatile("s_waitcnt vmcnt(0)" ::: "memory");
    }
    __syncthreads();
}
#define PHASE_BEGIN() ArgsP ap = kargs(); (void)ap
template <int PH> __device__ __forceinline__ void run_phase(LAS unsigned char* lds_base) {
    Frame F; F.lds = lds_base;
    int bx = blockIdx.x, G = gridDim.x; asm volatile("" : "+s"(bx), "+s"(G));
    { int t_ = threadIdx.x; asm volatile("" : "+v"(t_)); F.tid = t_; F.lane = t_ & 63; F.wave = __builtin_amdgcn_readfirstlane(t_ >> 6); F.G = G; F.vcu = (G % 8 == 0) ? (bx % 8) * (G / 8) + bx / 8 : bx; }
    constexpr int ph = PH; constexpr int layer = (PH >= 7 && PH < 16) ? 1 : 0;
        switch (ph) {
        case 0:
#ifndef SKIP_P0
            p0_prologue(F);
#endif
            break;
        case 1: {
            PHASE_BEGIN();
            pg8::Gemm g{WSP(bf16, WS_HB), WSP(bf16, WS_WQKV)}; pg8::StaticOrder S; S.init(M, NQKV, G, bx);
            pg8::fill_rstd(F.lds, WSP(float, WS_SSQ0), S);
            pg8::EpiQKV E{F.lds, WSP(bf16, WS_QO), WSP(bf16, WS_K0), WSP(bf16, WS_V0)};
            pg8::gemm_phase<pg8::EpiQKV, pg8::StaticOrder, D, D, D, PG8_ALIGN, PG8_SP2>(F.lds + RING_OFF, g, S, E);
        } break;
        case 2:
#ifdef USE_SB_SIMPLE
            sb_simple(F);
#else
            sb_mfma(F);
#endif
            break;
        case 3: case 11: {
            PHASE_BEGIN();
            pg8::Gemm g{WSP(bf16, WS_QO), layer ? WSP(bf16, WS_WO1) : WSP(bf16, WS_WO0)}; pg8::StaticOrder S; S.init(M, D, G, bx);
            if (layer == 0) { pg8::EpiRes<true> E{(const void*)ap->in[0], WSP(bf16, WS_HB), WSP(float, WS_SSQ1)};
                pg8::gemm_phase<pg8::EpiRes<true>, pg8::StaticOrder, D, D, D, PG8_ALIGN, PG8_SP2>(F.lds + RING_OFF, g, S, E); }
            else { pg8::EpiRes<false> E{(const void*)WSP(bf16, WS_PP), WSP(bf16, WS_HB), WSP(float, WS_SSQ0)};
                pg8::gemm_phase<pg8::EpiRes<false>, pg8::StaticOrder, D, D, D, PG8_ALIGN, PG8_SP2>(F.lds + RING_OFF, g, S, E); }
        } break;
        case 4: case 12: {
            PHASE_BEGIN();
            pg8::Gemm g{WSP(bf16, WS_HB), layer ? WSP(bf16, WS_WFI1) : WSP(bf16, WS_WFI0)}; pg8::StaticOrder S; S.init(M, NFFI, G, bx);
            pg8::fill_rstd(F.lds, layer ? WSP(float, WS_SSQ0) : WSP(float, WS_SSQ1), S);
            pg8::EpiSwiglu E{F.lds, WSP(bf16, WS_ACT)};
            pg8::gemm_phase<pg8::EpiSwiglu, pg8::StaticOrder, D, D, D, PG8_ALIGN, PG8_SP2>(F.lds + RING_OFF, g, S, E);
            {
                ArgsP ap5 = kargs();
                pg8::Gemm g2{(const bf16*)(ap5->ws + WS_PB) + (size_t)layer * M * PLE, (const bf16*)(ap5->ws + (layer ? WS_WP1 : WS_WP0))}; pg8::UpperHalfOrder S2{bx, G};
                pg8::EpiBf16Plain E2{(bf16*)(ap5->ws + WS_PP), D};
                pg8::gemm_phase<pg8::EpiBf16Plain, pg8::UpperHalfOrder, PLE, PLE, PLE, PG8_ALIGN, PG8_SP2>(F.lds + RING_OFF, g2, S2, E2);
            }
        } break;
        case 5: case 13: {
            {
                PHASE_BEGIN();
                pg8::Gemm g{WSP(bf16, WS_ACT), layer ? WSP(bf16, WS_WFO1) : WSP(bf16, WS_WFO0)}; pg8::StaticOrder S; S.init(M, D, G, bx);
                pg8::EpiRes<false> E{(const void*)WSP(bf16, WS_HB), WSP(bf16, WS_HB), layer ? WSP(float, WS_SSQ1) : WSP(float, WS_SSQ0)};
                pg8::gemm_phase<pg8::EpiRes<false>, pg8::StaticOrder, FF, FF, FF, PG8_ALIGN, PG8_SP2>(F.lds + RING_OFF, g, S, E);
            }
        } break;
        case 6: case 14: {
            PHASE_BEGIN();
            pg8::Gemm g{WSP(bf16, WS_HB), layer ? WSP(bf16, WS_WG1) : WSP(bf16, WS_WG0)}; pg8::StaticOrder S; S.init(M, D, G, bx);
            pg8::fill_rstd(F.lds, layer ? WSP(float, WS_SSQ1) : WSP(float, WS_SSQ0), S);
            if (layer == 0) { pg8::EpiGate<false> E{F.lds, WSP(bf16, WS_HB), ap->out, WSP(bf16, WS_PP), WSP(float, WS_SSQ1)};
                pg8::gemm_phase<pg8::EpiGate<false>, pg8::StaticOrder, D, D, D, PG8_ALIGN, PG8_SP2>(F.lds + RING_OFF, g, S, E); }
            else { pg8::EpiGateFinal E{F.lds, WSP(bf16, WS_HB), ap->out, WSP(bf16, WS_PP), WSP(float, WS_SSQ0), (unsigned*)(ap->ws + WS_CTL) + CW_PANEL, ap->in[6], (unsigned*)(ap->ws + WS_CTL) + CW_TMO};
                pg8::gemm_phase<pg8::EpiGateFinal, pg8::StaticOrder, D, D, D, PG8_ALIGN, PG8_SP2>(F.lds + RING_OFF, g, S, E); }
        } break;
        case 7: {
            PHASE_BEGIN();
            pg8::Gemm g{WSP(bf16, WS_PP), WSP(bf16, WS_WNSA)}; pg8::StaticOrder S; S.init(M, NNSA, G, bx);
            pg8::fill_rstd(F.lds, WSP(float, WS_SSQ1), S);
            pg8::EpiNSA E{F.lds, WSP(bf16, WS_QO), WSP(bf16, WS_KV1), KVSZ, WSP(float, WS_GATES)};
            pg8::gemm_phase<pg8::EpiNSA, pg8::StaticOrder, D, D, D, PG8_ALIGN, PG8_SP2>(F.lds + RING_OFF, g, S, E);
        } break;
        case 8: {
            PHASE_BEGIN();
            const int uix = F.vcu; const bool has = uix < 128; const int which = (uix >> 6) & 1, tile = (uix >> 2) & 15, ks = uix & 3;
            const bf16* Ab = WSP(bf16, WS_KV1) + (size_t)which * KVSZ + (size_t)(tile >> 1) * T * HD + (size_t)(tile & 1) * 256 * 1024 + ks * 512;
            const bf16* Bb = (which ? WSP(bf16, WS_WCV) : WSP(bf16, WS_WCK)) + ks * 512;
            pg8::Gemm g{Ab, Bb}; pg8::OneUnit S{has};
            pg8::EpiSlab E{WSP(bf16, WS_SLAB) + (size_t)((ks * 2 + which) * 16 + tile) * 65536};
            pg8::gemm_phase<pg8::EpiSlab, pg8::OneUnit, 1024, CMPK, 512, false, PG8_SP2>(F.lds + RING_OFF, g, S, E);
            nsa_relayout(F);
        } break;
        case 9:
#ifndef SKIP_C2
            cmp_stage2(F);
#endif
            break;
        case 10:
#ifdef USE_NSA_SIMPLE
            nsa_simple(F);
#else
            nsa_mfma<0>(F);
#endif
            break;
#ifdef PROBE_DUP
#ifndef PROBE_VAR
#define PROBE_VAR 0
#endif
        case 18: sb_mfma(F, WS_PP); break;
        case 19: nsa_mfma<(PROBE_VAR | 16)>(F, WS_SPARE); break;
#endif
#ifdef PROBE_NSA_DIFF
        case 16: nsa_simple(F, WS_SPARE); break;
        case 17: {
            PHASE_BEGIN(); bf16* q = WSP(bf16, WS_QO); const bf16* x = WSP(bf16, WS_SPARE); const int gt = F.vcu * (NWAVES * 64) + F.tid, NTH = F.G * NWAVES * 64;
            for (int i = gt; i < M * D; i += NTH) { const float a = bf2f(q[i]), r = bf2f(x[i]);
#ifdef PROBE_NSA_SCALE
                q[i] = (bf16)f2bf(1.25f * a);
#else
                q[i] = (bf16)f2bf(r + 32.0f * (a - r));
#endif
            }
        } break;
#endif
        default: {
            PHASE_BEGIN();
            const int gw = F.vcu * NWAVES + F.wave, NGW = F.G * NWAVES; const float* gf = ap->in[6]; const float* SSQ = WSP(float, WS_SSQ0);
            f32x4 gv[4];
#pragma unroll
            for (int j = 0; j < 4; ++j) gv[j] = ((const f32x4*)gf)[F.lane + 64 * j];
            for (int m = gw; m < M; m += NGW) {
                float s = F.lane < 16 ? SSQ[(size_t)m * 16 + F.lane] : 0.f; s = wave_sum(s);
                const float r = rsqrtf(s * (1.0f / 1024.0f) + RMS_EPS);
                GAS f32x4* xr = (GAS f32x4*)(ap->out + (size_t)m * D) + F.lane;
#pragma unroll
                for (int j = 0; j < 4; ++j) { f32x4 v = xr[64 * j]; v = v * r * gv[j]; xr[64 * j] = v; }
            }
        } break;
        }
}
__global__ void __launch_bounds__(NWAVES * 64, 2) fwd_kernel(Args args) {
    extern __shared__ __attribute__((aligned(16))) unsigned char lds[];
    LAS unsigned char* L = (LAS unsigned char*)lds;
    { const int tid = threadIdx.x; for (int u = tid; u < (LDS_BYTES - LDSCTL_OFF) / 4; u += NWAVES * 64) ((LAS unsigned*)(L + LDSCTL_OFF))[u] = 0u; }
    __syncthreads();
    XcdBarrier bar = xcd_barrier_post((unsigned*)((gu32*)(args.ws + WS_CTL) + CW_BAR), (volatile LAS unsigned*)(L + MISC_OFF) + 8);
#define BAR_() do { XcdBarrier b2 = bar; asm volatile("" : "+s"(b2.bar), "+s"(b2.x)); xcd_barrier(b2); } while (0)
#define STEP(P) run_phase<P>(L); BAR_()
#ifdef PROBE_DUP
#define DUP_(P) if (PROBE_DUP == (P)) { STEP(P == 2 ? 18 : P == 10 ? 19 : P); }
#else
#define DUP_(P)
#endif
    DUP_(0) STEP(0); DUP_(1) STEP(1); DUP_(2) STEP(2); DUP_(3) STEP(3); DUP_(4) STEP(4); run_phase<5>(L); panel_sync(CW_PANEL2); STEP(6); DUP_(7) STEP(7); DUP_(8) STEP(8); DUP_(9) STEP(9);
#ifdef PROBE_NSA_DIFF
    STEP(16);
#endif
    DUP_(10) STEP(10);
#ifdef PROBE_NSA_DIFF
    STEP(17);
#endif
    STEP(11); STEP(12); run_phase<13>(L); panel_sync(CW_PANEL3);
    run_phase<14>(L);
}

extern "C" void kernel_launch(void* const* d_in, const int* in_sizes, int n_in, void* d_out, int out_size, void* d_ws, size_t ws_size, hipStream_t stream) {
    static int grid = 0;
    if (grid == 0) {
        if (n_in != 21 || in_sizes[0] != M * D || out_size != M * D || ws_size < WS_END) { fprintf(stderr, "kernel_launch: unexpected shapes (n_in %d, in0 %d, out %d, ws %zu)\n", n_in, n_in > 0 ? in_sizes[0] : -1, out_size, ws_size); grid = -1; return; }
        int dev = 0, cus = 0, per_cu = 0;
        if (hipGetDevice(&dev) != hipSuccess || hipDeviceGetAttribute(&cus, hipDeviceAttributeMultiprocessorCount, dev) != hipSuccess) { grid = -1; return; }
        if (hipFuncSetAttribute((const void*)fwd_kernel, hipFuncAttributeMaxDynamicSharedMemorySize, LDS_BYTES) != hipSuccess) { fprintf(stderr, "kernel_launch: hipFuncSetAttribute failed\n"); grid = -1; return; }
        if (hipOccupancyMaxActiveBlocksPerMultiprocessor(&per_cu, (const void*)fwd_kernel, NWAVES * 64, LDS_BYTES) != hipSuccess || per_cu < 1) { fprintf(stderr, "kernel_launch: occupancy query reports %d blocks per CU\n", per_cu); per_cu = 1; }
        (void)hipGetLastError();
        if (cus != 256) { fprintf(stderr, "kernel_launch: built for a 256-CU device (found %d CUs); nothing launched\n", cus); grid = -1; return; }
        grid = cus * (per_cu < 1 ? 1 : 1);
    }
    if (grid < 0) return;
    if (hipMemsetAsync((char*)d_ws + WS_CTL, 0, CTL_ZERO_BYTES, stream) != hipSuccess) { fprintf(stderr, "kernel_launch: memset failed\n"); return; }
    Args a{};
    for (int i = 0; i < 21; ++i) a.in[i] = (const float*)d_in[i];
    a.out = (float*)d_out; a.ws = (unsigned char*)d_ws;
    hipLaunchKernelGGL(fwd_kernel, dim3(grid), dim3(NWAVES * 64), LDS_BYTES, stream, a);
    const hipError_t le = hipPeekAtLastError();
    if (le != hipSuccess) fprintf(stderr, "kernel_launch: launch failed: %s\n", hipGetErrorName(le));
}
```

```cpp
#include <hip/hip_runtime.h>
#include <hip/hip_bf16.h>
#include <cstdio>
#include <cstdint>
#include <cmath>
namespace pg8 {
#define PG8_LAS __attribute__((address_space(3)))
typedef unsigned short bf16_t;
typedef short bf16x8 __attribute__((ext_vector_type(8)));
typedef float f32x4 __attribute__((ext_vector_type(4)));
typedef float f32x2 __attribute__((ext_vector_type(2)));
typedef unsigned u32x4 __attribute__((ext_vector_type(4)));
typedef unsigned u32x2 __attribute__((ext_vector_type(2)));
constexpr int BM = 256, BK = 64, HALF = 128, HTB = HALF * BK * 2  , STAGE_BYTES = 8 * HTB, NXCD = 8, WGM = 4;

__host__ __device__ __forceinline__ int lds_byte(int r, int c) { const int st = (r >> 4) * 2 + (c >> 5), rr = r & 15, cc = c & 31, ob = rr * 64 + cc * 2; return st * 1024 + (ob ^ (((ob >> 9) & 1) << 5)); }
__host__ __device__ __forceinline__ void stage_rc(int b, int& R, int& C) { const int st = b / 1024, sb = b % 1024, swz = sb ^ (((sb >> 9) & 1) << 5); R = (st >> 1) * 16 + swz / 64; C = (st & 1) * 32 + (swz % 64) / 2; }
__host__ __device__ __forceinline__ int perm32(int rho) { const int n = rho >> 4, i = rho & 15; return 8 * (i >> 2) + 4 * n + (i & 3); }

struct Unit { int pm, pn; };
struct Gemm { const bf16_t* A; const bf16_t* Bt; };

struct StaticOrder {
    int nM, nN, nwg, G, c;
    __host__ __device__ void init(int M, int N, int G_, int c_) { nM = M / BM; nN = N / BM; nwg = nM * nN; G = G_; c = c_; }
    __host__ __device__ bool next(int i, Unit& u) const {
        const long L = (long)i * G + c; if (L >= nwg) return false;
        int wgid = (int)L; { const int q = nwg / NXCD, r = nwg % NXCD, xcd = wgid % NXCD, off = wgid / NXCD; wgid = (xcd < r ? xcd * (q + 1) : r * (q + 1) + (xcd - r) * q) + off; }
        const int nig = WGM * nN, gid = wgid / nig, fm = gid * WGM, gsz = (nM - fm) < WGM ? (nM - fm) : WGM;
        u.pm = fm + ((wgid % nig) % gsz); u.pn = (wgid % nig) / gsz; return true;
    }
    __device__ __forceinline__ void a_ready(const Unit&) const {}
    __device__ __forceinline__ void done(const Unit&) const {}
};
struct UpperHalfOrder {
    int c, G;
    __device__ __forceinline__ bool next(int i, Unit& u) const { if (G != 256) { const int L = i * G + c; if (L >= 256) return false; u.pm = L >> 2; u.pn = L & 3; return true; }
        if (c < 128 || i >= 2) return false; const int L = (c - 128) + 128 * i; u.pm = L >> 2; u.pn = L & 3; return true; }
    __device__ __forceinline__ void a_ready(const Unit&) const {}
    __device__ __forceinline__ void done(const Unit&) const {}
};
struct OneUnit {
    bool has;
    __device__ __forceinline__ bool next(int i, Unit& u) const { if (i > 0 || !has) return false; u.pm = 0; u.pn = 0; return true; }
    __device__ __forceinline__ void a_ready(const Unit&) const {}
    __device__ __forceinline__ void done(const Unit&) const {}
};

__device__ __forceinline__ unsigned cvt_pk_bf16(float lo, float hi) { unsigned r; asm volatile("v_cvt_pk_bf16_f32 %0, %1, %2" : "=v"(r) : "v"(lo), "v"(hi)); return r; }
__device__ __forceinline__ float sigmoidf_(float x) { return __builtin_amdgcn_rcpf(1.0f + __builtin_amdgcn_exp2f(-1.4426950408889634f * x)); }

constexpr int SEQ_ = 8192;
constexpr int RTAB_OFF = 131072, RTAB_UNITS = 8;
template <class Sched> __device__ __forceinline__ void fill_rstd(PG8_LAS unsigned char* lds, const float* ssq, const Sched& S) {
    int t_ = threadIdx.x; asm volatile("" : "+v"(t_));
    PG8_LAS float* rtab = (PG8_LAS float*)(lds + RTAB_OFF); const int row = t_ & 255, half = t_ >> 8;
    Unit u;
#pragma unroll 1
    for (int ui = half; ui < RTAB_UNITS && S.next(ui, u); ui += 2) {
        const f32x4* p = (const f32x4*)(ssq + (size_t)(u.pm * BM + row) * 16);
        const f32x4 a = p[0], b = p[1], c = p[2], d = p[3];
        const float s = (((a[0] + a[1]) + (a[2] + a[3])) + ((b[0] + b[1]) + (b[2] + b[3]))) + (((c[0] + c[1]) + (c[2] + c[3])) + ((d[0] + d[1]) + (d[2] + d[3])));
        rtab[ui * 256 + row] = rsqrtf(s * (1.0f / 1024.0f) + 1e-6f);
    }
    asm volatile("s_waitcnt lgkmcnt(0)" ::: "memory"); __builtin_amdgcn_s_barrier(); asm volatile("" ::: "memory");
}
__device__ __forceinline__ void load_rstd(const PG8_LAS unsigned char* lds, int ui, int wr, int fr, float (&rs)[2][4]) {
    const PG8_LAS float* rtab = (const PG8_LAS float*)(lds + RTAB_OFF) + ui * 256;
#pragma unroll
    for (int ai = 0; ai < 2; ++ai)
#pragma unroll
        for (int m = 0; m < 4; ++m) rs[ai][m] = rtab[ai * HALF + wr * 64 + m * 16 + fr];
}
struct EpiQKV {
    static constexpr bool PERM = true, AFTER_DRAIN = false;
    const PG8_LAS unsigned char* lds; bf16_t* Q; bf16_t* Kh; bf16_t* Vh;
    __device__ __forceinline__ void operator()(const f32x4 (&acc)[2][2][4][2], const Unit& u, int ui, int wr, int wc, int fr_, int fq_) const {
        int fr = fr_, fq = fq_; asm volatile("" : "+v"(fr), "+v"(fq));
        float rs[2][4]; load_rstd(lds, ui, wr, fr, rs);
        const int t3 = u.pn >> 2; const int ct = (u.pn & 3) * 256 + wc * 32 + 8 * fq; const float sc = t3 == 0 ? 0.125f : 1.0f;
        char* const dbase = (char*)Q + (size_t)(t3 >= 1 ? 1 : 0) * (size_t)((const char*)Kh - (const char*)Q) + (size_t)(t3 >= 2 ? 1 : 0) * (size_t)((const char*)Vh - (const char*)Kh);
        const int row0 = u.pm * BM + wr * 64 + fr;
        unsigned off0, st_ai, st_m, st_bj;
        if (t3 == 0) { off0 = (unsigned)(row0 * 2048 + ct * 2); st_ai = HALF * 2048; st_m = 16 * 2048; st_bj = HALF * 2; }
        else { const int b = row0 >> 13, s = row0 & (SEQ_ - 1); off0 = (unsigned)(((b * 16 + (ct >> 6)) * SEQ_ + s) * 128 + (ct & 63) * 2); st_ai = HALF * 128; st_m = 16 * 128; st_bj = 2 * SEQ_ * 128; }
#pragma unroll
        for (int ai = 0; ai < 2; ++ai)
#pragma unroll
            for (int m = 0; m < 4; ++m) { const float r = rs[ai][m] * sc;
#pragma unroll
                for (int bj = 0; bj < 2; ++bj) { const f32x4 v0 = acc[ai][bj][m][0] * r, v1 = acc[ai][bj][m][1] * r;
                    u32x4 w; w.x = cvt_pk_bf16(v0[0], v0[1]); w.y = cvt_pk_bf16(v0[2], v0[3]); w.z = cvt_pk_bf16(v1[0], v1[1]); w.w = cvt_pk_bf16(v1[2], v1[3]);
                    const unsigned off = off0 + ai * st_ai + m * st_m + bj * st_bj;
                    *(u32x4*)(dbase + (size_t)off) = w; } }
    }
};
struct EpiNSA {
    static constexpr bool PERM = true, AFTER_DRAIN = false;
    const PG8_LAS unsigned char* lds; bf16_t* Q; bf16_t* KV; size_t kvsz; float* gates;
    __device__ __forceinline__ void operator()(const f32x4 (&acc)[2][2][4][2], const Unit& u, int ui, int wr, int wc, int fr_, int fq_) const {
        int fr = fr_, fq = fq_; asm volatile("" : "+v"(fr), "+v"(fq));
        float rs[2][4]; load_rstd(lds, ui, wr, fr, rs);
        const int pn = u.pn; const int cw = wc * 32 + 8 * fq;
        const int row0 = u.pm * BM + wr * 64 + fr;
        if (pn < 10) {
            char* const dbase = pn < 4 ? (char*)Q : (char*)KV + (size_t)(pn - 4) * kvsz * 2;
            unsigned off0, st_ai, st_m, st_bj;
            if (pn < 4) { off0 = (unsigned)(row0 * 2048 + (pn * 256 + cw) * 2); st_ai = HALF * 2048; st_m = 16 * 2048; st_bj = HALF * 2; }
            else { const int b = row0 >> 13, s = row0 & (SEQ_ - 1); off0 = (unsigned)(((b * 4 + (cw >> 6)) * SEQ_ + s) * 128 + (cw & 63) * 2); st_ai = HALF * 128; st_m = 16 * 128; st_bj = 2 * SEQ_ * 128; }
            const float sc = pn < 4 ? 0.125f : 1.0f;
#pragma unroll
            for (int ai = 0; ai < 2; ++ai)
#pragma unroll
                for (int m = 0; m < 4; ++m) { const float r = rs[ai][m] * sc;
#pragma unroll
                    for (int bj = 0; bj < 2; ++bj) { const f32x4 v0 = acc[ai][bj][m][0] * r, v1 = acc[ai][bj][m][1] * r;
                        u32x4 w; w.x = cvt_pk_bf16(v0[0], v0[1]); w.y = cvt_pk_bf16(v0[2], v0[3]); w.z = cvt_pk_bf16(v1[0], v1[1]); w.w = cvt_pk_bf16(v1[2], v1[3]);
                        *(u32x4*)(dbase + (size_t)(off0 + ai * st_ai + m * st_m + bj * st_bj)) = w; } }
        } else if (cw < 64) {
            const unsigned off0 = (unsigned)(row0 * 64 + cw) * 4u;
#pragma unroll
            for (int ai = 0; ai < 2; ++ai)
#pragma unroll
                for (int m = 0; m < 4; ++m) { const float r = rs[ai][m]; f32x4 v0 = acc[ai][0][m][0] * r, v1 = acc[ai][0][m][1] * r;
#pragma unroll
                    for (int e = 0; e < 4; ++e) { v0[e] = sigmoidf_(v0[e]); v1[e] = sigmoidf_(v1[e]); }
                    char* const dst = (char*)gates + (size_t)(off0 + ai * (HALF * 256) + m * (16 * 256)); *(f32x4*)dst = v0; *(f32x4*)(dst + 16) = v1; }
        }
    }
};
struct EpiSwiglu {
    static constexpr bool PERM = true, AFTER_DRAIN = false;
    const PG8_LAS unsigned char* lds; bf16_t* act;
    __device__ __forceinline__ void operator()(const f32x4 (&acc)[2][2][4][2], const Unit& u, int ui, int wr, int wc, int fr_, int fq_) const {
        int fr = fr_, fq = fq_; asm volatile("" : "+v"(fr), "+v"(fq));
        float rs[2][4]; load_rstd(lds, ui, wr, fr, rs);
        const int c0 = u.pn * 128 + wc * 32 + 8 * fq; const unsigned off0 = (unsigned)((u.pm * BM + wr * 64 + fr) * 2816 + c0) * 2u;
#pragma unroll
        for (int ai = 0; ai < 2; ++ai)
#pragma unroll
            for (int m = 0; m < 4; ++m) { const float r = rs[ai][m]; u32x4 w; unsigned* wp = (unsigned*)&w;
#pragma unroll
                for (int n = 0; n < 2; ++n) { const f32x4 a = acc[ai][0][m][n] * r, bb = acc[ai][1][m][n] * r; f32x4 o;
#pragma unroll
                    for (int e = 0; e < 4; ++e) o[e] = a[e] * sigmoidf_(a[e]) * bb[e];
                    wp[2 * n] = cvt_pk_bf16(o[0], o[1]); wp[2 * n + 1] = cvt_pk_bf16(o[2], o[3]); }
                *(u32x4*)((char*)act + (size_t)(off0 + ai * (HALF * 5632) + m * (16 * 5632))) = w; }
    }
};
struct EpiBf16Plain {
    static constexpr bool PERM = true, AFTER_DRAIN = false;
    bf16_t* O; int ldc;
    __device__ __forceinline__ void operator()(const f32x4 (&acc)[2][2][4][2], const Unit& u, int ui, int wr, int wc, int fr_, int fq_) const {
        int fr = fr_, fq = fq_; asm volatile("" : "+v"(fr), "+v"(fq));
        const int c0 = u.pn * BM + wc * 32 + 8 * fq; const unsigned off0 = (unsigned)((u.pm * BM + wr * 64 + fr) * ldc + c0) * 2u, st_r = (unsigned)ldc * 32u;
#pragma unroll
        for (int ai = 0; ai < 2; ++ai)
#pragma unroll
            for (int m = 0; m < 4; ++m) {
#pragma unroll
                for (int bj = 0; bj < 2; ++bj) { const f32x4 v0 = acc[ai][bj][m][0], v1 = acc[ai][bj][m][1];
                    u32x4 w; w.x = cvt_pk_bf16(v0[0], v0[1]); w.y = cvt_pk_bf16(v0[2], v0[3]); w.z = cvt_pk_bf16(v1[0], v1[1]); w.w = cvt_pk_bf16(v1[2], v1[3]);
                    *(u32x4*)((char*)O + (size_t)(off0 + (ai * 8 + m) * st_r + bj * (HALF * 2))) = w; } }
    }
};
__device__ __forceinline__ void unpack8(const u32x4& w, f32x4& lo, f32x4& hi) {
    lo[0] = __uint_as_float(w.x << 16); lo[1] = __uint_as_float(w.x & 0xffff0000u); lo[2] = __uint_as_float(w.y << 16); lo[3] = __uint_as_float(w.y & 0xffff0000u);
    hi[0] = __uint_as_float(w.z << 16); hi[1] = __uint_as_float(w.z & 0xffff0000u); hi[2] = __uint_as_float(w.w << 16); hi[3] = __uint_as_float(w.w & 0xffff0000u);
}
template <bool BASEF32> struct EpiRes {
    static constexpr bool PERM = true, AFTER_DRAIN = false;
    const void* base; bf16_t* hb; float* ssq;
    __device__ __forceinline__ void operator()(const f32x4 (&acc)[2][2][4][2], const Unit& u, int ui, int wr, int wc, int fr_, int fq_) const {
        int fr = fr_, fq = fq_; asm volatile("" : "+v"(fr), "+v"(fq));
        const int c0 = u.pn * BM + wc * 32 + 8 * fq; const int row0 = u.pm * BM + wr * 64 + fr; const unsigned eoff0 = (unsigned)(row0 * 1024 + c0);
#pragma unroll
        for (int ai = 0; ai < 2; ++ai) {
            f32x4 bl[4][2][2];
#pragma unroll
            for (int m = 0; m < 4; ++m)
#pragma unroll
                for (int bj = 0; bj < 2; ++bj) { const unsigned o2 = eoff0 + (unsigned)(ai * (HALF * 1024) + m * (16 * 1024) + bj * HALF);
                    if (BASEF32) { const char* bp = (const char*)base + (size_t)(o2 * 4u); bl[m][bj][0] = *(const f32x4*)bp; bl[m][bj][1] = *(const f32x4*)(bp + 16); }
                    else { const u32x4 pw = *(const u32x4*)((const char*)base + (size_t)(o2 * 2u)); bl[m][bj][0] = __builtin_bit_cast(f32x4, pw); } }
#pragma unroll
            for (int m = 0; m < 4; ++m) { const int row = row0 + ai * HALF + m * 16; float s = 0.f;
#pragma unroll
                for (int bj = 0; bj < 2; ++bj) { const unsigned o2 = eoff0 + (unsigned)(ai * (HALF * 1024) + m * (16 * 1024) + bj * HALF); f32x4 v0, v1;
                    if (BASEF32) { v0 = bl[m][bj][0]; v1 = bl[m][bj][1]; }
                    else { unpack8(__builtin_bit_cast(u32x4, bl[m][bj][0]), v0, v1); }
                    v0 = v0 + acc[ai][bj][m][0]; v1 = v1 + acc[ai][bj][m][1];
                    u32x4 w; w.x = cvt_pk_bf16(v0[0], v0[1]); w.y = cvt_pk_bf16(v0[2], v0[3]); w.z = cvt_pk_bf16(v1[0], v1[1]); w.w = cvt_pk_bf16(v1[2], v1[3]); *(u32x4*)((char*)hb + (size_t)(o2 * 2u)) = w;
                    s += ((v0[0] * v0[0] + v0[1] * v0[1]) + (v0[2] * v0[2] + v0[3] * v0[3])) + ((v1[0] * v1[0] + v1[1] * v1[1]) + (v1[2] * v1[2] + v1[3] * v1[3])); }
                s += __shfl_xor(s, 16); s += __shfl_xor(s, 32);
                if (fq == 0) ssq[(size_t)row * 16 + u.pn * 4 + wc] = s; }
        }
    }
};
template <bool LAST> struct EpiGate {
    static constexpr bool PERM = true, AFTER_DRAIN = false;
    const PG8_LAS unsigned char* lds; const bf16_t* base; float* out; bf16_t* pp; float* ssq_out;
    __device__ __forceinline__ void operator()(const f32x4 (&acc)[2][2][4][2], const Unit& u, int ui, int wr, int wc, int fr_, int fq_) const {
        int fr = fr_, fq = fq_; asm volatile("" : "+v"(fr), "+v"(fq));
        float rs[2][4]; load_rstd(lds, ui, wr, fr, rs);
        const int c0 = u.pn * BM + wc * 32 + 8 * fq; const int row0 = u.pm * BM + wr * 64 + fr; const unsigned eoff0 = (unsigned)(row0 * 1024 + c0);
#pragma unroll
        for (int ai = 0; ai < 2; ++ai) {
            u32x4 lp[4][2], lb[4][2];
#pragma unroll
            for (int m = 0; m < 4; ++m)
#pragma unroll
                for (int bj = 0; bj < 2; ++bj) { const unsigned o2 = eoff0 + (unsigned)(ai * (HALF * 1024) + m * (16 * 1024) + bj * HALF);
                    lp[m][bj] = *(const u32x4*)((const char*)pp + (size_t)(o2 * 2u)); lb[m][bj] = *(const u32x4*)((const char*)base + (size_t)(o2 * 2u)); }
#pragma unroll
            for (int m = 0; m < 4; ++m) { const int row = row0 + ai * HALF + m * 16; const float r = rs[ai][m]; float s = 0.f;
#pragma unroll
                for (int bj = 0; bj < 2; ++bj) { const unsigned o2 = eoff0 + (unsigned)(ai * (HALF * 1024) + m * (16 * 1024) + bj * HALF); const u32x4 pw = lp[m][bj], bw = lb[m][bj];
                    f32x4 p0, p1, v0, v1; unpack8(pw, p0, p1); unpack8(bw, v0, v1);
                    const f32x4 a0 = acc[ai][bj][m][0] * r, a1 = acc[ai][bj][m][1] * r;
#pragma unroll
                    for (int e = 0; e < 4; ++e) { v0[e] += sigmoidf_(a0[e]) * p0[e]; v1[e] += sigmoidf_(a1[e]) * p1[e]; }
                    if (LAST) { char* op = (char*)out + (size_t)(o2 * 4u); *(f32x4*)op = v0; *(f32x4*)(op + 16) = v1; }
                    else { u32x4 w; w.x = cvt_pk_bf16(v0[0], v0[1]); w.y = cvt_pk_bf16(v0[2], v0[3]); w.z = cvt_pk_bf16(v1[0], v1[1]); w.w = cvt_pk_bf16(v1[2], v1[3]); *(u32x4*)((char*)pp + (size_t)(o2 * 2u)) = w; }
                    s += ((v0[0] * v0[0] + v0[1] * v0[1]) + (v0[2] * v0[2] + v0[3] * v0[3])) + ((v1[0] * v1[0] + v1[1] * v1[1]) + (v1[2] * v1[2] + v1[3] * v1[3])); }
                s += __shfl_xor(s, 16); s += __shfl_xor(s, 32);
                if (fq == 0) ssq_out[(size_t)row * 16 + u.pn * 4 + wc] = s; }
        }
    }
};
struct EpiGateFinal {
    static constexpr bool PERM = true, AFTER_DRAIN = true;
    const PG8_LAS unsigned char* lds; const bf16_t* base; float* out; const bf16_t* pp; float* ssq; unsigned* cnt; const float* gfin; unsigned* tmo;
    __device__ __forceinline__ void operator()(const f32x4 (&)[2][2][4][2], const Unit&, int, int, int, int, int) const {}
    __device__ __forceinline__ void fused(const f32x4 (&acc)[2][2][4][2], const Unit& u, int wr, int wc, int fr_, int fq_, PG8_LAS unsigned char*, int, int) const {
        int fr = fr_, fq = fq_; asm volatile("" : "+v"(fr), "+v"(fq));
        float rs[2][4]; load_rstd(lds, 0, wr, fr, rs);
        const int c0 = u.pn * BM + wc * 32 + 8 * fq; const int row0 = u.pm * BM + wr * 64 + fr; const unsigned eoff0 = (unsigned)(row0 * 1024 + c0);
        f32x4 hv[2][4][2][2];
#pragma unroll
        for (int ai = 0; ai < 2; ++ai) {
            u32x4 lp[4][2], lb[4][2];
#pragma unroll
            for (int m = 0; m < 4; ++m)
#pragma unroll
                for (int bj = 0; bj < 2; ++bj) { const unsigned o2 = eoff0 + (unsigned)(ai * (HALF * 1024) + m * (16 * 1024) + bj * HALF);
                    lp[m][bj] = *(const u32x4*)((const char*)pp + (size_t)(o2 * 2u)); lb[m][bj] = *(const u32x4*)((const char*)base + (size_t)(o2 * 2u)); }
#pragma unroll
            for (int m = 0; m < 4; ++m) { const int row = row0 + ai * HALF + m * 16; const float r = rs[ai][m]; float s = 0.f;
#pragma unroll
                for (int bj = 0; bj < 2; ++bj) { const u32x4 pw = lp[m][bj], bw = lb[m][bj];
                    f32x4 p0, p1, v0, v1; unpack8(pw, p0, p1); unpack8(bw, v0, v1);
                    const f32x4 a0 = acc[ai][bj][m][0] * r, a1 = acc[ai][bj][m][1] * r;
#pragma unroll
                    for (int e = 0; e < 4; ++e) { v0[e] += sigmoidf_(a0[e]) * p0[e]; v1[e] += sigmoidf_(a1[e]) * p1[e]; }
                    hv[ai][m][bj][0] = v0; hv[ai][m][bj][1] = v1;
                    s += ((v0[0] * v0[0] + v0[1] * v0[1]) + (v0[2] * v0[2] + v0[3] * v0[3])) + ((v1[0] * v1[0] + v1[1] * v1[1]) + (v1[2] * v1[2] + v1[3] * v1[3])); }
                s += __shfl_xor(s, 16); s += __shfl_xor(s, 32);
                if (fq == 0) __hip_atomic_store(ssq + (size_t)row * 16 + u.pn * 4 + wc, s, __ATOMIC_RELAXED, __HIP_MEMORY_SCOPE_AGENT); }
        }
        asm volatile("s_waitcnt vmcnt(0)" ::: "memory");
        __syncthreads();
        if (threadIdx.x == 0) {
            unsigned* c = cnt + u.pm * 16;
            (void)__hip_atomic_fetch_add(c, 1u, __ATOMIC_RELAXED, __HIP_MEMORY_SCOPE_AGENT);
            unsigned sp = 0;
            while (__hip_atomic_load(c, __ATOMIC_RELAXED, __HIP_MEMORY_SCOPE_AGENT) < 4u) { __builtin_amdgcn_s_sleep(1); if (++sp > (1u << 22)) { atomicAdd(tmo, 1u); break; } }
        }
        __syncthreads();
        f32x4 g[2][2];
#pragma unroll
        for (int bj = 0; bj < 2; ++bj) { g[bj][0] = *(const f32x4*)(gfin + c0 + bj * HALF); g[bj][1] = *(const f32x4*)(gfin + c0 + bj * HALF + 4); }
#pragma unroll
        for (int ai = 0; ai < 2; ++ai)
#pragma unroll
            for (int m = 0; m < 4; ++m) { const int row = row0 + ai * HALF + m * 16;
                const unsigned long long* qp = (const unsigned long long*)((const char*)ssq + (size_t)((unsigned)(row * 16 + fq * 4) * 4u));
                const unsigned long long q01 = __hip_atomic_load(qp, __ATOMIC_RELAXED, __HIP_MEMORY_SCOPE_AGENT), q23 = __hip_atomic_load(qp + 1, __ATOMIC_RELAXED, __HIP_MEMORY_SCOPE_AGENT);
                float t = (__uint_as_float((unsigned)q01) + __uint_as_float((unsigned)(q01 >> 32))) + (__uint_as_float((unsigned)q23) + __uint_as_float((unsigned)(q23 >> 32))); t += __shfl_xor(t, 16); t += __shfl_xor(t, 32);
                const float rr = rsqrtf(t * (1.0f / 1024.0f) + 1e-6f);
#pragma unroll
                for (int bj = 0; bj < 2; ++bj) { const unsigned o2 = eoff0 + (unsigned)(ai * (HALF * 1024) + m * (16 * 1024) + bj * HALF); char* op = (char*)out + (size_t)(o2 * 4u);
                    *(f32x4*)op = hv[ai][m][bj][0] * rr * g[bj][0]; *(f32x4*)(op + 16) = hv[ai][m][bj][1] * rr * g[bj][1]; } }
    }
};
struct EpiSlab {
    static constexpr bool PERM = true, AFTER_DRAIN = false;
    bf16_t* slab;
    __device__ __forceinline__ void operator()(const f32x4 (&acc)[2][2][4][2], const Unit& u, int ui, int wr, int wc, int fr_, int fq_) const {
        int fr = fr_, fq = fq_; asm volatile("" : "+v"(fr), "+v"(fq));
        const int c0 = wc * 32 + 8 * fq; const unsigned off0 = (unsigned)((wr * 64 + fr) * 256 + c0) * 2u;
#pragma unroll
        for (int ai = 0; ai < 2; ++ai)
#pragma unroll
            for (int m = 0; m < 4; ++m) {
#pragma unroll
                for (int bj = 0; bj < 2; ++bj) { const f32x4 v0 = acc[ai][bj][m][0], v1 = acc[ai][bj][m][1];
                    u32x4 w; w.x = cvt_pk_bf16(v0[0], v0[1]); w.y = cvt_pk_bf16(v0[2], v0[3]); w.z = cvt_pk_bf16(v1[0], v1[1]); w.w = cvt_pk_bf16(v1[2], v1[3]);
                    *(u32x4*)((char*)slab + (size_t)(off0 + ai * (HALF * 512) + m * (16 * 512) + bj * (HALF * 2))) = w; } }
    }
};

template <class Epi, class Sched, int LDA, int LDB, int KK, bool ALIGN_EPI = false, bool SP2 = false>
__device__ __forceinline__ void gemm_phase(PG8_LAS unsigned char* lds, const Gemm g, const Sched& S, const Epi& E) {
    int tid_ = threadIdx.x; asm volatile("" : "+v"(tid_));
    const int tid = tid_, wid = __builtin_amdgcn_readfirstlane(tid >> 6), lane = tid & 63, wr = wid >> 2, wc = wid & 3, fr = lane & 15, fq = lane >> 4;
    constexpr int K = KK, nt = K / BK;
    unsigned voffA[2], voffB[2];
#pragma unroll
    for (int i = 0; i < 2; ++i) { int R, C; stage_rc(tid * 16 + i * 8192, R, C); const int Rb = Epi::PERM ? ((R & ~31) + perm32(R & 31)) : R;
        voffA[i] = (unsigned)(R * LDA + C) * 2u; voffB[i] = (unsigned)(Rb * LDB + C) * 2u; }
    constexpr size_t kstep = (size_t)(BK * 2);
    constexpr size_t hstepA = (size_t)HALF * LDA * 2, hstepB = (size_t)HALF * LDB * 2;
    constexpr size_t tstepA = 2 * hstepA, tstepB = 2 * hstepB;
    const unsigned ldsw = (unsigned)wid * 1024u;
    const int aoff = lds_byte(wr * 64 + fr, fq * 8), boff = lds_byte(wc * 32 + fr, fq * 8);
#define PG8_SA(b, h) (((b) * 2 + (h)) * HTB)
#define PG8_SB(b, h) ((4 + (b) * 2 + (h)) * HTB)
#define PG8_STAGE_(bufoff, rsrc, soff, voff) do { _Pragma("unroll") for (int _i = 0; _i < 2; ++_i) \
        __builtin_amdgcn_raw_ptr_buffer_load_lds(rsrc, (PG8_LAS unsigned*)(lds + (bufoff) + ldsw + _i * 8192), 16, (int)(voff)[_i], (int)(soff), 0, 0); } while (0)
#define PG8_STAGEA(bufoff, soff) PG8_STAGE_(bufoff, rA, soff, voffA)
#define PG8_STAGEB(bufoff, soff) PG8_STAGE_(bufoff, rB, soff, voffB)
#define PG8_LDA(dst, b, h) do { _Pragma("unroll") for (int m = 0; m < 4; ++m) _Pragma("unroll") for (int k = 0; k < 2; ++k) dst[m][k] = *(const PG8_LAS bf16x8*)(lds + PG8_SA(b, h) + aoff + m * 2048 + k * 1024); } while (0)
#define PG8_LDB(dst, b, h) do { _Pragma("unroll") for (int n = 0; n < 2; ++n) _Pragma("unroll") for (int k = 0; k < 2; ++k) dst[n][k] = *(const PG8_LAS bf16x8*)(lds + PG8_SB(b, h) + boff + n * 2048 + k * 1024); } while (0)
#define PG8_MMA(ai, bj, At, Bt) do { __builtin_amdgcn_s_setprio(1); _Pragma("unroll") for (int m = 0; m < 4; ++m) _Pragma("unroll") for (int n = 0; n < 2; ++n) _Pragma("unroll") for (int k = 0; k < 2; ++k) \
        acc[ai][bj][m][n] = __builtin_amdgcn_mfma_f32_16x16x32_bf16(Bt[n][k], At[m][k], acc[ai][bj][m][n], 0, 0, 0); __builtin_amdgcn_s_setprio(0); } while (0)
#define PG8_WAIT_V(n) asm volatile("s_waitcnt vmcnt(" #n ")" ::: "memory")
#define PG8_WAIT_L(n) asm volatile("s_waitcnt lgkmcnt(" #n ")" ::: "memory")
#define PG8_BAR __builtin_amdgcn_s_barrier()
#define PG8_SCHED __builtin_amdgcn_sched_barrier(0)
    Unit cur, nxt; int ui = 0;
    if (!S.next(0, cur)) return;
    f32x4 acc[2][2][4][2];
#pragma unroll
    for (int a = 0; a < 2; ++a)
#pragma unroll
        for (int b = 0; b < 2; ++b)
#pragma unroll
            for (int m = 0; m < 4; ++m)
#pragma unroll
                for (int n = 0; n < 2; ++n) acc[a][b][m][n] = (f32x4){0.f, 0.f, 0.f, 0.f};
    bf16x8 At[4][2], B0[2][2], B1[2][2];
    const unsigned long long pA_ = (unsigned long long)g.A, pB_ = (unsigned long long)g.Bt;
    void* const uA = (void*)(((unsigned long long)(unsigned)__builtin_amdgcn_readfirstlane((int)(unsigned)(pA_ >> 32)) << 32) | (unsigned)__builtin_amdgcn_readfirstlane((int)(unsigned)pA_));
    void* const uB = (void*)(((unsigned long long)(unsigned)__builtin_amdgcn_readfirstlane((int)(unsigned)(pB_ >> 32)) << 32) | (unsigned)__builtin_amdgcn_readfirstlane((int)(unsigned)pB_));
    const __amdgpu_buffer_rsrc_t rA = __builtin_amdgcn_make_buffer_rsrc(uA, 0, 0x7ffffff0, 0x00020000), rB = __builtin_amdgcn_make_buffer_rsrc(uB, 0, 0x7ffffff0, 0x00020000);
    unsigned cA = (unsigned)cur.pm * (unsigned)tstepA, cB = (unsigned)cur.pn * (unsigned)tstepB;
    S.a_ready(cur);
    if constexpr (SP2) {
        PG8_STAGEB(PG8_SB(0, 0), cB); PG8_STAGEB(PG8_SB(0, 1), cB + hstepB); PG8_STAGEA(PG8_SA(0, 0), cA); PG8_STAGEA(PG8_SA(0, 1), cA + hstepA);
        if (wr == 1) PG8_BAR;
        PG8_WAIT_V(2); PG8_BAR;
        PG8_STAGEB(PG8_SB(1, 0), cB + kstep); PG8_STAGEA(PG8_SA(1, 0), cA + kstep); PG8_STAGEB(PG8_SB(1, 1), cB + hstepB + kstep);
        PG8_WAIT_V(6); PG8_BAR;
    } else {
        PG8_STAGEB(PG8_SB(0, 0), cB); PG8_STAGEA(PG8_SA(0, 0), cA); PG8_STAGEB(PG8_SB(0, 1), cB + hstepB); PG8_STAGEA(PG8_SA(0, 1), cA + hstepA);
        if (wr == 1) PG8_BAR;
        PG8_WAIT_V(4); PG8_BAR;
        PG8_STAGEB(PG8_SB(1, 0), cB + kstep); PG8_STAGEA(PG8_SA(1, 0), cA + kstep); PG8_STAGEB(PG8_SB(1, 1), cB + hstepB + kstep);
        PG8_WAIT_V(6); PG8_BAR;
    }
    for (;;) {
        const bool has_next = S.next(ui + 1, nxt);
        const unsigned nA = has_next ? (unsigned)nxt.pm * (unsigned)tstepA : cA, nB = has_next ? (unsigned)nxt.pn * (unsigned)tstepB : cB;
        for (int t = 0; t < nt; t += 2) {
            const bool last = (t == nt - 2);
            const unsigned a1 = cA + (unsigned)(t + 1) * (unsigned)kstep;
            const unsigned a2 = last ? nA : cA + (unsigned)(t + 2) * (unsigned)kstep, b2 = last ? nB : cB + (unsigned)(t + 2) * (unsigned)kstep;
            const unsigned a3 = a2 + (unsigned)kstep, b3 = b2 + (unsigned)kstep;
            if (last && has_next) S.a_ready(nxt);
            if constexpr (SP2) {
            PG8_LDB(B0, 0, 0); PG8_LDB(B1, 0, 1); PG8_SCHED; PG8_LDA(At, 0, 0); PG8_STAGEA(PG8_SA(1, 1), a1 + hstepA);
            PG8_WAIT_V(8); PG8_WAIT_L(0); PG8_BAR; PG8_MMA(0, 0, At, B0); PG8_MMA(0, 1, At, B1); PG8_BAR; PG8_SCHED;
            PG8_LDA(At, 0, 1); PG8_STAGEB(PG8_SB(0, 0), b2); PG8_STAGEB(PG8_SB(0, 1), b2 + hstepB); PG8_STAGEA(PG8_SA(0, 0), a2);
            PG8_WAIT_V(8); PG8_WAIT_L(0); PG8_BAR; PG8_MMA(1, 0, At, B0); PG8_MMA(1, 1, At, B1); PG8_BAR; PG8_SCHED;
            PG8_LDB(B0, 1, 0); PG8_LDB(B1, 1, 1); PG8_SCHED; PG8_LDA(At, 1, 0); PG8_STAGEA(PG8_SA(0, 1), a2 + hstepA);
            PG8_WAIT_V(8); PG8_WAIT_L(0); PG8_BAR; PG8_MMA(0, 0, At, B0); PG8_MMA(0, 1, At, B1); PG8_BAR; PG8_SCHED;
            PG8_LDA(At, 1, 1); PG8_STAGEB(PG8_SB(1, 0), b3); PG8_STAGEB(PG8_SB(1, 1), b3 + hstepB); PG8_STAGEA(PG8_SA(1, 0), a3);
            PG8_WAIT_V(8); PG8_WAIT_L(0); PG8_BAR; PG8_MMA(1, 0, At, B0); PG8_MMA(1, 1, At, B1); PG8_BAR; PG8_SCHED;
            } else {
            PG8_LDB(B0, 0, 0); PG8_SCHED; PG8_LDA(At, 0, 0); PG8_STAGEA(PG8_SA(1, 1), a1 + hstepA);
            PG8_WAIT_L(8); PG8_BAR; PG8_WAIT_L(0); PG8_MMA(0, 0, At, B0); PG8_BAR; PG8_SCHED;
            PG8_LDB(B1, 0, 1); PG8_STAGEB(PG8_SB(0, 0), b2);
            PG8_BAR; PG8_WAIT_L(0); PG8_MMA(0, 1, At, B1); PG8_BAR;
            PG8_LDA(At, 0, 1); PG8_STAGEA(PG8_SA(0, 0), a2);
            PG8_BAR; PG8_WAIT_L(0); PG8_MMA(1, 0, At, B0); PG8_BAR; PG8_SCHED;
            PG8_STAGEB(PG8_SB(0, 1), b2 + hstepB);
            PG8_WAIT_V(6); PG8_BAR; PG8_MMA(1, 1, At, B1); PG8_BAR;
            PG8_LDB(B0, 1, 0); PG8_SCHED; PG8_LDA(At, 1, 0); PG8_STAGEA(PG8_SA(0, 1), a2 + hstepA);
            PG8_WAIT_L(8); PG8_BAR; PG8_WAIT_L(0); PG8_MMA(0, 0, At, B0); PG8_BAR; PG8_SCHED;
            PG8_LDB(B1, 1, 1); PG8_STAGEB(PG8_SB(1, 0), b3);
            PG8_BAR; PG8_WAIT_L(0); PG8_MMA(0, 1, At, B1); PG8_BAR;
            PG8_LDA(At, 1, 1); PG8_STAGEA(PG8_SA(1, 0), a3);
            PG8_BAR; PG8_WAIT_L(0); PG8_MMA(1, 0, At, B0); PG8_BAR; PG8_SCHED;
            PG8_STAGEB(PG8_SB(1, 1), b3 + hstepB);
            PG8_WAIT_V(6); PG8_BAR; PG8_MMA(1, 1, At, B1); PG8_BAR;
            }
        }
        if constexpr (ALIGN_EPI) { if (wr == 0) PG8_BAR; }
        if constexpr (!Epi::AFTER_DRAIN) { E(acc, cur, ui, wr, wc, fr, fq); S.done(cur); }
        if (!has_next) break;
#pragma unroll
        for (int a = 0; a < 2; ++a)
#pragma unroll
            for (int b = 0; b < 2; ++b)
#pragma unroll
                for (int m = 0; m < 4; ++m)
#pragma unroll
                    for (int n = 0; n < 2; ++n) acc[a][b][m][n] = (f32x4){0.f, 0.f, 0.f, 0.f};
        cur = nxt; cA = nA; cB = nB; ++ui;
        if constexpr (ALIGN_EPI) { if (wr == 1) PG8_BAR; }
    }
    PG8_WAIT_V(0);
    if constexpr (!ALIGN_EPI) { if (wr == 0) PG8_BAR; }
    PG8_BAR;
    if constexpr (Epi::AFTER_DRAIN) { E.fused(acc, cur, wr, wc, fr, fq, lds, wid, lane); S.done(cur); }
#undef PG8_SA
#undef PG8_SB
#undef PG8_STAGE_
#undef PG8_STAGEA
#undef PG8_STAGEB
#undef PG8_LDA
#undef PG8_LDB
#undef PG8_MMA
#undef PG8_WAIT_V
#undef PG8_WAIT_L
#undef PG8_BAR
#undef PG8_SCHED
}
}
#ifndef PG8_SP2
#define PG8_SP2 true
#endif
#ifndef PG8_ALIGN
#define PG8_ALIGN true
#endif
constexpr int NWAVES = 8;
constexpr int BATCH = 2, T = 8192, D = 1024, H = 16, HD = 64, FF = 2816, HKV = 4;
constexpr int M = BATCH * T;
constexpr int NQKV = 3 * D, NNSA_SRC = 2608, NNSA = 2816, NFFI = 2 * FF, PLE = 256;
constexpr int NCMP = 511, CMPH = 256, CMPK = 2048;
constexpr float RMS_EPS = 1e-6f;
constexpr size_t MiB = 1u << 20;
constexpr size_t WS_CTL = 0, CTL_ZERO_BYTES = 1 * MiB;
constexpr size_t WS_WQKV = 2 * MiB;
constexpr size_t WS_WO0  = WS_WQKV + (size_t)NQKV * D * 2;
constexpr size_t WS_WFI0 = WS_WO0 + (size_t)D * D * 2;
constexpr size_t WS_WFO0 = WS_WFI0 + (size_t)NFFI * D * 2;
constexpr size_t WS_WG0  = WS_WFO0 + (size_t)D * FF * 2;
constexpr size_t WS_WP0  = WS_WG0 + (size_t)D * D * 2;
constexpr size_t WS_WNSA = WS_WP0 + (size_t)D * PLE * 2;
constexpr size_t WS_WO1  = WS_WNSA + (size_t)NNSA * D * 2;
constexpr size_t WS_WFI1 = WS_WO1 + (size_t)D * D * 2;
constexpr size_t WS_WFO1 = WS_WFI1 + (size_t)NFFI * D * 2;
constexpr size_t WS_WG1  = WS_WFO1 + (size_t)D * FF * 2;
constexpr size_t WS_WP1  = WS_WG1 + (size_t)D * D * 2;
constexpr size_t WS_WCK  = WS_WP1 + (size_t)D * PLE * 2;
constexpr size_t WS_WCV  = WS_WCK + (size_t)CMPH * CMPK * 2;
constexpr size_t WS_WEND = WS_WCV + (size_t)CMPH * CMPK * 2;
static_assert(WS_WEND <= 58 * MiB, "weights");
constexpr size_t WS_HB   = 58 * MiB;
constexpr size_t WS_KSELF = WS_HB, WS_VSELF = WS_HB + 8 * MiB;
constexpr size_t WS_SLAB = WS_HB + 16 * MiB;
constexpr size_t WS_PARKG = WS_HB + 16 * MiB;
constexpr size_t WS_KWINF = 110 * MiB, WS_VWINF = 118 * MiB;
constexpr size_t WS_KCF = 126 * MiB, WS_VCF = 126 * MiB + 512 * 1024;
constexpr size_t WS_SSQ0 = 90 * MiB, WS_SSQ1 = 91 * MiB;
constexpr size_t WS_MISC = 93 * MiB;
constexpr size_t WS_KCVC = 92 * MiB;
constexpr size_t WS_PB   = 94 * MiB;
constexpr size_t WS_QO   = 128 * MiB;
constexpr size_t WS_K0   = 160 * MiB, WS_V0 = 192 * MiB;
constexpr size_t WS_ACT  = 128 * MiB;
constexpr size_t WS_PP   = 224 * MiB;
constexpr size_t WS_KV1  = 160 * MiB;
constexpr size_t KVSZ    = (size_t)BATCH * HKV * T * HD;
constexpr size_t WS_GATES = 208 * MiB;
constexpr size_t WS_SPARE = 212 * MiB;
constexpr size_t WS_END  = 256 * MiB;
static_assert(WS_ACT + (size_t)M * FF * 2 <= WS_PP && WS_SPARE + 32 * MiB <= WS_END, "ws map");
constexpr int CW_TMO = 0, CW_CODE = 1;
constexpr int CW_BAR = 4096;
constexpr int CW_PANEL = 16384;
constexpr int RING_OFF = 0, RING_BYTES = 131072;
constexpr int LDS_BYTES = 148480;
constexpr int LDSCTL_OFF = LDS_BYTES - 512, MISC_OFF = LDSCTL_OFF + 320;
static_assert(MISC_OFF + 128 <= LDS_BYTES, "LDS map");

#define GAS __attribute__((address_space(1)))
#define LAS __attribute__((address_space(3)))
typedef unsigned short bf16;
typedef unsigned v4u __attribute__((ext_vector_type(4)));
typedef float f32x4 __attribute__((ext_vector_type(4)));
typedef short bf16x8 __attribute__((ext_vector_type(8)));
typedef unsigned u32x4_t __attribute__((ext_vector_type(4)));
typedef unsigned u32x2_t __attribute__((ext_vector_type(2)));
typedef GAS unsigned gu32;
typedef GAS unsigned long long gu64;
#define RLX_AGENT __ATOMIC_RELAXED, __HIP_MEMORY_SCOPE_AGENT
#define LDS_WAIT() asm volatile("s_waitcnt lgkmcnt(0)" ::: "memory")
#define VM_WAIT() asm volatile("s_waitcnt vmcnt(0)" ::: "memory")
__device__ __forceinline__ unsigned long long rt() { return __builtin_amdgcn_s_memrealtime(); }
__device__ __forceinline__ unsigned f2bf(float f) { unsigned u = __builtin_bit_cast(unsigned, f); return (u + 0x7fffu + ((u >> 16) & 1u)) >> 16; }
__device__ __forceinline__ unsigned pk2(float lo, float hi) { return f2bf(lo) | (f2bf(hi) << 16); }

#define XB_TMO      128
#define XB_XCNT(j)  (256  + 64 * (j))
#define XB_XSUB(j)  (1280 + 64 * (j))
#define XB_XGEN(j)  (2304 + 64 * (j))
#define XB_TOP      3328
#define XB_TOPGEN   3392
#define XCD_BAR_WORDS 3456
#define XB_SPIN_CAP (1u << 18)

__device__ __forceinline__ unsigned xb_ld(unsigned* p)              { return __hip_atomic_load(p, __ATOMIC_RELAXED, __HIP_MEMORY_SCOPE_AGENT); }
__device__ __forceinline__ unsigned xb_add(unsigned* p, unsigned v) { return __hip_atomic_fetch_add(p, v, __ATOMIC_RELAXED, __HIP_MEMORY_SCOPE_AGENT); }
__device__ __forceinline__ unsigned xb_xcc_id() { return (unsigned)__builtin_amdgcn_s_getreg((3 << 11) | 20) & 0xFu; }
#define XB_SPIN(cond, bar) do { unsigned _sp = 0; while (cond) { __builtin_amdgcn_s_sleep(1); \
    if ((++_sp & 255u) == 0u) { if (xb_ld(&(bar)[XB_TMO])) break; if (_sp > XB_SPIN_CAP) { atomicAdd(&(bar)[XB_TMO], 1u); break; } } } } while (0)

struct XcdBarrier {
    unsigned* bar; unsigned x;
    volatile LAS unsigned* st;
};

__device__ __forceinline__ XcdBarrier xcd_barrier_post(unsigned* bar, volatile LAS unsigned* st) {
    XcdBarrier b; b.bar = bar; b.x = xb_xcc_id(); b.st = st;
    if (threadIdx.x == 0) (void)xb_add(&bar[XB_XCNT(b.x)], 1u);
    return b;
}
__device__ __forceinline__ void xcd_barrier_complete(unsigned* bar, unsigned x, unsigned& nloc, unsigned& nx) {
    const unsigned G = gridDim.x * gridDim.y * gridDim.z;
    unsigned sum, cnt, mine, sp = 0u;
    for (;;) {
        sum = 0u; cnt = 0u; mine = 0u;
#pragma unroll
        for (unsigned j = 0; j < 16; ++j) { const unsigned c = xb_ld(&bar[XB_XCNT(j)]); sum += c; cnt += (c > 0u) ? 1u : 0u; }
        mine = xb_ld(&bar[XB_XCNT(x)]);
        if (sum == G) break;
        __builtin_amdgcn_s_sleep(1);
        if ((++sp & 255u) == 0u) { if (xb_ld(&bar[XB_TMO])) break; if (sp > XB_SPIN_CAP) { atomicAdd(&bar[XB_TMO], 1u); break; } }
    }
    nloc = mine > 0u ? mine : 1u; nx = cnt > 0u ? cnt : 1u;
}

__device__ __forceinline__ void xcd_barrier(const XcdBarrier& b) {
    asm volatile("s_waitcnt vmcnt(0)" ::: "memory");
    __syncthreads();
    if (threadIdx.x == 0) {
        unsigned* bar = b.bar;
        __builtin_amdgcn_s_waitcnt(0);
        unsigned nloc = b.st[0], nx = b.st[1];
        if (nloc == 0u) { xcd_barrier_complete(bar, b.x, nloc, nx); b.st[0] = nloc; b.st[1] = nx; }
        const unsigned old = xb_add(&bar[XB_XSUB(b.x)], 1u);
        const unsigned gen = old / nloc;
        if (old + 1u == (gen + 1u) * nloc) {
            __builtin_amdgcn_fence(__ATOMIC_RELEASE, "agent");
            asm volatile("s_waitcnt vmcnt(0)" ::: "memory");
            const unsigned og = xb_add(&bar[XB_TOP], 1u);
            const unsigned tg = og / nx;
            if (og + 1u == (tg + 1u) * nx) xb_add(&bar[XB_TOPGEN], 1u);
            else XB_SPIN(xb_ld(&bar[XB_TOPGEN]) == tg, bar);
            __builtin_amdgcn_fence(__ATOMIC_ACQUIRE, "agent");
            xb_add(&bar[XB_XGEN(b.x)], 1u);
            asm volatile("s_waitcnt vmcnt(0)" ::: "memory");
        } else {
            XB_SPIN(xb_ld(&bar[XB_XGEN(b.x)]) == gen, bar);
            __builtin_amdgcn_fence(__ATOMIC_ACQUIRE, "agent");
            asm volatile("s_waitcnt vmcnt(0)" ::: "memory");
        }
    }
    __syncthreads();
}
struct Frame {
    LAS unsigned char* lds;
    int tid, lane, wave;
    int vcu, G;
};
struct Args { const float* in[21]; float* out; unsigned char* ws; };
typedef const __attribute__((address_space(4))) Args* ArgsP;
__device__ __forceinline__ ArgsP kargs() { ArgsP p = (ArgsP)__builtin_amdgcn_kernarg_segment_ptr(); asm volatile("" : "+s"(p)); return p; }
__device__ __forceinline__ float wave_sum(float v) {
#pragma unroll
    for (int o = 1; o < 64; o <<= 1) v += __shfl_xor(v, o);
    return v;
}
__device__ __forceinline__ float wave_max(float v) {
#pragma unroll
    for (int o = 1; o < 64; o <<= 1) v = fmaxf(v, __shfl_xor(v, o));
    return v;
}
__device__ __forceinline__ unsigned long long wave_max_u64(unsigned long long v) {
#pragma unroll
    for (int o = 1; o < 64; o <<= 1) { const unsigned lo = __shfl_xor((unsigned)v, o), hi = __shfl_xor((unsigned)(v >> 32), o); const unsigned long long w = ((unsigned long long)hi << 32) | lo; v = w > v ? w : v; }
    return v;
}
__device__ __forceinline__ float dpp_xor1(float v) { return __uint_as_float(__builtin_amdgcn_update_dpp(0u, __float_as_uint(v), 0xB1, 0xF, 0xF, false)); }
__device__ __forceinline__ float dpp_xor2(float v) { return __uint_as_float(__builtin_amdgcn_update_dpp(0u, __float_as_uint(v), 0x4E, 0xF, 0xF, false)); }
__device__ __forceinline__ float swap32(float v) { auto rr = __builtin_amdgcn_permlane32_swap(__float_as_uint(v), __float_as_uint(v), false, false); return __uint_as_float((threadIdx.x & 32) ? rr[0] : rr[1]); }
__device__ __forceinline__ float bflo(unsigned u) { return __uint_as_float(u << 16); }
__device__ __forceinline__ float bfhi(unsigned u) { return __uint_as_float(u & 0xffff0000u); }
__device__ __forceinline__ float bf2f(bf16 u) { return __uint_as_float((unsigned)u << 16); }

template <int MAP> __device__ __forceinline__ void conv_item(const float* W, int K, int Nsrc, int Ndst, const float* gain, bf16* WT, LAS float* scr, int item, int lane) {
    const int nblk = Ndst / 32, kb = item / nblk, nb = item % nblk, k0 = 64 * kb, n0 = 32 * nb;
    const int u = lane & 7; int sc, r0;
    if (MAP == 2) { sc = ((n0 & 128) ? FF : 0) + 128 * (n0 >> 8) + (n0 & 127) + 4 * u; r0 = 4 * u; }
    else { sc = n0 + 4 * u; r0 = 4 * u; if (MAP == 1 && sc >= Nsrc) sc = -1; }
    f32x4 v[8];
#pragma unroll
    for (int i = 0; i < 8; ++i) { const int kk = (lane >> 3) + 8 * i; v[i] = sc >= 0 ? *(const GAS f32x4*)(W + (size_t)(k0 + kk) * Nsrc + sc) : (f32x4){0.f, 0.f, 0.f, 0.f}; }
    if (gain) {
#pragma unroll
        for (int i = 0; i < 8; ++i) v[i] = v[i] * gain[k0 + (lane >> 3) + 8 * i]; }
#pragma unroll
    for (int i = 0; i < 8; ++i) { const int kk = (lane >> 3) + 8 * i; LAS float* d = scr + kk * 33 + r0; d[0] = v[i].x; d[1] = v[i].y; d[2] = v[i].z; d[3] = v[i].w; }
    LDS_WAIT(); asm volatile("" ::: "memory");
    const int c = lane & 7;
#pragma unroll
    for (int j = 0; j < 4; ++j) { const int n = (lane >> 3) + 8 * j; const LAS float* s = scr + (8 * c) * 33 + n;
        v4u o; o.x = pk2(s[0 * 33], s[1 * 33]); o.y = pk2(s[2 * 33], s[3 * 33]); o.z = pk2(s[4 * 33], s[5 * 33]); o.w = pk2(s[6 * 33], s[7 * 33]);
        *(GAS v4u*)(WT + (size_t)(n0 + n) * K + k0 + 8 * c) = o; }
    LDS_WAIT(); asm volatile("" ::: "memory");
}
#define WSP(T_, off) ((T_*)(ap->ws + (off)))
__device__ __forceinline__ void p0_prologue(Frame& F) {
    ArgsP ap = kargs();
    LAS float* scr = (LAS float*)(F.lds + RING_OFF + F.wave * 16384);
    const int gw = F.vcu * NWAVES + F.wave, NGW = F.G * NWAVES;
    constexpr int I_QKV = (D / 64) * (NQKV / 32), I_DD = (D / 64) * (D / 32), I_FI = (D / 64) * (NFFI / 32), I_FO = (FF / 64) * (D / 32), I_P = (PLE / 64) * (D / 32),
                  I_NSA = (D / 64) * (NNSA / 32), I_C = (CMPK / 64) * (CMPH / 32);
    constexpr int NITEMS = I_QKV + I_DD + I_FI + I_FO + I_DD + I_P + I_NSA + I_DD + I_FI + I_FO + I_DD + I_P + I_C + I_C;
    for (int it = gw; it < NITEMS; it += NGW) {
        int r = it;
        if (r < I_QKV) { conv_item<0>(ap->in[7], D, NQKV, NQKV, ap->in[3], WSP(bf16, WS_WQKV), scr, r, F.lane); continue; } r -= I_QKV;
        if (r < I_DD)  { conv_item<0>(ap->in[8], D, D, D, nullptr, WSP(bf16, WS_WO0), scr, r, F.lane); continue; } r -= I_DD;
        if (r < I_FI)  { conv_item<2>(ap->in[17], D, NFFI, NFFI, ap->in[4], WSP(bf16, WS_WFI0), scr, r, F.lane); continue; } r -= I_FI;
        if (r < I_FO)  { conv_item<0>(ap->in[18], FF, D, D, nullptr, WSP(bf16, WS_WFO0), scr, r, F.lane); continue; } r -= I_FO;
        if (r < I_DD)  { conv_item<0>(ap->in[20], D, D, D, ap->in[5], WSP(bf16, WS_WG0), scr, r, F.lane); continue; } r -= I_DD;
        if (r < I_P)   { conv_item<0>(ap->in[19], PLE, D, D, nullptr, WSP(bf16, WS_WP0), scr, r, F.lane); continue; } r -= I_P;
        if (r < I_NSA) { conv_item<1>(ap->in[9], D, NNSA_SRC, NNSA, ap->in[3] + D, WSP(bf16, WS_WNSA), scr, r, F.lane); continue; } r -= I_NSA;
        if (r < I_DD)  { conv_item<0>(ap->in[10], D, D, D, nullptr, WSP(bf16, WS_WO1), scr, r, F.lane); continue; } r -= I_DD;
        if (r < I_FI)  { conv_item<2>(ap->in[17] + (size_t)D * NFFI, D, NFFI, NFFI, ap->in[4] + D, WSP(bf16, WS_WFI1), scr, r, F.lane); continue; } r -= I_FI;
        if (r < I_FO)  { conv_item<0>(ap->in[18] + (size_t)FF * D, FF, D, D, nullptr, WSP(bf16, WS_WFO1), scr, r, F.lane); continue; } r -= I_FO;
        if (r < I_DD)  { conv_item<0>(ap->in[20] + (size_t)D * D, D, D, D, ap->in[5] + D, WSP(bf16, WS_WG1), scr, r, F.lane); continue; } r -= I_DD;
        if (r < I_P)   { conv_item<0>(ap->in[19] + (size_t)PLE * D, PLE, D, D, nullptr, WSP(bf16, WS_WP1), scr, r, F.lane); continue; } r -= I_P;
        if (r < I_C)   { conv_item<0>(ap->in[13], CMPK, CMPH, CMPH, nullptr, WSP(bf16, WS_WCK), scr, r, F.lane); continue; } r -= I_C;
        conv_item<0>(ap->in[15], CMPK, CMPH, CMPH, nullptr, WSP(bf16, WS_WCV), scr, r, F.lane);
    }
    {
        bf16* hb = WSP(bf16, WS_HB); float* ssq = WSP(float, WS_SSQ0);
        for (int m = gw; m < M; m += NGW) {
            const GAS f32x4* xr = (const GAS f32x4*)(ap->in[0] + (size_t)m * D) + F.lane; f32x4 v[4]; float s = 0.f;
#pragma unroll
            for (int j = 0; j < 4; ++j) { v[j] = xr[64 * j]; s += (v[j].x * v[j].x + v[j].y * v[j].y) + (v[j].z * v[j].z + v[j].w * v[j].w); }
            s = wave_sum(s);
            GAS unsigned long long* o8 = (GAS unsigned long long*)(hb + (size_t)m * D) + F.lane;
#pragma unroll
            for (int j = 0; j < 4; ++j) o8[64 * j] = (unsigned long long)pk2(v[j].x, v[j].y) | ((unsigned long long)pk2(v[j].z, v[j].w) << 32);
            if (F.lane < 16) ssq[(size_t)m * 16 + F.lane] = F.lane == 0 ? s : 0.f;
        }
    }
    {
        const GAS f32x4* p4 = (const GAS f32x4*)ap->in[1]; GAS unsigned long long* o8 = (GAS unsigned long long*)WSP(bf16, WS_PB);
        const int NI = 2 * M * PLE / 4; const int gt = F.vcu * (NWAVES * 64) + F.tid, NTH = F.G * NWAVES * 64;
        for (int i = gt; i < NI; i += NTH) { const f32x4 v = p4[i]; o8[i] = (unsigned long long)pk2(v.x, v.y) | ((unsigned long long)pk2(v.z, v.w) << 32); }
    }
    {
        float* b1p = WSP(float, WS_MISC);
        for (int it = gw; it < 64; it += NGW) { const int which = it >> 5, c = (it >> 2) & 7, jb = it & 3, j = jb * 64 + F.lane;
            const float* pe = which ? ap->in[12] : ap->in[11]; const float* w1 = which ? ap->in[15] : ap->in[13]; float a = 0.f;
            for (int kk = c * 256; kk < c * 256 + 256; ++kk) a += pe[kk] * w1[(size_t)kk * CMPH + j];
            b1p[(which * 8 + c) * 256 + j] = a; }
    }
}

__device__ __forceinline__ int t5_bucket(int n) {
    if (n < 16) return n < 0 ? 0 : n;
    if (n >= 113) return 31;
    return 16 + (n >= 19) + (n >= 21) + (n >= 24) + (n >= 27) + (n >= 31) + (n >= 35) + (n >= 40) + (n >= 46) + (n >= 52) + (n >= 59) + (n >= 67) + (n >= 77) + (n >= 87) + (n >= 99);
}
__device__ __forceinline__ void load_q64(float (&q)[64], const bf16* p) {
    const uint4* p4 = (const uint4*)p;
#pragma unroll
    for (int i = 0; i < 8; ++i) { const uint4 w = p4[i]; q[8 * i + 0] = bflo(w.x); q[8 * i + 1] = bfhi(w.x); q[8 * i + 2] = bflo(w.y); q[8 * i + 3] = bfhi(w.y);
        q[8 * i + 4] = bflo(w.z); q[8 * i + 5] = bfhi(w.z); q[8 * i + 6] = bflo(w.w); q[8 * i + 7] = bfhi(w.w); }
}
__device__ __forceinline__ float dot64(const float (&q)[64], const bf16* p) {
    const uint4* p4 = (const uint4*)p; float a = 0.f;
#pragma unroll
    for (int i = 0; i < 8; ++i) { const uint4 w = p4[i];
        a += q[8 * i + 0] * bflo(w.x); a += q[8 * i + 1] * bfhi(w.x); a += q[8 * i + 2] * bflo(w.y); a += q[8 * i + 3] * bfhi(w.y);
        a += q[8 * i + 4] * bflo(w.z); a += q[8 * i + 5] * bfhi(w.z); a += q[8 * i + 6] * bflo(w.w); a += q[8 * i + 7] * bfhi(w.w); }
    return a;
}
__device__ __forceinline__ void sb_simple(Frame& F) {
    ArgsP ap = kargs();
    bf16* QO = WSP(bf16, WS_QO); const bf16* Kh = WSP(bf16, WS_K0); const bf16* Vh = WSP(bf16, WS_V0);
    const int gt = F.vcu * (NWAVES * 64) + F.tid, NTH = F.G * NWAVES * 64;
    for (int it = gt; it < BATCH * H * T; it += NTH) {
        const int t = it & (T - 1), h = (it >> 13) & 15, b = it >> 17;
        bf16* qp = QO + ((size_t)(b * T + t)) * D + h * HD;
        float q[64]; load_q64(q, qp);
        float o[64];
#pragma unroll
        for (int d = 0; d < 64; ++d) o[d] = 0.f;
        const bf16* kp = Kh + ((size_t)(b * H + h) * T) * HD; const bf16* vp = Vh + ((size_t)(b * H + h) * T) * HD;
        float carry = 0.f;
        for (int s = t - 1; s >= 0; --s) {
            const float z = dot64(q, kp + (size_t)s * HD);
            const float sp = fmaxf(z, 0.f) + log1pf(expf(-fabsf(z)));
            const float a = expf((z - sp) + carry);
            const uint4* v4 = (const uint4*)(vp + (size_t)s * HD);
#pragma unroll
            for (int i = 0; i < 8; ++i) { const uint4 w = v4[i];
                o[8 * i + 0] += a * bflo(w.x); o[8 * i + 1] += a * bfhi(w.x); o[8 * i + 2] += a * bflo(w.y); o[8 * i + 3] += a * bfhi(w.y);
                o[8 * i + 4] += a * bflo(w.z); o[8 * i + 5] += a * bfhi(w.z); o[8 * i + 6] += a * bflo(w.w); o[8 * i + 7] += a * bfhi(w.w); }
            carry -= sp;
            if (carry < -104.f) break;
        }
        uint4* o4 = (uint4*)qp;
#pragma unroll
        for (int i = 0; i < 8; ++i) { uint4 w; w.x = pk2(o[8 * i + 0], o[8 * i + 1]); w.y = pk2(o[8 * i + 2], o[8 * i + 3]); w.z = pk2(o[8 * i + 4], o[8 * i + 5]); w.w = pk2(o[8 * i + 6], o[8 * i + 7]); o4[i] = w; }
    }
}
typedef _Float16 f16x8 __attribute__((ext_vector_type(8)));
typedef float f32x16 __attribute__((ext_vector_type(16)));
typedef short v4i16_t __attribute__((ext_vector_type(4)));
__device__ __forceinline__ bf16x8 tr_pair(const LAS unsigned char* p0, const LAS unsigned char* p1) {
    const v4i16_t lo = __builtin_amdgcn_ds_read_tr16_b64_v4i16((LAS v4i16_t*)p0), hi = __builtin_amdgcn_ds_read_tr16_b64_v4i16((LAS v4i16_t*)p1);
    return (bf16x8){lo[0], lo[1], lo[2], lo[3], hi[0], hi[1], hi[2], hi[3]};
}
__device__ __forceinline__ unsigned pkbf(float lo, float hi) { typedef float f2 __attribute__((ext_vector_type(2))); typedef __bf16 b2 __attribute__((ext_vector_type(2))); f2 v = {lo, hi}; b2 b = __builtin_convertvector(v, b2); return __builtin_bit_cast(unsigned, b); }
__device__ __forceinline__ void sb_mfma(Frame& F, size_t out_off = WS_QO) {
    ArgsP ap = kargs();
    LAS unsigned char* vl = F.lds + RING_OFF + F.wave * 16384;
    const int lane = F.lane, c = lane & 31, hh = lane >> 5;
    bf16* QO = WSP(bf16, WS_QO); const bf16* Kh = WSP(bf16, WS_K0); const bf16* Vh = WSP(bf16, WS_V0);
    f16x8 U0, U1;
    { u32x4_t w0, w1; unsigned short e0[8], e1[8];
#pragma unroll
      for (int j = 0; j < 8; ++j) { const int k0 = 8 * (j >> 2) + 4 * hh + (j & 3); e0[j] = (k0 > c) ? 0x3C00 : 0; e1[j] = (16 + k0 > c) ? 0x3C00 : 0; }
      w0.x = e0[0] | ((unsigned)e0[1] << 16); w0.y = e0[2] | ((unsigned)e0[3] << 16); w0.z = e0[4] | ((unsigned)e0[5] << 16); w0.w = e0[6] | ((unsigned)e0[7] << 16);
      w1.x = e1[0] | ((unsigned)e1[1] << 16); w1.y = e1[2] | ((unsigned)e1[3] << 16); w1.z = e1[4] | ((unsigned)e1[5] << 16); w1.w = e1[6] | ((unsigned)e1[7] << 16);
      U0 = __builtin_bit_cast(f16x8, w0); U1 = __builtin_bit_cast(f16x8, w1); }
    const LAS unsigned char* vrd = vl + (4 * hh + ((lane & 15) >> 2)) * 128 + (16 * ((lane >> 4) & 1) + 4 * (lane & 3)) * 2;
    LAS unsigned char* vwr = vl + (lane >> 1) * 128 + (lane & 1) * 64;
    const int gw = F.vcu * NWAVES + F.wave, NGW = F.G * NWAVES;
    constexpr float L2E = 1.4426950408889634f, LN2 = 0.6931471805599453f;
    for (int it = gw; it < BATCH * H * (T / 32); it += NGW) {
        const int qt = it & 255, hd = (it >> 8) & 15, b = it >> 12;
        bf16* Qp = QO + ((size_t)(b * T + 32 * qt + c)) * D + hd * HD;
        bf16x8 Qf[4];
#pragma unroll
        for (int ks = 0; ks < 4; ++ks) Qf[ks] = *(const bf16x8*)(Qp + 16 * ks + 8 * hh);
        const bf16* Kb = Kh + ((size_t)(b * H + hd) * T) * HD; const bf16* Vb = Vh + ((size_t)(b * H + hd) * T) * HD;
        f32x16 O0, O1;
#pragma unroll
        for (int r = 0; r < 16; ++r) { O0[r] = 0.f; O1[r] = 0.f; }
        float carry = 0.f;
        bf16x8 Kn[4]; u32x4_t Vn[4];
        { const bf16* kp = Kb + (size_t)(32 * qt + c) * HD + 8 * hh; const bf16* vp = Vb + (size_t)(32 * qt + (lane >> 1)) * HD + (lane & 1) * 32;
#pragma unroll
          for (int i = 0; i < 4; ++i) { Kn[i] = *(const bf16x8*)(kp + 16 * i); Vn[i] = *(const u32x4_t*)(vp + 8 * i); } }
        for (int kt = qt; kt >= 0; --kt) {
            bf16x8 Kc[4]; u32x4_t Vc[4];
#pragma unroll
            for (int i = 0; i < 4; ++i) { Kc[i] = Kn[i]; Vc[i] = Vn[i]; }
            { const int kn = kt > 0 ? kt - 1 : 0; const bf16* kp = Kb + (size_t)(32 * kn + c) * HD + 8 * hh; const bf16* vp = Vb + (size_t)(32 * kn + (lane >> 1)) * HD + (lane & 1) * 32;
#pragma unroll
                for (int i = 0; i < 4; ++i) { Kn[i] = *(const bf16x8*)(kp + 16 * i); Vn[i] = *(const u32x4_t*)(vp + 8 * i); } }
#pragma unroll
            for (int i = 0; i < 4; ++i) *(LAS u32x4_t*)(vwr + 16 * i) = Vc[i];
            f32x16 z;
#pragma unroll
            for (int r = 0; r < 16; ++r) z[r] = 0.f;
#pragma unroll
            for (int ks = 0; ks < 4; ++ks) z = __builtin_amdgcn_mfma_f32_32x32x16_bf16(Kc[ks], Qf[ks], z, 0, 0, 0);
            const bool diag = kt == qt;
            float lf[16], ls[16]; float tot = 0.f;
#pragma unroll
            for (int r = 0; r < 16; ++r) { const int key = (r & 3) + 8 * (r >> 2) + 4 * hh; const bool valid = !diag || key < c; const float zz = z[r];
                const float sp = fmaxf(zz, 0.f) + LN2 * __builtin_amdgcn_logf(1.0f + __builtin_amdgcn_exp2f(-fabsf(zz) * L2E));
                lf[r] = valid ? -sp : 0.f; ls[r] = valid ? zz - sp : -INFINITY; tot += lf[r]; }
            const f16x8 X0 = {(_Float16)lf[0], (_Float16)lf[1], (_Float16)lf[2], (_Float16)lf[3], (_Float16)lf[4], (_Float16)lf[5], (_Float16)lf[6], (_Float16)lf[7]};
            const f16x8 X1 = {(_Float16)lf[8], (_Float16)lf[9], (_Float16)lf[10], (_Float16)lf[11], (_Float16)lf[12], (_Float16)lf[13], (_Float16)lf[14], (_Float16)lf[15]};
            f32x16 Y;
#pragma unroll
            for (int r = 0; r < 16; ++r) Y[r] = 0.f;
            Y = __builtin_amdgcn_mfma_f32_32x32x16_f16(U0, X0, Y, 0, 0, 0); Y = __builtin_amdgcn_mfma_f32_32x32x16_f16(U1, X1, Y, 0, 0, 0);
            tot += __shfl_xor(tot, 32);
            float a[16];
#pragma unroll
            for (int r = 0; r < 16; ++r) a[r] = __builtin_amdgcn_exp2f((ls[r] + Y[r] + carry) * L2E);
            bf16x8 P0, P1; { u32x4_t w0, w1; w0.x = pkbf(a[0], a[1]); w0.y = pkbf(a[2], a[3]); w0.z = pkbf(a[4], a[5]); w0.w = pkbf(a[6], a[7]); w1.x = pkbf(a[8], a[9]); w1.y = pkbf(a[10], a[11]); w1.z = pkbf(a[12], a[13]); w1.w = pkbf(a[14], a[15]);
                P0 = __builtin_bit_cast(bf16x8, w0); P1 = __builtin_bit_cast(bf16x8, w1); }
            O0 = __builtin_amdgcn_mfma_f32_32x32x16_bf16(tr_pair(vrd, vrd + 8 * 128), P0, O0, 0, 0, 0);
            O0 = __builtin_amdgcn_mfma_f32_32x32x16_bf16(tr_pair(vrd + 16 * 128, vrd + 24 * 128), P1, O0, 0, 0, 0);
            O1 = __builtin_amdgcn_mfma_f32_32x32x16_bf16(tr_pair(vrd + 64, vrd + 64 + 8 * 128), P0, O1, 0, 0, 0);
            O1 = __builtin_amdgcn_mfma_f32_32x32x16_bf16(tr_pair(vrd + 64 + 16 * 128, vrd + 64 + 24 * 128), P1, O1, 0, 0, 0);
            carry += tot;
            if (__all(carry < -104.0f)) break;
        }
#pragma unroll
        for (int rg = 0; rg < 4; ++rg) { u32x2_t w0, w1; w0.x = pkbf(O0[4 * rg], O0[4 * rg + 1]); w0.y = pkbf(O0[4 * rg + 2], O0[4 * rg + 3]); w1.x = pkbf(O1[4 * rg], O1[4 * rg + 1]); w1.y = pkbf(O1[4 * rg + 2], O1[4 * rg + 3]);
            bf16* Op = WSP(bf16, out_off) + ((size_t)(b * T + 32 * qt + c)) * D + hd * HD;
            *(u32x2_t*)(Op + 8 * rg + 4 * hh) = w0; *(u32x2_t*)(Op + 32 + 8 * rg + 4 * hh) = w1; }
    }
}
__device__ __forceinline__ float gelu_tanh(float x) { const float u = 0.7978845608028654f * (x + 0.044715f * x * x * x); return 0.5f * x * (1.0f + tanhf(u)); }
__device__ __forceinline__ void cmp_stage2(Frame& F) {
    ArgsP ap = kargs();
    LAS float* hbuf = (LAS float*)(F.lds + RING_OFF + F.wave * 16384);
    const int gw = F.vcu * NWAVES + F.wave, NGW = F.G * NWAVES;
    const bf16* slab = WSP(bf16, WS_SLAB); const float* b1p = WSP(float, WS_MISC); bf16* kcvc = WSP(bf16, WS_KCVC);
    for (int it = gw; it < 2 * 1024; it += NGW) {
        const int which = it >> 10, r0 = (it & 1023) * 4, tile = r0 >> 8;
        const float* w2 = which ? ap->in[16] : ap->in[14];
        float bias[4];
#pragma unroll
        for (int q = 0; q < 4; ++q) { const int j = F.lane + 64 * q; float bsum = 0.f;
#pragma unroll
            for (int c = 0; c < 8; ++c) bsum += b1p[(which * 8 + c) * 256 + j];
            bias[q] = bsum; }
#pragma unroll
        for (int rw = 0; rw < 4; ++rw) { const int rr = (r0 + rw) & 255;
#pragma unroll
            for (int q = 0; q < 4; ++q) { const int j = F.lane + 64 * q; float pre = bias[q];
#pragma unroll
                for (int ks = 0; ks < 4; ++ks) pre += bf2f(slab[((size_t)((ks * 2 + which) * 16 + tile) * 256 + rr) * 256 + j]);
                hbuf[rw * 256 + j] = gelu_tanh(pre); } }
        LDS_WAIT(); asm volatile("" ::: "memory");
        float a[4] = {0.f, 0.f, 0.f, 0.f};
        const float* w2l = w2 + F.lane;
        float wv[32], wn[32];
#pragma unroll
        for (int u = 0; u < 32; ++u) wv[u] = w2l[u * 64];
#pragma unroll 1
        for (int j0 = 0; j0 < 256; j0 += 32) {
            const int jn = j0 + 32 < 256 ? j0 + 32 : j0;
#pragma unroll
            for (int u = 0; u < 32; ++u) wn[u] = w2l[(jn + u) * 64];
#pragma unroll
            for (int u4 = 0; u4 < 8; ++u4) {
#pragma unroll
                for (int rw = 0; rw < 4; ++rw) { const f32x4 h4 = *(const LAS f32x4*)(hbuf + rw * 256 + j0 + 4 * u4);
                    a[rw] += h4[0] * wv[4 * u4 + 0]; a[rw] += h4[1] * wv[4 * u4 + 1]; a[rw] += h4[2] * wv[4 * u4 + 2]; a[rw] += h4[3] * wv[4 * u4 + 3]; } }
#pragma unroll
            for (int u = 0; u < 32; ++u) wv[u] = wn[u];
        }
#pragma unroll
        for (int rw = 0; rw < 4; ++rw) { const int r = r0 + rw, i = r & 511; const float av = i >= NCMP ? 0.f : a[rw];
            kcvc[((size_t)which * 4096 + r) * 64 + F.lane] = (bf16)f2bf(av);
            const int bh_ = r >> 9, blk = i >> 6, nn = i & 63, d = F.lane;
            if (which == 0) { const int tl = nn >> 5, r32 = nn & 31, ks = d >> 4, h = (d >> 3) & 1, e = d & 7; WSP(bf16, WS_KCF)[(((size_t)(bh_ * 8 + blk) * 8 + 4 * tl + ks) * 64 + r32 + 32 * h) * 8 + e] = (bf16)f2bf(av); }
            else { const int k4 = nn >> 4, kk = nn & 15, e = ((kk >> 3) << 2) | (kk & 3), hA = (kk >> 2) & 1, dt = d >> 5, dp = d & 31; WSP(bf16, WS_VCF)[(((size_t)(bh_ * 8 + blk) * 8 + 4 * dt + k4) * 64 + dp + 32 * hA) * 8 + e] = (bf16)f2bf(av); } }
        LDS_WAIT(); asm volatile("" ::: "memory");
    }
}
__device__ __forceinline__ void nsa_simple(Frame& F, size_t out_off = WS_QO) {
    ArgsP ap = kargs();
    LAS float* pbuf = (LAS float*)(F.lds + RING_OFF + F.wave * 16384);
    LAS float* pg = pbuf + 1024;
    LAS float* obuf = pbuf + 1536;
    LAS int* selb = (LAS int*)(pbuf + 2304);
    const int gw = F.vcu * NWAVES + F.wave, NGW = F.G * NWAVES, lane = F.lane;
    bf16* NQ = WSP(bf16, WS_QO); const bf16* KV = WSP(bf16, WS_KV1); const bf16* KCVC = WSP(bf16, WS_KCVC);
    const float* gates = WSP(float, WS_GATES); const float* rel_bias = ap->in[2];
    for (int it = gw; it < BATCH * HKV * T; it += NGW) {
        const int t = it & (T - 1), hkv = (it >> 13) & 3, b = it >> 15, bh = b * 4 + hkv, cur = t >> 6;
        const bf16* kc = KCVC + (size_t)bh * 512 * 64; const bf16* vc = KCVC + (size_t)4096 * 64 + (size_t)bh * 512 * 64;
        const bf16* ksel = KV + 2 * KVSZ + (size_t)bh * T * HD; const bf16* vsel = KV + 3 * KVSZ + (size_t)bh * T * HD;
        const bf16* kwin = KV + 4 * KVSZ + (size_t)bh * T * HD; const bf16* vwin = KV + 5 * KVSZ + (size_t)bh * T * HD;
        bf16* qrow = NQ + (size_t)(b * T + t) * D + hkv * 256;
        const int nv = t >= 31 ? ((t - 31) >> 4) + 1 : 0;
#pragma unroll 1
        for (int i = 0; i < 8; ++i) pg[lane + 64 * i] = 0.f;
#pragma unroll 1
        for (int g = 0; g < 4; ++g) {
            const int hq = hkv * 4 + g; float qv[64]; load_q64(qv, qrow + g * 64);
            float mx = -INFINITY;
#pragma unroll 1
            for (int i = 0; i < 8; ++i) { const int n = lane + 64 * i;
                const float sc = n < nv ? dot64(qv, kc + (size_t)n * 64) + rel_bias[t5_bucket(t - 16 * n - 31) * 16 + hq] : -INFINITY; pbuf[n] = sc; mx = fmaxf(mx, sc); }
            mx = wave_max(mx); const float mm = mx == -INFINITY ? 0.f : mx; float sum = 0.f;
#pragma unroll 1
            for (int i = 0; i < 8; ++i) { const int n = lane + 64 * i; const float e = n < nv ? expf(pbuf[n] - mm) : 0.f; pbuf[n] = e; sum += e; }
            sum = wave_sum(sum); const float inv = 1.0f / (sum > 0.f ? sum : 1.0f);
#pragma unroll 1
            for (int i = 0; i < 8; ++i) { const int n = lane + 64 * i; const float p = pbuf[n] * inv; pbuf[n] = p; pg[n] += p; }
            LDS_WAIT(); asm volatile("" ::: "memory");
            float a = 0.f;
            for (int n = 0; n < nv; ++n) a += pbuf[n] * bf2f(vc[(size_t)n * 64 + lane]);
            obuf[g * 64 + lane] = a;
            LDS_WAIT(); asm volatile("" ::: "memory");
        }
        unsigned long long key[2];
#pragma unroll
        for (int q = 0; q < 2; ++q) { const int j = lane + 64 * q; float imp = 0.f;
#pragma unroll
            for (int dn = -1; dn <= 3; ++dn) { const int n = 4 * j + dn; if (n >= 0 && n < 512) imp += pg[n]; }
            const bool forced = (j == 0) || (j == cur) || (j == cur - 1); const float val = forced ? 100.0f : imp;
            key[q] = j <= cur ? (((unsigned long long)__float_as_uint(val) << 32) | (unsigned)(128 - j)) : 0ull; }
#pragma unroll 1
        for (int r = 0; r < 16; ++r) { unsigned long long k = key[0] > key[1] ? key[0] : key[1]; k = wave_max_u64(k);
            const int sj = k ? 128 - (int)(unsigned)(k & 0xffffffffull) : -1; if (lane == 0) selb[r] = sj;
            if (k) { if (key[0] == k) key[0] = 0ull; if (key[1] == k) key[1] = 0ull; } }
        LDS_WAIT(); asm volatile("" ::: "memory");
#pragma unroll 1
        for (int g = 0; g < 4; ++g) {
            const int hq = hkv * 4 + g; float qv[64]; load_q64(qv, qrow + g * 64);
            float mx = -INFINITY;
#pragma unroll 1
            for (int r = 0; r < 16; ++r) { const int sj = selb[r]; const int pos = sj * 64 + lane, dist = t - pos;
                const float sc = (sj >= 0 && dist >= 0) ? dot64(qv, ksel + (size_t)pos * 64) + rel_bias[t5_bucket(dist) * 16 + hq] : -INFINITY; pbuf[r * 64 + lane] = sc; mx = fmaxf(mx, sc); }
            mx = wave_max(mx); float sum = 0.f;
#pragma unroll 1
            for (int r = 0; r < 16; ++r) { const float sc = pbuf[r * 64 + lane]; const float e = sc == -INFINITY ? 0.f : expf(sc - mx); pbuf[r * 64 + lane] = e; sum += e; }
            sum = wave_sum(sum); const float inv = 1.0f / sum;
            LDS_WAIT(); asm volatile("" ::: "memory");
            float a = 0.f;
#pragma unroll 1
            for (int r = 0; r < 16; ++r) { const int sj = selb[r]; if (sj < 0) continue; const bf16* vb = vsel + (size_t)sj * 64 * 64 + lane;
                for (int kk = 0; kk < 64; ++kk) a += pbuf[r * 64 + kk] * bf2f(vb[kk * 64]); }
            obuf[256 + g * 64 + lane] = a * inv;
            LDS_WAIT(); asm volatile("" ::: "memory");
            mx = -INFINITY;
#pragma unroll 1
            for (int i = 0; i < 8; ++i) { const int kk = lane + 64 * i, pos = t - 511 + kk;
                const float sc = pos >= 0 ? dot64(qv, kwin + (size_t)pos * 64) + rel_bias[t5_bucket(511 - kk) * 16 + hq] : -INFINITY; pbuf[kk] = sc; mx = fmaxf(mx, sc); }
            mx = wave_max(mx); sum = 0.f;
#pragma unroll 1
            for (int i = 0; i < 8; ++i) { const int kk = lane + 64 * i; const float sc = pbuf[kk]; const float e = sc == -INFINITY ? 0.f : expf(sc - mx); pbuf[kk] = e; sum += e; }
            sum = wave_sum(sum); const float inv2 = 1.0f / sum;
            LDS_WAIT(); asm volatile("" ::: "memory");
            a = 0.f;
            for (int kk = (t >= 511 ? 0 : 511 - t); kk < 512; ++kk) a += pbuf[kk] * bf2f(vwin[(size_t)(t - 511 + kk) * 64 + lane]);
            obuf[512 + g * 64 + lane] = a * inv2;
            LDS_WAIT(); asm volatile("" ::: "memory");
        }
        const float* gr = gates + (size_t)(b * T + t) * 64 + hkv * 4;
#pragma unroll
        for (int g = 0; g < 4; ++g) { const float v = gr[g] * obuf[g * 64 + lane] + gr[16 + g] * obuf[256 + g * 64 + lane] + gr[32 + g] * obuf[512 + g * 64 + lane]; (WSP(bf16, out_off) + (size_t)(b * T + t) * D + hkv * 256)[g * 64 + lane] = (bf16)f2bf(v); }
        LDS_WAIT(); asm volatile("" ::: "memory");
    }
}

constexpr int NSA_KP = 144, NSA_VP = 192;
constexpr int NSA_KBUF = 64 * NSA_KP, NSA_VBUF = 64 * NSA_VP, NSA_BUF = NSA_KBUF + NSA_VBUF;
constexpr int NSA_OFF_IMP = 2 * NSA_BUF;
constexpr int NSA_OFF_BIAS = 126976;
constexpr int NSA_OFF_SEL = NSA_OFF_BIAS + 4 * 128 * 4;
constexpr int NSA_OFF_T1 = NSA_OFF_SEL + 64 * 16;
static_assert(NSA_OFF_IMP + 64 * 128 * 4 <= NSA_OFF_BIAS && NSA_OFF_T1 + 4 * 256 * 4 <= LDSCTL_OFF, "NSA LDS map");
constexpr float NSA_L2E = 1.4426950408889634f;
struct NsaState { f32x16 O0, O1; float m, l; };
__device__ __forceinline__ void nsa_reset(NsaState& s) {
#pragma unroll
    for (int r = 0; r < 16; ++r) { s.O0[r] = 0.f; s.O1[r] = 0.f; }
    s.m = -INFINITY; s.l = 0.f;
}
template <bool NEAR, int MASK, int PASS, bool TB = false, bool KPF = false>
__device__ __forceinline__ void nsa_step_r(NsaState& st, bf16x8 (&Kc)[8], const bf16x8 (&Vc)[8], const LAS unsigned char* Qrow  , int lane, float cbias2, int dbase, int dstep,
                                         const LAS float* biasg, float minv  , float linv  , float (&gs)[8], float (&lastv)[8], const char* knext = nullptr) {
    const int hh = lane >> 5;
    bf16x8 Qf[4];
#pragma unroll
    for (int ks = 0; ks < 4; ++ks) Qf[ks] = *(const LAS bf16x8*)(Qrow + 32 * ks);
    f32x16 S[2];
#pragma unroll
    for (int tl = 0; tl < 2; ++tl) {
#pragma unroll
        for (int r = 0; r < 16; ++r) S[tl][r] = 0.f;
#pragma unroll
        for (int ks = 0; ks < 4; ++ks) S[tl] = __builtin_amdgcn_mfma_f32_32x32x16_bf16(Kc[tl * 4 + ks], Qf[ks], S[tl], 0, 0, 0);
    }
    if (KPF) { const unsigned vo_ = (unsigned)lane * 16u;
#pragma unroll
        for (int f_ = 0; f_ < 8; ++f_) Kc[f_] = *(const bf16x8*)(knext + (vo_ + (unsigned)f_ * 1024u)); }
    { asm volatile("" : "+v"(dbase)); }
    float mx = -INFINITY, mx2 = -INFINITY; constexpr bool PLAIN = !NEAR && MASK == 0;
    if (PLAIN) {
        float m0 = fmaxf(S[0][0], S[1][0]), m1 = fmaxf(S[0][1], S[1][1]);
#pragma unroll
        for (int r = 2; r < 16; r += 2) { m0 = fmaxf(m0, fmaxf(S[0][r], S[1][r])); m1 = fmaxf(m1, fmaxf(S[0][r + 1], S[1][r + 1])); }
        mx = fmaxf(m0, m1) * NSA_L2E + cbias2;
    } else if (TB) {
        const LAS float* tb = biasg + (dbase + 1 - 4 * hh);
#pragma unroll
        for (int tl = 0; tl < 2; ++tl) {
            if (tl == 1) asm volatile("" ::: "memory");
#pragma unroll
            for (int r = 0; r < 16; ++r) { const float v = __builtin_fmaf(S[tl][r], NSA_L2E, tb[63 - (32 * tl + (r & 3) + 8 * (r >> 2))]); S[tl][r] = v; if (r & 1) mx = fmaxf(mx, v); else mx2 = fmaxf(mx2, v); }
        }
        mx = fmaxf(mx, mx2);
    } else {
#pragma unroll
    for (int tl = 0; tl < 2; ++tl) {
        if (NEAR && tl == 1) asm volatile("" ::: "memory");
#pragma unroll
        for (int r = 0; r < 16; ++r) {
            float v;
            if (NEAR) { const int key = 32 * tl + (r & 3) + 8 * (r >> 2) + 4 * hh; const int dist = dbase - dstep * key; int idx = dist < 0 ? 0 : dist; idx = idx > 127 ? 127 : idx;
                v = (S[tl][r] + biasg[idx]) * NSA_L2E + cbias2;
                bool ok = true; if (MASK == 1 || MASK == 3) ok = dist >= 0; if (MASK == 2) ok = dist >= 0 && dist < 512;
                v = ok ? v : -INFINITY;
            } else {
                v = S[tl][r] * NSA_L2E + cbias2;
                if (MASK == 2) { const int key = 32 * tl + (r & 3) + 8 * (r >> 2) + 4 * hh; const int dist = dbase - dstep * key; v = (dist >= 0 && dist < 512) ? v : -INFINITY; }
            }
            S[tl][r] = v; mx = fmaxf(mx, v);
        }
    }
    }
    if (PASS == 2) {
        { auto rr = __builtin_amdgcn_permlane32_swap(__float_as_uint(mx), __float_as_uint(mx), false, false); mx = fmaxf(__uint_as_float(rr[0]), __uint_as_float(rr[1])); }
        st.m = fmaxf(st.m, mx);
    } else if (PASS == 0) {
        { auto rr = __builtin_amdgcn_permlane32_swap(__float_as_uint(mx), __float_as_uint(mx), false, false); mx = fmaxf(__uint_as_float(rr[0]), __uint_as_float(rr[1])); }
        const float mn = fmaxf(st.m, mx), mref = mn == -INFINITY ? 0.f : mn;
        if (__any(mn != st.m)) {
            const float alpha = __builtin_amdgcn_exp2f(st.m - mref);
#pragma unroll
            for (int r = 0; r < 16; ++r) { st.O0[r] *= alpha; st.O1[r] *= alpha; }
            st.l *= alpha; st.m = mn;
        }
        float ls = 0.f;
        if (PLAIN) { const float off = cbias2 - mref;
#pragma unroll
            for (int tl = 0; tl < 2; ++tl)
#pragma unroll
                for (int r = 0; r < 16; ++r) { const float p = __builtin_amdgcn_exp2f(__builtin_fmaf(S[tl][r], NSA_L2E, off)); S[tl][r] = p; ls += p; }
        } else {
#pragma unroll
        for (int tl = 0; tl < 2; ++tl)
#pragma unroll
            for (int r = 0; r < 16; ++r) { const float p = __builtin_amdgcn_exp2f(S[tl][r] - mref); S[tl][r] = p; ls += p; }
        }
        st.l += ls;
#pragma unroll
        for (int tl = 0; tl < 2; ++tl)
#pragma unroll
            for (int s = 0; s < 2; ++s) { u32x4_t w; w.x = pkbf(S[tl][8 * s + 0], S[tl][8 * s + 1]); w.y = pkbf(S[tl][8 * s + 2], S[tl][8 * s + 3]); w.z = pkbf(S[tl][8 * s + 4], S[tl][8 * s + 5]); w.w = pkbf(S[tl][8 * s + 6], S[tl][8 * s + 7]);
                const bf16x8 P = __builtin_bit_cast(bf16x8, w);
                st.O0 = __builtin_amdgcn_mfma_f32_32x32x16_bf16(Vc[2 * tl + s], P, st.O0, 0, 0, 0);
                st.O1 = __builtin_amdgcn_mfma_f32_32x32x16_bf16(Vc[4 + 2 * tl + s], P, st.O1, 0, 0, 0); }
    } else {
        const float mref = minv == -INFINITY ? 0.f : minv;
        if (PLAIN) {
#pragma unroll
            for (int tl = 0; tl < 2; ++tl)
#pragma unroll
                for (int r = 0; r < 16; ++r) S[tl][r] = __builtin_fmaf(S[tl][r], NSA_L2E, cbias2);
        }
#pragma unroll
        for (int tl = 0; tl < 2; ++tl)
#pragma unroll
            for (int rg = 0; rg < 4; ++rg) { const float p0 = __builtin_amdgcn_exp2f(S[tl][4 * rg + 0] - mref) * linv, p1 = __builtin_amdgcn_exp2f(S[tl][4 * rg + 1] - mref) * linv,
                                                         p2 = __builtin_amdgcn_exp2f(S[tl][4 * rg + 2] - mref) * linv, p3 = __builtin_amdgcn_exp2f(S[tl][4 * rg + 3] - mref) * linv;
                gs[4 * tl + rg] = (p0 + p1) + (p2 + p3); lastv[4 * tl + rg] = p3; }
    }
}
#define NSA_BAR() do { asm volatile("s_waitcnt lgkmcnt(0)" ::: "memory"); __builtin_amdgcn_s_barrier(); asm volatile("" ::: "memory"); } while (0)

__device__ __forceinline__ void nsa_relayout(Frame& F) {
    ArgsP ap = kargs();
    LAS unsigned char* vt = F.lds + RING_OFF + F.wave * 16384 + 2048;
    const int gw = F.vcu * NWAVES + F.wave, NGW = F.G * NWAVES, lane = F.lane, hh = lane >> 5;
    const bf16* KV = WSP(bf16, WS_KV1); bf16* KF = WSP(bf16, WS_KSELF); bf16* VF = WSP(bf16, WS_VSELF);
    const LAS unsigned char* vrd = vt + (4 * hh + ((lane & 15) >> 2)) * 192 + (16 * ((lane >> 4) & 1) + 4 * (lane & 3)) * 2;
    for (int it = gw; it < 2 * 8 * 128; it += NGW) {
        const int pair = it >> 10, bh = (it >> 7) & 7, j = it & 127;
        const bf16* ks = KV + (size_t)(2 + 2 * pair) * KVSZ + ((size_t)bh * T + 64 * j) * HD; const bf16* vs = ks + KVSZ;
        bf16* kf = (pair ? WSP(bf16, WS_KWINF) : KF) + (size_t)(bh * 128 + j) * 4096; bf16* vf = (pair ? WSP(bf16, WS_VWINF) : VF) + (size_t)(bh * 128 + j) * 4096;
        u32x4_t kv_[8], vv_[8];
#pragma unroll
        for (int f = 0; f < 8; ++f) { kv_[f] = *(const u32x4_t*)(ks + (32 * (f >> 2) + (lane & 31)) * HD + 16 * (f & 3) + 8 * hh); const int id = lane + 64 * f; vv_[f] = *(const u32x4_t*)(vs + (id >> 3) * HD + (id & 7) * 8); }
#pragma unroll
        for (int f = 0; f < 8; ++f) { *(u32x4_t*)(kf + (f * 64 + lane) * 8) = kv_[f]; const int id = lane + 64 * f; *(LAS u32x4_t*)(vt + (id >> 3) * 192 + (id & 7) * 16) = vv_[f]; }
        LDS_WAIT(); asm volatile("" ::: "memory");
#pragma unroll
        for (int f = 0; f < 8; ++f) { const int dt = f >> 2, k4 = f & 3; const LAS unsigned char* p = vrd + dt * 64 + 16 * k4 * 192; const bf16x8 fr = tr_pair(p, p + 8 * 192); *(bf16x8*)(vf + (f * 64 + lane) * 8) = fr; }
        LDS_WAIT(); asm volatile("" ::: "memory");
    }
}
constexpr int SC_OACC = 0;
constexpr int SC_M = 66560, SC_L = SC_M + 1024;
constexpr int SC_QS = 75776;
constexpr float SC_SHIFT = 10.0f, SC_LSMAX = 262144.0f;
constexpr int SC_FLAG = SC_L + 1024;
constexpr int SC_LIST = SC_QS + 256 * 144;
constexpr int SC_CAP = 136;
static_assert(SC_LIST + 8 * SC_CAP * 12 <= NSA_OFF_BIAS, "selected-branch LDS map");
__device__ __forceinline__ unsigned f2ord(float f) { const unsigned u = __float_as_uint(f); return (u & 0x80000000u) ? ~u : (u | 0x80000000u); }
__device__ __forceinline__ float ord2f(unsigned u) { return u == 0u ? -INFINITY : ((u & 0x80000000u) ? __uint_as_float(u & 0x7fffffffu) : __uint_as_float(~u)); }
template <int PB> __device__ __forceinline__ void sc_item(LAS unsigned char* L, const bf16x8 (&Kc)[8], const bf16x8 (&Vc)[8], const bf16x8 (&Qg)[4], int lane, int col, bool valid, int tcol, int j, int qb, float b31, const LAS float* biasg) {
    const int hh = lane >> 5;
    f32x16 S[2];
#pragma unroll
    for (int tl = 0; tl < 2; ++tl) {
#pragma unroll
        for (int r = 0; r < 16; ++r) S[tl][r] = 0.f;
#pragma unroll
        for (int ks = 0; ks < 4; ++ks) S[tl] = __builtin_amdgcn_mfma_f32_32x32x16_bf16(Kc[tl * 4 + ks], Qg[ks], S[tl], 0, 0, 0);
    }
    LAS unsigned* Mx = (LAS unsigned*)(L + SC_M); LAS int* Ls = (LAS int*)(L + SC_L); LAS int* Oa = (LAS int*)(L + SC_OACC);
    const bool nearb = j >= qb - 2;
    float mx = -INFINITY; const float cb = valid ? b31 : -INFINITY;
    if (nearb) {
        int dbase = tcol - 64 * j; asm volatile("" : "+v"(dbase));
#pragma unroll
        for (int tl = 0; tl < 2; ++tl)
#pragma unroll
            for (int r = 0; r < 16; ++r) { const int key = 32 * tl + (r & 3) + 8 * (r >> 2) + 4 * hh; const int dist = dbase - key; int idx = dist < 0 ? 0 : dist; idx = idx > 127 ? 127 : idx;
                float v = (S[tl][r] + biasg[idx]) * NSA_L2E; v = (dist >= 0 && valid) ? v : -INFINITY; S[tl][r] = v; mx = fmaxf(mx, v); }
    } else if (PB == 0) {
        float m0 = fmaxf(S[0][0], S[1][0]), m1 = fmaxf(S[0][1], S[1][1]);
#pragma unroll
        for (int r = 2; r < 16; r += 2) { m0 = fmaxf(m0, fmaxf(S[0][r], S[1][r])); m1 = fmaxf(m1, fmaxf(S[0][r + 1], S[1][r + 1])); }
        mx = __builtin_fmaf(fmaxf(m0, m1), NSA_L2E, cb);
    }
    if (PB == 0) {
        { auto rr = __builtin_amdgcn_permlane32_swap(__float_as_uint(mx), __float_as_uint(mx), false, false); mx = fmaxf(__uint_as_float(rr[0]), __uint_as_float(rr[1])); }
        if (valid && hh == 0) __hip_atomic_fetch_max(Mx + col, f2ord(mx), __ATOMIC_RELAXED, __HIP_MEMORY_SCOPE_WORKGROUP);
    } else {
        const float mref = (valid ? ord2f(Mx[col]) : 0.f) - SC_SHIFT;
        float ls = 0.f;
        if (nearb) {
#pragma unroll
            for (int tl = 0; tl < 2; ++tl)
#pragma unroll
                for (int r = 0; r < 16; ++r) { const float p = __builtin_amdgcn_exp2f(S[tl][r] - mref); S[tl][r] = p; ls += p; }
        } else { const float off = cb - mref;
#pragma unroll
            for (int tl = 0; tl < 2; ++tl)
#pragma unroll
                for (int r = 0; r < 16; ++r) { const float p = __builtin_amdgcn_exp2f(__builtin_fmaf(S[tl][r], NSA_L2E, off)); S[tl][r] = p; ls += p; }
        }
        { auto rr = __builtin_amdgcn_permlane32_swap(__float_as_uint(ls), __float_as_uint(ls), false, false); ls = __uint_as_float(rr[0]) + __uint_as_float(rr[1]); }
        if (valid && hh == 0) __hip_atomic_fetch_add(Ls + col, (int)ls, __ATOMIC_RELAXED, __HIP_MEMORY_SCOPE_WORKGROUP);
        if (valid && ls > SC_LSMAX) *(volatile LAS unsigned*)(L + SC_FLAG) = 1u;
        bf16x8 P[4];
#pragma unroll
        for (int k4 = 0; k4 < 4; ++k4) { const int tl = k4 >> 1, s8 = 8 * (k4 & 1); u32x4_t w; w.x = pkbf(S[tl][s8 + 0], S[tl][s8 + 1]); w.y = pkbf(S[tl][s8 + 2], S[tl][s8 + 3]); w.z = pkbf(S[tl][s8 + 4], S[tl][s8 + 5]); w.w = pkbf(S[tl][s8 + 6], S[tl][s8 + 7]); P[k4] = __builtin_bit_cast(bf16x8, w); }
        f32x16 O0, O1;
#pragma unroll
        for (int r = 0; r < 16; ++r) { O0[r] = 0.f; O1[r] = 0.f; }
#pragma unroll
        for (int k4 = 0; k4 < 4; ++k4) { O0 = __builtin_amdgcn_mfma_f32_32x32x16_bf16(Vc[k4], P[k4], O0, 0, 0, 0); O1 = __builtin_amdgcn_mfma_f32_32x32x16_bf16(Vc[4 + k4], P[k4], O1, 0, 0, 0); }
        if (valid) { LAS int* o = Oa + col * 65 + 4 * hh;
#pragma unroll
            for (int r = 0; r < 16; ++r) __hip_atomic_fetch_add(o + (r & 3) + 8 * (r >> 2), (int)O0[r], __ATOMIC_RELAXED, __HIP_MEMORY_SCOPE_WORKGROUP);
#pragma unroll
            for (int r = 0; r < 16; ++r) __hip_atomic_fetch_add(o + 32 + (r & 3) + 8 * (r >> 2), (int)O1[r], __ATOMIC_RELAXED, __HIP_MEMORY_SCOPE_WORKGROUP); }
    }
}
__device__ __forceinline__ int sc_build(LAS unsigned char* L, int lane, int w, int qb, unsigned ws0, unsigned ws1, unsigned ws2, unsigned ws3) {
    LAS int* il = (LAS int*)(L + SC_LIST) + w * SC_CAP; LAS unsigned char* iq = L + SC_LIST + 8 * SC_CAP * 4 + w * SC_CAP * 8; int n = 0;
#pragma unroll 1
    for (int j = w; j <= qb; j += 8) {
        if (j == 0 || j >= qb - 1) continue;
        const unsigned wsel = j < 32 ? ws0 : j < 64 ? ws1 : j < 96 ? ws2 : ws3; const bool bit = (wsel >> (j & 31)) & 1u; const unsigned long long mask = __ballot(bit); const int cnt = __popcll(mask);
        const int ntl = (cnt + 7) >> 3; if (ntl == 0) continue;
        const int rank = __popcll(mask & ((1ull << lane) - 1ull));
        if (bit) iq[n * 8 + rank] = (unsigned char)lane;
        if (lane < 8 * ntl - cnt) iq[n * 8 + cnt + lane] = 0xFF;
        if (lane < ntl) il[n + lane] = j;
        n += ntl;
    }
    asm volatile("s_waitcnt lgkmcnt(0)" ::: "memory");
    return n;
}
template <int PB> __device__ __forceinline__ void sc_pass(LAS unsigned char* L, const bf16* KF, const bf16* VF, int lane, int w, int qb, int nitems, float b31, const LAS float* biasg) {
    const int c = lane & 31, hh = lane >> 5;
    const LAS int* il = (const LAS int*)(L + SC_LIST) + w * SC_CAP; const LAS unsigned char* iq = L + SC_LIST + 8 * SC_CAP * 4 + w * SC_CAP * 8; const LAS unsigned char* Qs = L + SC_QS;
    bf16x8 Kc[8], Vc[8], Kn[8], Vn[8];
    int it = __builtin_amdgcn_readfirstlane(il[0]);
    { const int j0 = it & 255;
#pragma unroll
      for (int f = 0; f < 8; ++f) { Kc[f] = *(const bf16x8*)((const char*)KF + (size_t)j0 * 8192 + ((unsigned)lane * 16u + (unsigned)f * 1024u)); if (PB == 1) Vc[f] = *(const bf16x8*)((const char*)VF + (size_t)j0 * 8192 + ((unsigned)lane * 16u + (unsigned)f * 1024u)); } }
#pragma unroll 1
    for (int i = 0; i < nitems; ++i) {
        const int inx = __builtin_amdgcn_readfirstlane(il[i + 1 < nitems ? i + 1 : i]);
        const int j = it & 255, jn = inx & 255;
        const int qraw = iq[i * 8 + (c >> 2)];
        const bool ld = jn != j;
        if (ld) {
#pragma unroll
            for (int f = 0; f < 8; ++f) Kn[f] = *(const bf16x8*)((const char*)KF + (size_t)jn * 8192 + ((unsigned)lane * 16u + (unsigned)f * 1024u)); }
        const bool valid = qraw != 0xFF; const int q = valid ? qraw : 0; const int col = 4 * q + (c & 3), tcol = 64 * qb + q;
        bf16x8 Qg[4];
#pragma unroll
        for (int ks = 0; ks < 4; ++ks) Qg[ks] = *(const LAS bf16x8*)(Qs + col * 144 + (16 * ks + 8 * hh) * 2);
        if (PB == 1 && ld) {
#pragma unroll
            for (int f = 0; f < 8; ++f) Vn[f] = *(const bf16x8*)((const char*)VF + (size_t)jn * 8192 + ((unsigned)lane * 16u + (unsigned)f * 1024u)); }
        sc_item<PB>(L, Kc, Vc, Qg, lane, col, valid, tcol, j, qb, b31, biasg);
        if (ld) {
#pragma unroll
            for (int f = 0; f < 8; ++f) { Kc[f] = Kn[f]; if (PB == 1) Vc[f] = Vn[f]; } }
        it = inx;
    }
}
template <int VAR = 0> __device__ __forceinline__ void nsa_mfma(Frame& F, size_t out_off = WS_QO) {
    ArgsP ap = kargs();
    LAS unsigned char* L = F.lds + RING_OFF;
    LAS float* impL = (LAS float*)(L + NSA_OFF_IMP); LAS float* biasL = (LAS float*)(L + NSA_OFF_BIAS); LAS unsigned* selL = (LAS unsigned*)(L + NSA_OFF_SEL);
    const int tid_outer = F.tid, w = F.wave;
    const float* rel_bias = ap->in[2];
    const int bh = F.vcu >> 5, b = bh >> 2, hkv = bh & 3, ui = F.vcu & 31;
    if (F.G != 256) return;
    { const int gg = tid_outer >> 7, dd = tid_outer & 127; biasL[gg * 128 + dd] = rel_bias[t5_bucket(dd) * 16 + hkv * 4 + gg];
      LAS float* T1 = (LAS float*)(L + NSA_OFF_T1);
#pragma unroll
      for (int e = 0; e < 2; ++e) { const int x = (tid_outer & 127) + 128 * e, dist = x - 64; T1[gg * 256 + x] = dist < 0 ? -INFINITY : rel_bias[t5_bucket(dist) * 16 + hkv * 4 + gg] * NSA_L2E; } }
#define NSA_PTRS_C() ArgsP ap2 = kargs(); const bf16* kc = (const bf16*)(ap2->ws + WS_KCVC) + (size_t)bh * 512 * 64; const bf16* vc = kc + (size_t)4096 * 64
#define NSA_PTRS_KV(kname, vname, idx) ArgsP ap3 = kargs(); const bf16* kname = (const bf16*)(ap3->ws + WS_KV1) + (size_t)(idx) * KVSZ + (size_t)bh * T * HD; const bf16* vname = kname + KVSZ
#define NSA_PARK_ADD() do { _Pragma("unroll") for (int s_ = 0; s_ < 2; ++s_) _Pragma("unroll") for (int r8 = 0; r8 < 2; ++r8) { const u32x4_t a_ = ((const u32x4_t*)park)[4 * s_ + r8], b_ = ((const u32x4_t*)park)[4 * s_ + 2 + r8]; const unsigned* ap_ = (const unsigned*)&a_; const unsigned* bp_ = (const unsigned*)&b_; \
        _Pragma("unroll") for (int e = 0; e < 4; ++e) { st.O0[8 * r8 + 2 * e] += bflo(ap_[e]); st.O0[8 * r8 + 2 * e + 1] += bfhi(ap_[e]); st.O1[8 * r8 + 2 * e] += bflo(bp_[e]); st.O1[8 * r8 + 2 * e + 1] += bfhi(bp_[e]); } } } while (0)
#define NSA_LSUM(dst, src) do { auto rr_ = __builtin_amdgcn_permlane32_swap(__float_as_uint(src), __float_as_uint(src), false, false); dst = __uint_as_float(rr_[0]) + __uint_as_float(rr_[1]); } while (0)
    NSA_BAR();
    float gs[8], lastv[8];
#pragma unroll 1
    for (int un = 0; un < 4; ++un) {
        int tid = tid_outer; asm volatile("" : "+v"(tid)); const int lane = tid & 63, c = lane & 31, hh = lane >> 5, g = c & 3, hq = hkv * 4 + g;
        const float b31 = kargs()->in[2][31 * 16 + hq] * NSA_L2E; const LAS float* biasg = biasL + g * 128; const LAS float* t1g = (const LAS float*)(L + NSA_OFF_T1) + g * 256;
        const int qb = un == 0 ? ui : un == 1 ? 63 - ui : un == 2 ? 64 + ui : 127 - ui;
        const int ql = 8 * w + (c >> 2), t = 64 * qb + ql;
        bf16* qrow; float gate_c, gate_s, gate_w; float* park;
        { ArgsP ap1 = kargs(); qrow = (bf16*)(ap1->ws + WS_QO) + (size_t)(b * T + t) * D + hq * HD; const float* gr = (const float*)(ap1->ws + WS_GATES) + (size_t)(b * T + t) * 64 + hq; gate_c = gr[0]; gate_s = gr[16]; gate_w = gr[32];
          park = (float*)(ap1->ws + WS_PARKG) + ((size_t)blockIdx.x * 512 + tid) * 32; }
        const LAS unsigned char* Qrow = L + SC_QS + (32 * w + c) * 144 + 16 * hh;
        {
#pragma unroll
          for (int ks = 0; ks < 4; ++ks) *(LAS bf16x8*)(L + SC_QS + (32 * w + c) * 144 + (16 * ks + 8 * hh) * 2) = *(const bf16x8*)(qrow + 16 * ks + 8 * hh); }
        asm volatile("s_waitcnt lgkmcnt(0)" ::: "memory");
        NsaState st;
#define NSA_LDK(dst, base, blk) do { const char* bb_ = (const char*)(base) + (size_t)(blk) * 8192; const unsigned vo_ = (unsigned)lane * 16u;   \
        _Pragma("unroll") for (int f_ = 0; f_ < 8; ++f_) dst[f_] = *(const bf16x8*)(bb_ + (vo_ + (unsigned)f_ * 1024u)); } while (0)
        nsa_reset(st);
        const int jb0 = qb >= 8 ? qb - 8 : 0;
        if (!(VAR & 4)) {
            ArgsP ap3 = kargs(); const bf16* KFw = (const bf16*)(ap3->ws + WS_KWINF) + (size_t)bh * 128 * 4096; const bf16* VFw = (const bf16*)(ap3->ws + WS_VWINF) + (size_t)bh * 128 * 4096;
            bf16x8 Kc[8];
            NSA_LDK(Kc, KFw, jb0);
#pragma unroll 1
            for (int jb = jb0; jb <= qb; ++jb) {
                bf16x8 Vc[8];
                NSA_LDK(Vc, VFw, jb);
                const char* kn = (const char*)KFw + (size_t)(jb + 1) * 8192;
                if (jb >= qb - 2) { if (jb > jb0 && jb > qb - 2) NSA_LDK(Kc, KFw, jb);
                    nsa_step_r<true, 1, 0, true>(st, Kc, Vc, Qrow, lane, 0.f, t - 64 * jb, 1, t1g, 0.f, 0.f, gs, lastv); }
                else if (jb == qb - 8) nsa_step_r<false, 2, 0>(st, Kc, Vc, Qrow, lane, b31, t - 64 * jb, 1, biasg, 0.f, 0.f, gs, lastv);
                else { if (jb > jb0 && jb == qb - 7) NSA_LDK(Kc, KFw, jb);
                    nsa_step_r<false, 0, 0, false, true>(st, Kc, Vc, Qrow, lane, b31, 0, 0, biasg, 0.f, 0.f, gs, lastv, kn); }
            }
        }
        { float ltot; NSA_LSUM(ltot, st.l); const float sc = ltot > 0.f ? gate_w / ltot : 0.f;
#pragma unroll
          for (int r8 = 0; r8 < 2; ++r8) { u32x4_t a, b2; unsigned* ap_ = (unsigned*)&a; unsigned* bp_ = (unsigned*)&b2; for (int e = 0; e < 4; ++e) { ap_[e] = pkbf(sc * st.O0[8 * r8 + 2 * e], sc * st.O0[8 * r8 + 2 * e + 1]); bp_[e] = pkbf(sc * st.O1[8 * r8 + 2 * e], sc * st.O1[8 * r8 + 2 * e + 1]); } ((u32x4_t*)park)[r8] = a; ((u32x4_t*)park)[2 + r8] = b2; } }
        const int nbc = (VAR & 1) ? 0 : (4 * qb + 3 + 63) >> 6;
        const int dbc = t - 31;
        nsa_reset(st);
        const bf16* KFc; const bf16* VFc; { ArgsP ap2 = kargs(); KFc = (const bf16*)(ap2->ws + WS_KCF) + (size_t)bh * 8 * 4096; VFc = (const bf16*)(ap2->ws + WS_VCF) + (size_t)bh * 8 * 4096; }
        {
#pragma unroll 1
            for (int i = 0; i < nbc; ++i) {
                bf16x8 Kc[8], Vc[8];
                NSA_LDK(Kc, KFc, i); NSA_LDK(Vc, VFc, i);
                const bool near_ = 64 * i + 63 >= 4 * qb - 8;
                if (near_) nsa_step_r<true, 3, 0>(st, Kc, Vc, Qrow, lane, 0.f, dbc - 16 * 64 * i, 16, biasg, 0.f, 0.f, gs, lastv);
                else nsa_step_r<false, 0, 0>(st, Kc, Vc, Qrow, lane, b31, 0, 0, biasg, 0.f, 0.f, gs, lastv);
            }
        }
        const float mfin = st.m; float lfin; NSA_LSUM(lfin, st.l);
        { const float inv = lfin > 0.f ? 1.0f / lfin : 0.f; const float sc = gate_c * inv;
#pragma unroll
          for (int r8 = 0; r8 < 2; ++r8) { u32x4_t a, b2; unsigned* ap_ = (unsigned*)&a; unsigned* bp_ = (unsigned*)&b2; for (int e = 0; e < 4; ++e) { ap_[e] = pkbf(sc * st.O0[8 * r8 + 2 * e], sc * st.O0[8 * r8 + 2 * e + 1]); bp_[e] = pkbf(sc * st.O1[8 * r8 + 2 * e], sc * st.O1[8 * r8 + 2 * e + 1]); } ((u32x4_t*)park)[4 + r8] = a; ((u32x4_t*)park)[6 + r8] = b2; } }
        if (nbc > 0) {
            const float linv = lfin > 0.f ? 1.0f / lfin : 0.f; float carry_last = 0.f;
#pragma unroll 1
            for (int i = 0; i < nbc; ++i) {
                bf16x8 Kc[8];
                NSA_LDK(Kc, KFc, i);
                const bool near_ = 64 * i + 63 >= 4 * qb - 8;
                if (near_) nsa_step_r<true, 3, 1>(st, Kc, Kc, Qrow, lane, 0.f, dbc - 16 * 64 * i, 16, biasg, mfin, linv, gs, lastv);
                else nsa_step_r<false, 0, 1>(st, Kc, Kc, Qrow, lane, b31, 0, 0, biasg, mfin, linv, gs, lastv);
                float plp = carry_last;
#pragma unroll
                for (int k8 = 0; k8 < 8; ++k8) {
                    const float pl = swap32(lastv[k8]);
                    const float prev = hh ? pl : plp;
                    float v = gs[k8] + prev;
                    v += dpp_xor1(v); v += dpp_xor2(v);
                    if (g == 0) impL[ql * 128 + 16 * i + 2 * k8 + hh] = v;
                    plp = pl;
                }
                carry_last = plp;
            }
        }
        asm volatile("s_waitcnt lgkmcnt(0)" ::: "memory");
#pragma unroll 1
        for (int qi = 0; qi < ((VAR & 8) ? 0 : 8); qi += 4) {
            unsigned k0[4], k1[4];
#pragma unroll
            for (int u = 0; u < 4; ++u) { const int q2 = 8 * w + qi + u; const int ja = lane, jb_ = lane + 64;
                const bool fa = (ja == 0) || (ja == qb) || (ja == qb - 1), fb = (jb_ == qb) || (jb_ == qb - 1);
                const float i0 = ja <= qb ? impL[q2 * 128 + ja] : 0.f, i1 = jb_ <= qb ? impL[q2 * 128 + jb_] : 0.f;
                k0[u] = ja <= qb ? __float_as_uint(fa ? 100.0f : i0) + 1u : 0u; k1[u] = jb_ <= qb ? __float_as_uint(fb ? 100.0f : i1) + 1u : 0u; }
            unsigned pf[4] = {0u, 0u, 0u, 0u};
            if (qb >= 16) {
                int exact = 0;
#pragma unroll 1
                for (int bit = 30; bit >= 0 && exact != 15; --bit) {
#pragma unroll
                    for (int u = 0; u < 4; ++u) { const unsigned cand = pf[u] | (1u << bit); const int n = __popcll(__ballot(k0[u] >= cand)) + __popcll(__ballot(k1[u] >= cand)); pf[u] = n >= 16 ? cand : pf[u]; exact |= (n == 16) ? (1 << u) : 0; }
                }
            } else { pf[0] = pf[1] = pf[2] = pf[3] = 1u; }
#pragma unroll
            for (int u = 0; u < 4; ++u) {
                unsigned long long g0 = __ballot(k0[u] > pf[u]), g1 = __ballot(k1[u] > pf[u]), t0 = __ballot(k0[u] == pf[u]), t1 = __ballot(k1[u] == pf[u]);
                int need = 16 - (__popcll(g0) + __popcll(g1));
                if (qb < 16) { g0 |= t0; g1 |= t1; need = 0; }
#pragma unroll 1
                while (need > 0 && (t0 | t1)) { if (t0) { const unsigned long long lb = t0 & (0ull - t0); g0 |= lb; t0 ^= lb; } else { const unsigned long long lb = t1 & (0ull - t1); g1 |= lb; t1 ^= lb; } --need; }
                if (lane == 0) { const int q2 = 8 * w + qi + u; selL[q2 * 4 + 0] = (unsigned)g0; selL[q2 * 4 + 1] = (unsigned)(g0 >> 32); selL[q2 * 4 + 2] = (unsigned)g1; selL[q2 * 4 + 3] = (unsigned)(g1 >> 32); }
            }
        }
        NSA_BAR();
        if (!(VAR & 2)) {
            { LAS float* Oa = (LAS float*)(L + SC_OACC) + (32 * w + c) * 65 + 32 * hh;
#pragma unroll
              for (int i = 0; i < 32; ++i) Oa[i] = 0.f;
              if (hh == 0) { ((LAS unsigned*)(L + SC_M))[32 * w + c] = 0u; ((LAS float*)(L + SC_L))[32 * w + c] = 0.f; }
              if (tid == 0) *(volatile LAS unsigned*)(L + SC_FLAG) = 0u;
            }
            const unsigned ws0 = selL[lane * 4 + 0], ws1 = selL[lane * 4 + 1], ws2 = selL[lane * 4 + 2], ws3 = selL[lane * 4 + 3];
            NSA_BAR();
            ArgsP ap4 = kargs(); const bf16* KFb = (const bf16*)(ap4->ws + WS_KSELF) + (size_t)bh * 128 * 4096; const bf16* VFb = (const bf16*)(ap4->ws + WS_VSELF) + (size_t)bh * 128 * 4096;
            const int nitems = sc_build(L, lane, w, qb, ws0, ws1, ws2, ws3);
#define NSA_FORCED(PASSNO) do { _Pragma("unroll 1") for (int fi = 0; fi < 3; ++fi) { const int j = fi == 0 ? qb : fi == 1 ? qb - 1 : 0; if (j < 0 || (fi == 2 && qb <= 1)) continue; \
                bf16x8 Kc[8], Vc[8]; NSA_LDK(Kc, KFb, j); if (PASSNO == 0) NSA_LDK(Vc, VFb, j); \
                if (j >= qb - 2) nsa_step_r<true, 1, PASSNO, true>(st, Kc, (PASSNO == 0 ? Vc : Kc), Qrow, lane, 0.f, t - 64 * j, 1, t1g, 0.f, 0.f, gs, lastv); \
                else nsa_step_r<false, 0, PASSNO>(st, Kc, (PASSNO == 0 ? Vc : Kc), Qrow, lane, b31, 0, 0, biasg, 0.f, 0.f, gs, lastv); } } while (0)
            nsa_reset(st);
            NSA_FORCED(2);
            if (hh == 0) ((LAS unsigned*)(L + SC_M))[32 * w + c] = f2ord(st.m);
            NSA_BAR();
            if (nitems > 0) sc_pass<1>(L, KFb, VFb, lane, w, qb, nitems, b31, biasg);
            NSA_BAR();
#ifdef PROBE_FORCE_FALLBACK
            const bool redo = true;
#else
            const bool redo = *(volatile LAS unsigned*)(L + SC_FLAG) != 0u;
#endif
            if (redo) {
                NSA_BAR();
                { LAS float* Oz = (LAS float*)(L + SC_OACC) + (32 * w + c) * 65 + 32 * hh;
#pragma unroll
                  for (int i = 0; i < 32; ++i) Oz[i] = 0.f;
                  if (hh == 0) { ((LAS unsigned*)(L + SC_M))[32 * w + c] = 0u; ((LAS float*)(L + SC_L))[32 * w + c] = 0.f; }
                  if (tid == 0) *(volatile LAS unsigned*)(L + SC_FLAG) = 0u; }
                NSA_BAR();
                if (nitems > 0) sc_pass<0>(L, KFb, VFb, lane, w, qb, nitems, b31, biasg);
                NSA_BAR();
                if (nitems > 0) sc_pass<1>(L, KFb, VFb, lane, w, qb, nitems, b31, biasg);
                NSA_BAR();
            }
            nsa_reset(st);
            NSA_FORCED(0);
            { const LAS int* Oa = (const LAS int*)(L + SC_OACC) + (32 * w + c) * 65 + 4 * hh; const float lrest = (float)((const LAS int*)(L + SC_L))[32 * w + c]; const float mrest = ord2f(((const LAS unsigned*)(L + SC_M))[32 * w + c]);
              float lf; NSA_LSUM(lf, st.l); const float Mx_ = fmaxf(st.m, mrest);
              const float af = __builtin_amdgcn_exp2f(st.m - Mx_), ar = (mrest == -INFINITY || lrest == 0.f) ? 0.f : __builtin_amdgcn_exp2f(mrest - Mx_ - SC_SHIFT);
              const float sc = gate_s / (lf * af + lrest * ar), sf = sc * af, sr = sc * ar;
#pragma unroll
              for (int r = 0; r < 16; ++r) { const int d = (r & 3) + 8 * (r >> 2); st.O0[r] = sf * st.O0[r] + sr * (float)Oa[d]; st.O1[r] = sf * st.O1[r] + sr * (float)Oa[32 + d]; } }
            NSA_PARK_ADD();
        } else {
#pragma unroll
            for (int r = 0; r < 16; ++r) { st.O0[r] = 0.f; st.O1[r] = 0.f; }
            NSA_PARK_ADD();
        }
#pragma unroll
        for (int rg = 0; rg < 4; ++rg) { u32x2_t w0, w1; w0.x = pkbf(st.O0[4 * rg], st.O0[4 * rg + 1]); w0.y = pkbf(st.O0[4 * rg + 2], st.O0[4 * rg + 3]); w1.x = pkbf(st.O1[4 * rg], st.O1[4 * rg + 1]); w1.y = pkbf(st.O1[4 * rg + 2], st.O1[4 * rg + 3]);
            bf16* orow = (bf16*)(kargs()->ws + out_off) + (size_t)(b * T + t) * D + hq * HD;
            if (VAR == 0 || out_off == WS_QO) { *(u32x2_t*)(orow + 8 * rg + 4 * hh) = w0; *(u32x2_t*)(orow + 32 + 8 * rg + 4 * hh) = w1; }
            else { asm volatile("" :: "v"(w0.x), "v"(w0.y), "v"(w1.x), "v"(w1.y)); } }
        NSA_BAR();
    }
}

#define PHASE_BEGIN() ArgsP ap = kargs(); (void)ap
template <int PH> __device__ __forceinline__ void run_phase(LAS unsigned char* lds_base) {
    Frame F; F.lds = lds_base;
    int bx = blockIdx.x, G = gridDim.x; asm volatile("" : "+s"(bx), "+s"(G));
    { int t_ = threadIdx.x; asm volatile("" : "+v"(t_)); F.tid = t_; F.lane = t_ & 63; F.wave = __builtin_amdgcn_readfirstlane(t_ >> 6); F.G = G; F.vcu = (G % 8 == 0) ? (bx % 8) * (G / 8) + bx / 8 : bx; }
    constexpr int ph = PH; constexpr int layer = (PH >= 7 && PH < 16) ? 1 : 0;
        switch (ph) {
        case 0:
#ifndef SKIP_P0
            p0_prologue(F);
#endif
            break;
        case 1: {
            PHASE_BEGIN();
            pg8::Gemm g{WSP(bf16, WS_HB), WSP(bf16, WS_WQKV)}; pg8::StaticOrder S; S.init(M, NQKV, G, bx);
            pg8::fill_rstd(F.lds, WSP(float, WS_SSQ0), S);
            pg8::EpiQKV E{F.lds, WSP(bf16, WS_QO), WSP(bf16, WS_K0), WSP(bf16, WS_V0)};
            pg8::gemm_phase<pg8::EpiQKV, pg8::StaticOrder, D, D, D, PG8_ALIGN, PG8_SP2>(F.lds + RING_OFF, g, S, E);
        } break;
        case 2:
#ifdef USE_SB_SIMPLE
            sb_simple(F);
#else
            sb_mfma(F);
#endif
            break;
        case 3: case 11: {
            PHASE_BEGIN();
            pg8::Gemm g{WSP(bf16, WS_QO), layer ? WSP(bf16, WS_WO1) : WSP(bf16, WS_WO0)}; pg8::StaticOrder S; S.init(M, D, G, bx);
            if (layer == 0) { pg8::EpiRes<true> E{(const void*)ap->in[0], WSP(bf16, WS_HB), WSP(float, WS_SSQ1)};
                pg8::gemm_phase<pg8::EpiRes<true>, pg8::StaticOrder, D, D, D, PG8_ALIGN, PG8_SP2>(F.lds + RING_OFF, g, S, E); }
            else { pg8::EpiRes<false> E{(const void*)WSP(bf16, WS_PP), WSP(bf16, WS_HB), WSP(float, WS_SSQ0)};
                pg8::gemm_phase<pg8::EpiRes<false>, pg8::StaticOrder, D, D, D, PG8_ALIGN, PG8_SP2>(F.lds + RING_OFF, g, S, E); }
        } break;
        case 4: case 12: {
            PHASE_BEGIN();
            pg8::Gemm g{WSP(bf16, WS_HB), layer ? WSP(bf16, WS_WFI1) : WSP(bf16, WS_WFI0)}; pg8::StaticOrder S; S.init(M, NFFI, G, bx);
            pg8::fill_rstd(F.lds, layer ? WSP(float, WS_SSQ0) : WSP(float, WS_SSQ1), S);
            pg8::EpiSwiglu E{F.lds, WSP(bf16, WS_ACT)};
            pg8::gemm_phase<pg8::EpiSwiglu, pg8::StaticOrder, D, D, D, PG8_ALIGN, PG8_SP2>(F.lds + RING_OFF, g, S, E);
            {
                ArgsP ap5 = kargs();
                pg8::Gemm g2{(const bf16*)(ap5->ws + WS_PB) + (size_t)layer * M * PLE, (const bf16*)(ap5->ws + (layer ? WS_WP1 : WS_WP0))}; pg8::UpperHalfOrder S2{bx, G};
                pg8::EpiBf16Plain E2{(bf16*)(ap5->ws + WS_PP), D};
                pg8::gemm_phase<pg8::EpiBf16Plain, pg8::UpperHalfOrder, PLE, PLE, PLE, PG8_ALIGN, PG8_SP2>(F.lds + RING_OFF, g2, S2, E2);
            }
        } break;
        case 5: case 13: {
            {
                PHASE_BEGIN();
                pg8::Gemm g{WSP(bf16, WS_ACT), layer ? WSP(bf16, WS_WFO1) : WSP(bf16, WS_WFO0)}; pg8::StaticOrder S; S.init(M, D, G, bx);
                pg8::EpiRes<false> E{(const void*)WSP(bf16, WS_HB), WSP(bf16, WS_HB), layer ? WSP(float, WS_SSQ1) : WSP(float, WS_SSQ0)};
                pg8::gemm_phase<pg8::EpiRes<false>, pg8::StaticOrder, FF, FF, FF, PG8_ALIGN, PG8_SP2>(F.lds + RING_OFF, g, S, E);
            }
        } break;
        case 6: case 14: {
            PHASE_BEGIN();
            pg8::Gemm g{WSP(bf16, WS_HB), layer ? WSP(bf16, WS_WG1) : WSP(bf16, WS_WG0)}; pg8::StaticOrder S; S.init(M, D, G, bx);
            pg8::fill_rstd(F.lds, layer ? WSP(float, WS_SSQ1) : WSP(float, WS_SSQ0), S);
            if (layer == 0) { pg8::EpiGate<false> E{F.lds, WSP(bf16, WS_HB), ap->out, WSP(bf16, WS_PP), WSP(float, WS_SSQ1)};
                pg8::gemm_phase<pg8::EpiGate<false>, pg8::StaticOrder, D, D, D, PG8_ALIGN, PG8_SP2>(F.lds + RING_OFF, g, S, E); }
            else { pg8::EpiGateFinal E{F.lds, WSP(bf16, WS_HB), ap->out, WSP(bf16, WS_PP), WSP(float, WS_SSQ0), (unsigned*)(ap->ws + WS_CTL) + CW_PANEL, ap->in[6], (unsigned*)(ap->ws + WS_CTL) + CW_TMO};
                pg8::gemm_phase<pg8::EpiGateFinal, pg8::StaticOrder, D, D, D, PG8_ALIGN, PG8_SP2>(F.lds + RING_OFF, g, S, E); }
        } break;
        case 7: {
            PHASE_BEGIN();
            pg8::Gemm g{WSP(bf16, WS_PP), WSP(bf16, WS_WNSA)}; pg8::StaticOrder S; S.init(M, NNSA, G, bx);
            pg8::fill_rstd(F.lds, WSP(float, WS_SSQ1), S);
            pg8::EpiNSA E{F.lds, WSP(bf16, WS_QO), WSP(bf16, WS_KV1), KVSZ, WSP(float, WS_GATES)};
            pg8::gemm_phase<pg8::EpiNSA, pg8::StaticOrder, D, D, D, PG8_ALIGN, PG8_SP2>(F.lds + RING_OFF, g, S, E);
        } break;
        case 8: {
            PHASE_BEGIN();
            const int uix = F.vcu; const bool has = uix < 128; const int which = (uix >> 6) & 1, tile = (uix >> 2) & 15, ks = uix & 3;
            const bf16* Ab = WSP(bf16, WS_KV1) + (size_t)which * KVSZ + (size_t)(tile >> 1) * T * HD + (size_t)(tile & 1) * 256 * 1024 + ks * 512;
            const bf16* Bb = (which ? WSP(bf16, WS_WCV) : WSP(bf16, WS_WCK)) + ks * 512;
            pg8::Gemm g{Ab, Bb}; pg8::OneUnit S{has};
            pg8::EpiSlab E{WSP(bf16, WS_SLAB) + (size_t)((ks * 2 + which) * 16 + tile) * 65536};
            pg8::gemm_phase<pg8::EpiSlab, pg8::OneUnit, 1024, CMPK, 512, false, PG8_SP2>(F.lds + RING_OFF, g, S, E);
            nsa_relayout(F);
        } break;
        case 9:
#ifndef SKIP_C2
            cmp_stage2(F);
#endif
            break;
        case 10:
#ifdef USE_NSA_SIMPLE
            nsa_simple(F);
#else
            nsa_mfma<0>(F);
#endif
            break;
#ifdef PROBE_DUP
#ifndef PROBE_VAR
#define PROBE_VAR 0
#endif
        case 18: sb_mfma(F, WS_PP); break;
        case 19: nsa_mfma<(PROBE_VAR | 16)>(F, WS_SPARE); break;
#endif
#ifdef PROBE_NSA_DIFF
        case 16: nsa_simple(F, WS_SPARE); break;
        case 17: {
            PHASE_BEGIN(); bf16* q = WSP(bf16, WS_QO); const bf16* x = WSP(bf16, WS_SPARE); const int gt = F.vcu * (NWAVES * 64) + F.tid, NTH = F.G * NWAVES * 64;
            for (int i = gt; i < M * D; i += NTH) { const float a = bf2f(q[i]), r = bf2f(x[i]);
#ifdef PROBE_NSA_SCALE
                q[i] = (bf16)f2bf(1.25f * a);
#else
                q[i] = (bf16)f2bf(r + 32.0f * (a - r));
#endif
            }
        } break;
#endif
        default: {
            PHASE_BEGIN();
            const int gw = F.vcu * NWAVES + F.wave, NGW = F.G * NWAVES; const float* gf = ap->in[6]; const float* SSQ = WSP(float, WS_SSQ0);
            f32x4 gv[4];
#pragma unroll
            for (int j = 0; j < 4; ++j) gv[j] = ((const f32x4*)gf)[F.lane + 64 * j];
            for (int m = gw; m < M; m += NGW) {
                float s = F.lane < 16 ? SSQ[(size_t)m * 16 + F.lane] : 0.f; s = wave_sum(s);
                const float r = rsqrtf(s * (1.0f / 1024.0f) + RMS_EPS);
                GAS f32x4* xr = (GAS f32x4*)(ap->out + (size_t)m * D) + F.lane;
#pragma unroll
                for (int j = 0; j < 4; ++j) { f32x4 v = xr[64 * j]; v = v * r * gv[j]; xr[64 * j] = v; }
            }
        } break;
        }
}
__global__ void __launch_bounds__(NWAVES * 64, 2) fwd_kernel(Args args) {
    extern __shared__ __attribute__((aligned(16))) unsigned char lds[];
    LAS unsigned char* L = (LAS unsigned char*)lds;
    { const int tid = threadIdx.x; for (int u = tid; u < (LDS_BYTES - LDSCTL_OFF) / 4; u += NWAVES * 64) ((LAS unsigned*)(L + LDSCTL_OFF))[u] = 0u; }
    __syncthreads();
    XcdBarrier bar = xcd_barrier_post((unsigned*)((gu32*)(args.ws + WS_CTL) + CW_BAR), (volatile LAS unsigned*)(L + MISC_OFF) + 8);
#define BAR_() do { XcdBarrier b2 = bar; asm volatile("" : "+s"(b2.bar), "+s"(b2.x)); xcd_barrier(b2); } while (0)
#define STEP(P) run_phase<P>(L); BAR_()
#ifdef PROBE_DUP
#define DUP_(P) if (PROBE_DUP == (P)) { STEP(P == 2 ? 18 : P == 10 ? 19 : P); }
#else
#define DUP_(P)
#endif
    DUP_(0) STEP(0); DUP_(1) STEP(1); DUP_(2) STEP(2); DUP_(3) STEP(3); DUP_(4) STEP(4); STEP(5); STEP(6); DUP_(7) STEP(7); DUP_(8) STEP(8); DUP_(9) STEP(9);
#ifdef PROBE_NSA_DIFF
    STEP(16);
#endif
    DUP_(10) STEP(10);
#ifdef PROBE_NSA_DIFF
    STEP(17);
#endif
    STEP(11); STEP(12); STEP(13);
    run_phase<14>(L);
}

extern "C" void kernel_launch(void* const* d_in, const int* in_sizes, int n_in, void* d_out, int out_size, void* d_ws, size_t ws_size, hipStream_t stream) {
    static int grid = 0;
    if (grid == 0) {
        if (n_in != 21 || in_sizes[0] != M * D || out_size != M * D || ws_size < WS_END) { fprintf(stderr, "kernel_launch: unexpected shapes (n_in %d, in0 %d, out %d, ws %zu)\n", n_in, n_in > 0 ? in_sizes[0] : -1, out_size, ws_size); grid = -1; return; }
        int dev = 0, cus = 0, per_cu = 0;
        if (hipGetDevice(&dev) != hipSuccess || hipDeviceGetAttribute(&cus, hipDeviceAttributeMultiprocessorCount, dev) != hipSuccess) { grid = -1; return; }
        if (hipFuncSetAttribute((const void*)fwd_kernel, hipFuncAttributeMaxDynamicSharedMemorySize, LDS_BYTES) != hipSuccess) { fprintf(stderr, "kernel_launch: hipFuncSetAttribute failed\n"); grid = -1; return; }
        if (hipOccupancyMaxActiveBlocksPerMultiprocessor(&per_cu, (const void*)fwd_kernel, NWAVES * 64, LDS_BYTES) != hipSuccess || per_cu < 1) { fprintf(stderr, "kernel_launch: occupancy query reports %d blocks per CU\n", per_cu); per_cu = 1; }
        (void)hipGetLastError();
        if (cus != 256) { fprintf(stderr, "kernel_launch: built for a 256-CU device (found %d CUs); nothing launched\n", cus); grid = -1; return; }
        grid = cus * (per_cu < 1 ? 1 : 1);
    }
    if (grid < 0) return;
    if (hipMemsetAsync((char*)d_ws + WS_CTL, 0, CTL_ZERO_BYTES, stream) != hipSuccess) { fprintf(stderr, "kernel_launch: memset failed\n"); return; }
    Args a{};
    for (int i = 0; i < 21; ++i) a.in[i] = (const float*)d_in[i];
    a.out = (float*)d_out; a.ws = (unsigned char*)d_ws;
    hipLaunchKernelGGL(fwd_kernel, dim3(grid), dim3(NWAVES * 64), LDS_BYTES, stream, a);
    const hipError_t le = hipPeekAtLastError();
    if (le != hipSuccess) fprintf(stderr, "kernel_launch: launch failed: %s\n", hipGetErrorName(le));
}
```

```cpp
#include <hip/hip_runtime.h>
#include <hip/hip_bf16.h>
#include <cstdio>
#include <cstdint>
#include <cmath>
namespace pg8 {
#define PG8_LAS __attribute__((address_space(3)))
typedef unsigned short bf16_t;
typedef short bf16x8 __attribute__((ext_vector_type(8)));
typedef float f32x4 __attribute__((ext_vector_type(4)));
typedef float f32x2 __attribute__((ext_vector_type(2)));
typedef unsigned u32x4 __attribute__((ext_vector_type(4)));
typedef unsigned u32x2 __attribute__((ext_vector_type(2)));
constexpr int BM = 256, BK = 64, HALF = 128, HTB = HALF * BK * 2  , STAGE_BYTES = 8 * HTB, NXCD = 8, WGM = 4;

__host__ __device__ __forceinline__ int lds_byte(int r, int c) { const int st = (r >> 4) * 2 + (c >> 5), rr = r & 15, cc = c & 31, ob = rr * 64 + cc * 2; return st * 1024 + (ob ^ (((ob >> 9) & 1) << 5)); }
__host__ __device__ __forceinline__ void stage_rc(int b, int& R, int& C) { const int st = b / 1024, sb = b % 1024, swz = sb ^ (((sb >> 9) & 1) << 5); R = (st >> 1) * 16 + swz / 64; C = (st & 1) * 32 + (swz % 64) / 2; }
__host__ __device__ __forceinline__ int perm32(int rho) { const int n = rho >> 4, i = rho & 15; return 8 * (i >> 2) + 4 * n + (i & 3); }

struct Unit { int pm, pn; };
struct Gemm { const bf16_t* A; const bf16_t* Bt; };

struct StaticOrder {
    int nM, nN, nwg, G, c;
    __host__ __device__ void init(int M, int N, int G_, int c_) { nM = M / BM; nN = N / BM; nwg = nM * nN; G = G_; c = c_; }
    __host__ __device__ bool next(int i, Unit& u) const {
        const long L = (long)i * G + c; if (L >= nwg) return false;
        int wgid = (int)L; { const int q = nwg / NXCD, r = nwg % NXCD, xcd = wgid % NXCD, off = wgid / NXCD; wgid = (xcd < r ? xcd * (q + 1) : r * (q + 1) + (xcd - r) * q) + off; }
        const int nig = WGM * nN, gid = wgid / nig, fm = gid * WGM, gsz = (nM % WGM == 0) ? WGM : ((nM - fm) < WGM ? (nM - fm) : WGM);
        u.pm = fm + ((wgid % nig) % gsz); u.pn = (wgid % nig) / gsz; return true;
    }
    __device__ __forceinline__ void a_ready(const Unit&) const {}
    __device__ __forceinline__ void done(const Unit&) const {}
};
struct UpperHalfOrder {
    int c, G;
    __device__ __forceinline__ bool next(int i, Unit& u) const { if (G != 256) { const int L = i * G + c; if (L >= 256) return false; u.pm = L >> 2; u.pn = L & 3; return true; }
        if (c < 128 || i >= 2) return false; const int L = (c - 128) + 128 * i; u.pm = L >> 2; u.pn = L & 3; return true; }
    __device__ __forceinline__ void a_ready(const Unit&) const {}
    __device__ __forceinline__ void done(const Unit&) const {}
};
struct OneUnit {
    bool has;
    __device__ __forceinline__ bool next(int i, Unit& u) const { if (i > 0 || !has) return false; u.pm = 0; u.pn = 0; return true; }
    __device__ __forceinline__ void a_ready(const Unit&) const {}
    __device__ __forceinline__ void done(const Unit&) const {}
};

__device__ __forceinline__ unsigned cvt_pk_bf16(float lo, float hi) { unsigned r; asm volatile("v_cvt_pk_bf16_f32 %0, %1, %2" : "=v"(r) : "v"(lo), "v"(hi)); return r; }
__device__ __forceinline__ float sigmoidf_(float x) { return __builtin_amdgcn_rcpf(1.0f + __builtin_amdgcn_exp2f(-1.4426950408889634f * x)); }

constexpr int SEQ_ = 8192;
constexpr int RTAB_OFF = 131072, RTAB_UNITS = 8;
template <class Sched> __device__ __forceinline__ void fill_rstd(PG8_LAS unsigned char* lds, const float* ssq, const Sched& S) {
    int t_ = threadIdx.x; asm volatile("" : "+v"(t_));
    PG8_LAS float* rtab = (PG8_LAS float*)(lds + RTAB_OFF); const int row = t_ & 255, half = t_ >> 8;
    Unit u;
#pragma unroll 1
    for (int ui = half; ui < RTAB_UNITS && S.next(ui, u); ui += 2) {
        const f32x4* p = (const f32x4*)(ssq + (size_t)(u.pm * BM + row) * 16);
        const f32x4 a = p[0], b = p[1], c = p[2], d = p[3];
        const float s = (((a[0] + a[1]) + (a[2] + a[3])) + ((b[0] + b[1]) + (b[2] + b[3]))) + (((c[0] + c[1]) + (c[2] + c[3])) + ((d[0] + d[1]) + (d[2] + d[3])));
        rtab[ui * 256 + row] = rsqrtf(s * (1.0f / 1024.0f) + 1e-6f);
    }
    asm volatile("s_waitcnt lgkmcnt(0)" ::: "memory"); __builtin_amdgcn_s_barrier(); asm volatile("" ::: "memory");
}
__device__ __forceinline__ void load_rstd(const PG8_LAS unsigned char* lds, int ui, int wr, int fr, float (&rs)[2][4]) {
    const PG8_LAS float* rtab = (const PG8_LAS float*)(lds + RTAB_OFF) + ui * 256;
#pragma unroll
    for (int ai = 0; ai < 2; ++ai)
#pragma unroll
        for (int m = 0; m < 4; ++m) rs[ai][m] = rtab[ai * HALF + wr * 64 + m * 16 + fr];
}
struct EpiQKV {
    static constexpr bool BMAP2 = false, PERM = true, AFTER_DRAIN = false;
    const PG8_LAS unsigned char* lds; bf16_t* Q; bf16_t* Kh; bf16_t* Vh;
    __device__ __forceinline__ void operator()(const f32x4 (&acc)[2][2][4][2], const Unit& u, int ui, int wr, int wc, int fr_, int fq_) const {
        int fr = fr_, fq = fq_; asm volatile("" : "+v"(fr), "+v"(fq));
        float rs[2][4]; load_rstd(lds, ui, wr, fr, rs);
        const int t3 = u.pn >> 2; const int ct = (u.pn & 3) * 256 + wc * 32 + 8 * fq; const float sc = t3 == 0 ? 0.125f : 1.0f;
        char* const dbase = (char*)Q + (size_t)(t3 >= 1 ? 1 : 0) * (size_t)((const char*)Kh - (const char*)Q) + (size_t)(t3 >= 2 ? 1 : 0) * (size_t)((const char*)Vh - (const char*)Kh);
        const int row0 = u.pm * BM + wr * 64 + fr;
        unsigned off0, st_ai, st_m, st_bj;
        if (t3 == 0) { off0 = (unsigned)(row0 * 2048 + ct * 2); st_ai = HALF * 2048; st_m = 16 * 2048; st_bj = HALF * 2; }
        else { const int b = row0 >> 13, s = row0 & (SEQ_ - 1); off0 = (unsigned)(((b * 16 + (ct >> 6)) * SEQ_ + s) * 128 + (ct & 63) * 2); st_ai = HALF * 128; st_m = 16 * 128; st_bj = 2 * SEQ_ * 128; }
#pragma unroll
        for (int ai = 0; ai < 2; ++ai)
#pragma unroll
            for (int m = 0; m < 4; ++m) { const float r = rs[ai][m] * sc;
#pragma unroll
                for (int bj = 0; bj < 2; ++bj) { const f32x4 v0 = acc[ai][bj][m][0] * r, v1 = acc[ai][bj][m][1] * r;
                    u32x4 w; w.x = cvt_pk_bf16(v0[0], v0[1]); w.y = cvt_pk_bf16(v0[2], v0[3]); w.z = cvt_pk_bf16(v1[0], v1[1]); w.w = cvt_pk_bf16(v1[2], v1[3]);
                    const unsigned off = off0 + ai * st_ai + m * st_m + bj * st_bj;
                    *(u32x4*)(dbase + (size_t)off) = w; } }
    }
};
struct EpiNSA {
    static constexpr bool BMAP2 = false, PERM = true, AFTER_DRAIN = false;
    const PG8_LAS unsigned char* lds; bf16_t* Q; bf16_t* KV; size_t kvsz; float* gates;
    __device__ __forceinline__ void operator()(const f32x4 (&acc)[2][2][4][2], const Unit& u, int ui, int wr, int wc, int fr_, int fq_) const {
        int fr = fr_, fq = fq_; asm volatile("" : "+v"(fr), "+v"(fq));
        float rs[2][4]; load_rstd(lds, ui, wr, fr, rs);
        const int pn = u.pn; const int cw = wc * 32 + 8 * fq;
        const int row0 = u.pm * BM + wr * 64 + fr;
        if (pn < 10) {
            char* const dbase = pn < 4 ? (char*)Q : (char*)KV + (size_t)(pn - 4) * kvsz * 2;
            unsigned off0, st_ai, st_m, st_bj;
            if (pn < 4) { off0 = (unsigned)(row0 * 2048 + (pn * 256 + cw) * 2); st_ai = HALF * 2048; st_m = 16 * 2048; st_bj = HALF * 2; }
            else { const int b = row0 >> 13, s = row0 & (SEQ_ - 1); off0 = (unsigned)(((b * 4 + (cw >> 6)) * SEQ_ + s) * 128 + (cw & 63) * 2); st_ai = HALF * 128; st_m = 16 * 128; st_bj = 2 * SEQ_ * 128; }
            const float sc = pn < 4 ? 0.125f : 1.0f;
#pragma unroll
            for (int ai = 0; ai < 2; ++ai)
#pragma unroll
                for (int m = 0; m < 4; ++m) { const float r = rs[ai][m] * sc;
#pragma unroll
                    for (int bj = 0; bj < 2; ++bj) { const f32x4 v0 = acc[ai][bj][m][0] * r, v1 = acc[ai][bj][m][1] * r;
                        u32x4 w; w.x = cvt_pk_bf16(v0[0], v0[1]); w.y = cvt_pk_bf16(v0[2], v0[3]); w.z = cvt_pk_bf16(v1[0], v1[1]); w.w = cvt_pk_bf16(v1[2], v1[3]);
                        *(u32x4*)(dbase + (size_t)(off0 + ai * st_ai + m * st_m + bj * st_bj)) = w; } }
        } else if (cw < 64) {
            const unsigned off0 = (unsigned)(row0 * 64 + cw) * 4u;
#pragma unroll
            for (int ai = 0; ai < 2; ++ai)
#pragma unroll
                for (int m = 0; m < 4; ++m) { const float r = rs[ai][m]; f32x4 v0 = acc[ai][0][m][0] * r, v1 = acc[ai][0][m][1] * r;
#pragma unroll
                    for (int e = 0; e < 4; ++e) { v0[e] = sigmoidf_(v0[e]); v1[e] = sigmoidf_(v1[e]); }
                    char* const dst = (char*)gates + (size_t)(off0 + ai * (HALF * 256) + m * (16 * 256)); *(f32x4*)dst = v0; *(f32x4*)(dst + 16) = v1; }
        }
    }
};
struct EpiSwiglu {
    static constexpr bool BMAP2 = false, PERM = true, AFTER_DRAIN = false;
    const PG8_LAS unsigned char* lds; bf16_t* act;
    __device__ __forceinline__ void operator()(const f32x4 (&acc)[2][2][4][2], const Unit& u, int ui, int wr, int wc, int fr_, int fq_) const {
        int fr = fr_, fq = fq_; asm volatile("" : "+v"(fr), "+v"(fq));
        float rs[2][4]; load_rstd(lds, ui, wr, fr, rs);
        const int c0 = u.pn * 128 + wc * 32 + 8 * fq; const unsigned off0 = (unsigned)((u.pm * BM + wr * 64 + fr) * 2816 + c0) * 2u;
#pragma unroll
        for (int ai = 0; ai < 2; ++ai)
#pragma unroll
            for (int m = 0; m < 4; ++m) { const float r = rs[ai][m]; u32x4 w; unsigned* wp = (unsigned*)&w;
                const float kk = -1.4426950408889634f * r, r2 = r * r;
#pragma unroll
                for (int n = 0; n < 2; ++n) { const f32x4 a = acc[ai][0][m][n], bb = acc[ai][1][m][n]; const f32x4 arg = a * kk; const f32x4 q = (a * bb) * r2; f32x4 sg;
#pragma unroll
                    for (int e = 0; e < 4; ++e) sg[e] = __builtin_amdgcn_exp2f(arg[e]);
                    sg = sg + 1.0f;
#pragma unroll
                    for (int e = 0; e < 4; ++e) sg[e] = __builtin_amdgcn_rcpf(sg[e]);
                    const f32x4 o = q * sg;
                    wp[2 * n] = cvt_pk_bf16(o[0], o[1]); wp[2 * n + 1] = cvt_pk_bf16(o[2], o[3]); }
                *(u32x4*)((char*)act + (size_t)(off0 + ai * (HALF * 5632) + m * (16 * 5632))) = w; }
    }
};
struct EpiBf16Plain {
    static constexpr bool BMAP2 = false, PERM = true, AFTER_DRAIN = false;
    bf16_t* O; int ldc;
    __device__ __forceinline__ void operator()(const f32x4 (&acc)[2][2][4][2], const Unit& u, int ui, int wr, int wc, int fr_, int fq_) const {
        int fr = fr_, fq = fq_; asm volatile("" : "+v"(fr), "+v"(fq));
        const int c0 = u.pn * BM + wc * 32 + 8 * fq; const unsigned off0 = (unsigned)((u.pm * BM + wr * 64 + fr) * ldc + c0) * 2u, st_r = (unsigned)ldc * 32u;
#pragma unroll
        for (int ai = 0; ai < 2; ++ai)
#pragma unroll
            for (int m = 0; m < 4; ++m) {
#pragma unroll
                for (int bj = 0; bj < 2; ++bj) { const f32x4 v0 = acc[ai][bj][m][0], v1 = acc[ai][bj][m][1];
                    u32x4 w; w.x = cvt_pk_bf16(v0[0], v0[1]); w.y = cvt_pk_bf16(v0[2], v0[3]); w.z = cvt_pk_bf16(v1[0], v1[1]); w.w = cvt_pk_bf16(v1[2], v1[3]);
                    *(u32x4*)((char*)O + (size_t)(off0 + (ai * 8 + m) * st_r + bj * (HALF * 2))) = w; } }
    }
};
__device__ __forceinline__ void unpack8(const u32x4& w, f32x4& lo, f32x4& hi) {
    lo[0] = __uint_as_float(w.x << 16); lo[1] = __uint_as_float(w.x & 0xffff0000u); lo[2] = __uint_as_float(w.y << 16); lo[3] = __uint_as_float(w.y & 0xffff0000u);
    hi[0] = __uint_as_float(w.z << 16); hi[1] = __uint_as_float(w.z & 0xffff0000u); hi[2] = __uint_as_float(w.w << 16); hi[3] = __uint_as_float(w.w & 0xffff0000u);
}
typedef float f32x2 __attribute__((ext_vector_type(2)));
__device__ __forceinline__ void ssq8(const f32x4& a, const f32x4& b, f32x2& s2) {
    const f32x2 a0 = {a[0], a[1]}, a1 = {a[2], a[3]}, b0 = {b[0], b[1]}, b1 = {b[2], b[3]};
    s2 = __builtin_elementwise_fma(a0, a0, s2); s2 = __builtin_elementwise_fma(a1, a1, s2); s2 = __builtin_elementwise_fma(b0, b0, s2); s2 = __builtin_elementwise_fma(b1, b1, s2);
}
template <bool BASEF32> struct EpiRes {
    static constexpr bool BMAP2 = false, PERM = true, AFTER_DRAIN = false;
    const void* base; bf16_t* hb; float* ssq;
    __device__ __forceinline__ void operator()(const f32x4 (&acc)[2][2][4][2], const Unit& u, int ui, int wr, int wc, int fr_, int fq_) const {
        int fr = fr_, fq = fq_; asm volatile("" : "+v"(fr), "+v"(fq));
        const int c0 = u.pn * BM + wc * 32 + 8 * fq; const int row0 = u.pm * BM + wr * 64 + fr; const unsigned eoff0 = (unsigned)(row0 * 1024 + c0);
#pragma unroll
        for (int ai = 0; ai < 2; ++ai) {
            f32x4 bl[4][2][2];
#pragma unroll
            for (int m = 0; m < 4; ++m)
#pragma unroll
                for (int bj = 0; bj < 2; ++bj) { const unsigned o2 = eoff0 + (unsigned)(ai * (HALF * 1024) + m * (16 * 1024) + bj * HALF);
                    if (BASEF32) { const char* bp = (const char*)base + (size_t)(o2 * 4u); bl[m][bj][0] = *(const f32x4*)bp; bl[m][bj][1] = *(const f32x4*)(bp + 16); }
                    else { const u32x4 pw = *(const u32x4*)((const char*)base + (size_t)(o2 * 2u)); bl[m][bj][0] = __builtin_bit_cast(f32x4, pw); } }
#pragma unroll
            for (int m = 0; m < 4; ++m) { const int row = row0 + ai * HALF + m * 16; float s = 0.f; f32x2 s2 = {0.f, 0.f};
#pragma unroll
                for (int bj = 0; bj < 2; ++bj) { const unsigned o2 = eoff0 + (unsigned)(ai * (HALF * 1024) + m * (16 * 1024) + bj * HALF); f32x4 v0, v1;
                    if (BASEF32) { v0 = bl[m][bj][0]; v1 = bl[m][bj][1]; }
                    else { unpack8(__builtin_bit_cast(u32x4, bl[m][bj][0]), v0, v1); }
                    v0 = v0 + acc[ai][bj][m][0]; v1 = v1 + acc[ai][bj][m][1];
                    u32x4 w; w.x = cvt_pk_bf16(v0[0], v0[1]); w.y = cvt_pk_bf16(v0[2], v0[3]); w.z = cvt_pk_bf16(v1[0], v1[1]); w.w = cvt_pk_bf16(v1[2], v1[3]); *(u32x4*)((char*)hb + (size_t)(o2 * 2u)) = w;
                    ssq8(v0, v1, s2); }
                s = s2[0] + s2[1]; s += __shfl_xor(s, 16); s += __shfl_xor(s, 32);
                if (fq == 0) ssq[(size_t)row * 16 + u.pn * 4 + wc] = s; }
        }
    }
};
template <bool LAST> struct EpiGate {
    static constexpr bool BMAP2 = false, PERM = true, AFTER_DRAIN = false;
    const PG8_LAS unsigned char* lds; const bf16_t* base; float* out; bf16_t* pp; float* ssq_out;
    __device__ __forceinline__ void operator()(const f32x4 (&acc)[2][2][4][2], const Unit& u, int ui, int wr, int wc, int fr_, int fq_) const {
        int fr = fr_, fq = fq_; asm volatile("" : "+v"(fr), "+v"(fq));
        float rs[2][4]; load_rstd(lds, ui, wr, fr, rs);
        const int c0 = u.pn * BM + wc * 32 + 8 * fq; const int row0 = u.pm * BM + wr * 64 + fr; const unsigned eoff0 = (unsigned)(row0 * 1024 + c0);
#pragma unroll
        for (int ai = 0; ai < 2; ++ai) {
            u32x4 lp[4][2], lb[4][2];
#pragma unroll
            for (int m = 0; m < 4; ++m)
#pragma unroll
                for (int bj = 0; bj < 2; ++bj) { const unsigned o2 = eoff0 + (unsigned)(ai * (HALF * 1024) + m * (16 * 1024) + bj * HALF);
                    lp[m][bj] = *(const u32x4*)((const char*)pp + (size_t)(o2 * 2u)); lb[m][bj] = *(const u32x4*)((const char*)base + (size_t)(o2 * 2u)); }
#pragma unroll
            for (int m = 0; m < 4; ++m) { const int row = row0 + ai * HALF + m * 16; const float r = rs[ai][m]; float s = 0.f; f32x2 s2 = {0.f, 0.f};
#pragma unroll
                for (int bj = 0; bj < 2; ++bj) { const unsigned o2 = eoff0 + (unsigned)(ai * (HALF * 1024) + m * (16 * 1024) + bj * HALF); const u32x4 pw = lp[m][bj], bw = lb[m][bj];
                    f32x4 p0, p1, v0, v1, g0, g1; unpack8(pw, p0, p1); unpack8(bw, v0, v1);
                    const float kk = -1.4426950408889634f * r; const f32x4 a0 = acc[ai][bj][m][0] * kk, a1 = acc[ai][bj][m][1] * kk;
#pragma unroll
                    for (int e = 0; e < 4; ++e) { g0[e] = __builtin_amdgcn_exp2f(a0[e]); g1[e] = __builtin_amdgcn_exp2f(a1[e]); }
                    g0 = g0 + 1.0f; g1 = g1 + 1.0f;
#pragma unroll
                    for (int e = 0; e < 4; ++e) { g0[e] = __builtin_amdgcn_rcpf(g0[e]); g1[e] = __builtin_amdgcn_rcpf(g1[e]); }
                    v0 = __builtin_elementwise_fma(g0, p0, v0); v1 = __builtin_elementwise_fma(g1, p1, v1);
                    if (LAST) { char* op = (char*)out + (size_t)(o2 * 4u); *(f32x4*)op = v0; *(f32x4*)(op + 16) = v1; }
                    else { u32x4 w; w.x = cvt_pk_bf16(v0[0], v0[1]); w.y = cvt_pk_bf16(v0[2], v0[3]); w.z = cvt_pk_bf16(v1[0], v1[1]); w.w = cvt_pk_bf16(v1[2], v1[3]); *(u32x4*)((char*)pp + (size_t)(o2 * 2u)) = w; }
                    ssq8(v0, v1, s2); }
                s = s2[0] + s2[1]; s += __shfl_xor(s, 16); s += __shfl_xor(s, 32);
                if (fq == 0) ssq_out[(size_t)row * 16 + u.pn * 4 + wc] = s; }
        }
    }
};
struct EpiGateFinal {
    static constexpr bool BMAP2 = false, PERM = true, AFTER_DRAIN = true;
    const PG8_LAS unsigned char* lds; const bf16_t* base; float* out; const bf16_t* pp; float* ssq; unsigned* cnt; const float* gfin; unsigned* tmo;
    __device__ __forceinline__ void operator()(const f32x4 (&)[2][2][4][2], const Unit&, int, int, int, int, int) const {}
    __device__ __forceinline__ void fused(const f32x4 (&acc)[2][2][4][2], const Unit& u, int wr, int wc, int fr_, int fq_, PG8_LAS unsigned char*, int, int) const {
        int fr = fr_, fq = fq_; asm volatile("" : "+v"(fr), "+v"(fq));
        float rs[2][4]; load_rstd(lds, 0, wr, fr, rs);
        const int c0 = u.pn * BM + wc * 32 + 8 * fq; const int row0 = u.pm * BM + wr * 64 + fr; const unsigned eoff0 = (unsigned)(row0 * 1024 + c0);
        f32x4 hv[2][4][2][2];
#pragma unroll
        for (int ai = 0; ai < 2; ++ai) {
            u32x4 lp[4][2], lb[4][2];
#pragma unroll
            for (int m = 0; m < 4; ++m)
#pragma unroll
                for (int bj = 0; bj < 2; ++bj) { const unsigned o2 = eoff0 + (unsigned)(ai * (HALF * 1024) + m * (16 * 1024) + bj * HALF);
                    lp[m][bj] = *(const u32x4*)((const char*)pp + (size_t)(o2 * 2u)); lb[m][bj] = *(const u32x4*)((const char*)base + (size_t)(o2 * 2u)); }
#pragma unroll
            for (int m = 0; m < 4; ++m) { const int row = row0 + ai * HALF + m * 16; const float r = rs[ai][m]; float s = 0.f; f32x2 s2 = {0.f, 0.f};
#pragma unroll
                for (int bj = 0; bj < 2; ++bj) { const u32x4 pw = lp[m][bj], bw = lb[m][bj];
                    f32x4 p0, p1, v0, v1, g0, g1; unpack8(pw, p0, p1); unpack8(bw, v0, v1);
                    const float kk = -1.4426950408889634f * r; const f32x4 a0 = acc[ai][bj][m][0] * kk, a1 = acc[ai][bj][m][1] * kk;
#pragma unroll
                    for (int e = 0; e < 4; ++e) { g0[e] = __builtin_amdgcn_exp2f(a0[e]); g1[e] = __builtin_amdgcn_exp2f(a1[e]); }
                    g0 = g0 + 1.0f; g1 = g1 + 1.0f;
#pragma unroll
                    for (int e = 0; e < 4; ++e) { g0[e] = __builtin_amdgcn_rcpf(g0[e]); g1[e] = __builtin_amdgcn_rcpf(g1[e]); }
                    v0 = __builtin_elementwise_fma(g0, p0, v0); v1 = __builtin_elementwise_fma(g1, p1, v1);
                    hv[ai][m][bj][0] = v0; hv[ai][m][bj][1] = v1;
                    ssq8(v0, v1, s2); }
                s = s2[0] + s2[1]; s += __shfl_xor(s, 16); s += __shfl_xor(s, 32);
                if (fq == 0) ssq[(size_t)row * 16 + u.pn * 4 + wc] = s; }
        }
        asm volatile("s_waitcnt vmcnt(0)" ::: "memory");
        __syncthreads();
        if (threadIdx.x == 0) {
            __builtin_amdgcn_fence(__ATOMIC_RELEASE, "agent");
            asm volatile("s_waitcnt vmcnt(0)" ::: "memory");
            unsigned* c = cnt + u.pm * 16;
            (void)__hip_atomic_fetch_add(c, 1u, __ATOMIC_RELAXED, __HIP_MEMORY_SCOPE_AGENT);
            unsigned sp = 0;
            while (__hip_atomic_load(c, __ATOMIC_RELAXED, __HIP_MEMORY_SCOPE_AGENT) < 4u) { __builtin_amdgcn_s_sleep(1); if (++sp > (1u << 22)) { atomicAdd(tmo, 1u); break; } }
            __builtin_amdgcn_fence(__ATOMIC_ACQUIRE, "agent");
            asm volatile("s_waitcnt vmcnt(0)" ::: "memory");
        }
        __syncthreads();
        f32x4 g[2][2];
#pragma unroll
        for (int bj = 0; bj < 2; ++bj) { g[bj][0] = *(const f32x4*)(gfin + c0 + bj * HALF); g[bj][1] = *(const f32x4*)(gfin + c0 + bj * HALF + 4); }
#pragma unroll
        for (int ai = 0; ai < 2; ++ai)
#pragma unroll
            for (int m = 0; m < 4; ++m) { const int row = row0 + ai * HALF + m * 16;
                const f32x4 q = *(const f32x4*)((const char*)ssq + (size_t)((unsigned)(row * 16 + fq * 4) * 4u));
                float t = (q[0] + q[1]) + (q[2] + q[3]); t += __shfl_xor(t, 16); t += __shfl_xor(t, 32);
                const float rr = rsqrtf(t * (1.0f / 1024.0f) + 1e-6f);
#pragma unroll
                for (int bj = 0; bj < 2; ++bj) { const unsigned o2 = eoff0 + (unsigned)(ai * (HALF * 1024) + m * (16 * 1024) + bj * HALF); char* op = (char*)out + (size_t)(o2 * 4u);
                    *(f32x4*)op = hv[ai][m][bj][0] * rr * g[bj][0]; *(f32x4*)(op + 16) = hv[ai][m][bj][1] * rr * g[bj][1]; } }
    }
};
struct EpiSlab {
    static constexpr bool BMAP2 = false, PERM = true, AFTER_DRAIN = false;
    bf16_t* slab;
    __device__ __forceinline__ void operator()(const f32x4 (&acc)[2][2][4][2], const Unit& u, int ui, int wr, int wc, int fr_, int fq_) const {
        int fr = fr_, fq = fq_; asm volatile("" : "+v"(fr), "+v"(fq));
        const int c0 = wc * 32 + 8 * fq; const unsigned off0 = (unsigned)((wr * 64 + fr) * 256 + c0) * 2u;
#pragma unroll
        for (int ai = 0; ai < 2; ++ai)
#pragma unroll
            for (int m = 0; m < 4; ++m) {
#pragma unroll
                for (int bj = 0; bj < 2; ++bj) { const f32x4 v0 = acc[ai][bj][m][0], v1 = acc[ai][bj][m][1];
                    u32x4 w; w.x = cvt_pk_bf16(v0[0], v0[1]); w.y = cvt_pk_bf16(v0[2], v0[3]); w.z = cvt_pk_bf16(v1[0], v1[1]); w.w = cvt_pk_bf16(v1[2], v1[3]);
                    *(u32x4*)((char*)slab + (size_t)(off0 + ai * (HALF * 512) + m * (16 * 512) + bj * (HALF * 2))) = w; } }
    }
};

template <class Epi, class Sched, int LDA, int LDB, int KK, bool ALIGN_EPI = false, bool SP2 = false>
__device__ __forceinline__ void gemm_phase(PG8_LAS unsigned char* lds, const Gemm g, const Sched& S, const Epi& E) {
    int tid_ = threadIdx.x; asm volatile("" : "+v"(tid_));
    const int tid = tid_, wid = __builtin_amdgcn_readfirstlane(tid >> 6), lane = tid & 63, wr = wid >> 2, wc = wid & 3, fr = lane & 15, fq = lane >> 4;
    constexpr int K = KK, nt = K / BK;
    unsigned voffA[2], voffB[2];
#pragma unroll
    for (int i = 0; i < 2; ++i) { int R, C; stage_rc(tid * 16 + i * 8192, R, C); const int Rb = Epi::BMAP2 ? (64 * (R >> 5) + perm32(R & 31)) : (Epi::PERM ? ((R & ~31) + perm32(R & 31)) : R);
        voffA[i] = (unsigned)(R * LDA + C) * 2u; voffB[i] = (unsigned)(Rb * LDB + C) * 2u; }
    constexpr size_t kstep = (size_t)(BK * 2);
    constexpr size_t hstepA = (size_t)HALF * LDA * 2, hstepB = (size_t)(Epi::BMAP2 ? 32 : HALF) * LDB * 2;
    constexpr size_t tstepA = 2 * hstepA, tstepB = (size_t)2 * HALF * LDB * 2;
    const unsigned ldsw = (unsigned)wid * 1024u;
    const int aoff = lds_byte(wr * 64 + fr, fq * 8), boff = lds_byte(wc * 32 + fr, fq * 8);
#define PG8_SA(b, h) (((b) * 2 + (h)) * HTB)
#define PG8_SB(b, h) ((4 + (b) * 2 + (h)) * HTB)
#define PG8_STAGE_(bufoff, rsrc, soff, voff) do { _Pragma("unroll") for (int _i = 0; _i < 2; ++_i) \
        __builtin_amdgcn_raw_ptr_buffer_load_lds(rsrc, (PG8_LAS unsigned*)(lds + (bufoff) + ldsw + _i * 8192), 16, (int)(voff)[_i], (int)(soff), 0, 0); } while (0)
#define PG8_STAGEA(bufoff, soff) PG8_STAGE_(bufoff, rA, soff, voffA)
#define PG8_STAGEB(bufoff, soff) PG8_STAGE_(bufoff, rB, soff, voffB)
#define PG8_LDA(dst, b, h) do { _Pragma("unroll") for (int m = 0; m < 4; ++m) _Pragma("unroll") for (int k = 0; k < 2; ++k) dst[m][k] = *(const PG8_LAS bf16x8*)(lds + PG8_SA(b, h) + aoff + m * 2048 + k * 1024); } while (0)
#define PG8_LDB(dst, b, h) do { _Pragma("unroll") for (int n = 0; n < 2; ++n) _Pragma("unroll") for (int k = 0; k < 2; ++k) dst[n][k] = *(const PG8_LAS bf16x8*)(lds + PG8_SB(b, h) + boff + n * 2048 + k * 1024); } while (0)
#define PG8_MMA(ai, bj, At, Bt) do { __builtin_amdgcn_s_setprio(1); _Pragma("unroll") for (int m = 0; m < 4; ++m) _Pragma("unroll") for (int n = 0; n < 2; ++n) _Pragma("unroll") for (int k = 0; k < 2; ++k) \
        acc[ai][bj][m][n] = __builtin_amdgcn_mfma_f32_16x16x32_bf16(Bt[n][k], At[m][k], acc[ai][bj][m][n], 0, 0, 0); __builtin_amdgcn_s_setprio(0); } while (0)
#define PG8_MMA0(ai, bj, At, Bt) do { __builtin_amdgcn_s_setprio(1); _Pragma("unroll") for (int m = 0; m < 4; ++m) _Pragma("unroll") for (int n = 0; n < 2; ++n) { \
        acc[ai][bj][m][n] = __builtin_amdgcn_mfma_f32_16x16x32_bf16(Bt[n][0], At[m][0], (f32x4){0.f, 0.f, 0.f, 0.f}, 0, 0, 0); \
        acc[ai][bj][m][n] = __builtin_amdgcn_mfma_f32_16x16x32_bf16(Bt[n][1], At[m][1], acc[ai][bj][m][n], 0, 0, 0); } __builtin_amdgcn_s_setprio(0); } while (0)
#define PG8_WAIT_V(n) asm volatile("s_waitcnt vmcnt(" #n ")" ::: "memory")
#define PG8_WAIT_L(n) asm volatile("s_waitcnt lgkmcnt(" #n ")" ::: "memory")
#define PG8_BAR __builtin_amdgcn_s_barrier()
#define PG8_SCHED __builtin_amdgcn_sched_barrier(0)
    Unit cur, nxt; int ui = 0;
    if (!S.next(0, cur)) return;
    f32x4 acc[2][2][4][2];
    if constexpr (!SP2)
#pragma unroll
    for (int a = 0; a < 2; ++a)
#pragma unroll
        for (int b = 0; b < 2; ++b)
#pragma unroll
            for (int m = 0; m < 4; ++m)
#pragma unroll
                for (int n = 0; n < 2; ++n) acc[a][b][m][n] = (f32x4){0.f, 0.f, 0.f, 0.f};
    bf16x8 At[4][2], B0[2][2], B1[2][2];
    const unsigned long long pA_ = (unsigned long long)g.A, pB_ = (unsigned long long)g.Bt;
    void* const uA = (void*)(((unsigned long long)(unsigned)__builtin_amdgcn_readfirstlane((int)(unsigned)(pA_ >> 32)) << 32) | (unsigned)__builtin_amdgcn_readfirstlane((int)(unsigned)pA_));
    void* const uB = (void*)(((unsigned long long)(unsigned)__builtin_amdgcn_readfirstlane((int)(unsigned)(pB_ >> 32)) << 32) | (unsigned)__builtin_amdgcn_readfirstlane((int)(unsigned)pB_));
    const __amdgpu_buffer_rsrc_t rA = __builtin_amdgcn_make_buffer_rsrc(uA, 0, 0x7ffffff0, 0x00020000), rB = __builtin_amdgcn_make_buffer_rsrc(uB, 0, 0x7ffffff0, 0x00020000);
    unsigned cA = (unsigned)cur.pm * (unsigned)tstepA, cB = (unsigned)cur.pn * (unsigned)tstepB;
    S.a_ready(cur);
    if constexpr (SP2) {
        PG8_STAGEB(PG8_SB(0, 0), cB); PG8_STAGEB(PG8_SB(0, 1), cB + hstepB); PG8_STAGEA(PG8_SA(0, 0), cA); PG8_STAGEA(PG8_SA(0, 1), cA + hstepA);
        if (wr == 1) PG8_BAR;
        PG8_WAIT_V(2); PG8_BAR;
        PG8_STAGEB(PG8_SB(1, 0), cB + kstep); PG8_STAGEA(PG8_SA(1, 0), cA + kstep); PG8_STAGEB(PG8_SB(1, 1), cB + hstepB + kstep);
        PG8_WAIT_V(6); PG8_BAR;
    } else {
        PG8_STAGEB(PG8_SB(0, 0), cB); PG8_STAGEA(PG8_SA(0, 0), cA); PG8_STAGEB(PG8_SB(0, 1), cB + hstepB); PG8_STAGEA(PG8_SA(0, 1), cA + hstepA);
        if (wr == 1) PG8_BAR;
        PG8_WAIT_V(4); PG8_BAR;
        PG8_STAGEB(PG8_SB(1, 0), cB + kstep); PG8_STAGEA(PG8_SA(1, 0), cA + kstep); PG8_STAGEB(PG8_SB(1, 1), cB + hstepB + kstep);
        PG8_WAIT_V(6); PG8_BAR;
    }
    for (;;) {
        const bool has_next = S.next(ui + 1, nxt);
        const unsigned nA = has_next ? (unsigned)nxt.pm * (unsigned)tstepA : cA, nB = has_next ? (unsigned)nxt.pn * (unsigned)tstepB : cB;
        for (int t = 0; t < nt; t += 2) {
            const bool last = (t == nt - 2);
            const unsigned a1 = cA + (unsigned)(t + 1) * (unsigned)kstep;
            const unsigned a2 = last ? nA : cA + (unsigned)(t + 2) * (unsigned)kstep, b2 = last ? nB : cB + (unsigned)(t + 2) * (unsigned)kstep;
            const unsigned a3 = a2 + (unsigned)kstep, b3 = b2 + (unsigned)kstep;
            if (last && has_next) S.a_ready(nxt);
            if constexpr (SP2) {
            PG8_LDB(B0, 0, 0); PG8_LDB(B1, 0, 1); PG8_SCHED; PG8_LDA(At, 0, 0); PG8_STAGEA(PG8_SA(1, 1), a1 + hstepA);
            PG8_WAIT_V(8); PG8_WAIT_L(0); PG8_BAR; if (t == 0) { PG8_MMA0(0, 0, At, B0); PG8_MMA0(0, 1, At, B1); } else { PG8_MMA(0, 0, At, B0); PG8_MMA(0, 1, At, B1); } PG8_BAR; PG8_SCHED;
            PG8_LDA(At, 0, 1); PG8_STAGEB(PG8_SB(0, 0), b2); PG8_STAGEB(PG8_SB(0, 1), b2 + hstepB); PG8_STAGEA(PG8_SA(0, 0), a2);
            PG8_WAIT_V(8); PG8_WAIT_L(0); PG8_BAR; if (t == 0) { PG8_MMA0(1, 0, At, B0); PG8_MMA0(1, 1, At, B1); } else { PG8_MMA(1, 0, At, B0); PG8_MMA(1, 1, At, B1); } PG8_BAR; PG8_SCHED;
            PG8_LDB(B0, 1, 0); PG8_LDB(B1, 1, 1); PG8_SCHED; PG8_LDA(At, 1, 0); PG8_STAGEA(PG8_SA(0, 1), a2 + hstepA);
            PG8_WAIT_V(8); PG8_WAIT_L(0); PG8_BAR; PG8_MMA(0, 0, At, B0); PG8_MMA(0, 1, At, B1); PG8_BAR; PG8_SCHED;
            PG8_LDA(At, 1, 1); PG8_STAGEB(PG8_SB(1, 0), b3); PG8_STAGEB(PG8_SB(1, 1), b3 + hstepB); PG8_STAGEA(PG8_SA(1, 0), a3);
            PG8_WAIT_V(8); PG8_WAIT_L(0); PG8_BAR; PG8_MMA(1, 0, At, B0); PG8_MMA(1, 1, At, B1); PG8_BAR; PG8_SCHED;
            } else {
            PG8_LDB(B0, 0, 0); PG8_SCHED; PG8_LDA(At, 0, 0); PG8_STAGEA(PG8_SA(1, 1), a1 + hstepA);
            PG8_WAIT_L(8); PG8_BAR; PG8_WAIT_L(0); PG8_MMA(0, 0, At, B0); PG8_BAR; PG8_SCHED;
            PG8_LDB(B1, 0, 1); PG8_STAGEB(PG8_SB(0, 0), b2);
            PG8_BAR; PG8_WAIT_L(0); PG8_MMA(0, 1, At, B1); PG8_BAR;
            PG8_LDA(At, 0, 1); PG8_STAGEA(PG8_SA(0, 0), a2);
            PG8_BAR; PG8_WAIT_L(0); PG8_MMA(1, 0, At, B0); PG8_BAR; PG8_SCHED;
            PG8_STAGEB(PG8_SB(0, 1), b2 + hstepB);
            PG8_WAIT_V(6); PG8_BAR; PG8_MMA(1, 1, At, B1); PG8_BAR;
            PG8_LDB(B0, 1, 0); PG8_SCHED; PG8_LDA(At, 1, 0); PG8_STAGEA(PG8_SA(0, 1), a2 + hstepA);
            PG8_WAIT_L(8); PG8_BAR; PG8_WAIT_L(0); PG8_MMA(0, 0, At, B0); PG8_BAR; PG8_SCHED;
            PG8_LDB(B1, 1, 1); PG8_STAGEB(PG8_SB(1, 0), b3);
            PG8_BAR; PG8_WAIT_L(0); PG8_MMA(0, 1, At, B1); PG8_BAR;
            PG8_LDA(At, 1, 1); PG8_STAGEA(PG8_SA(1, 0), a3);
            PG8_BAR; PG8_WAIT_L(0); PG8_MMA(1, 0, At, B0); PG8_BAR; PG8_SCHED;
            PG8_STAGEB(PG8_SB(1, 1), b3 + hstepB);
            PG8_WAIT_V(6); PG8_BAR; PG8_MMA(1, 1, At, B1); PG8_BAR;
            }
        }
        if constexpr (ALIGN_EPI) { if (wr == 0) PG8_BAR; }
        if constexpr (!Epi::AFTER_DRAIN) { E(acc, cur, ui, wr, wc, fr, fq); S.done(cur); }
        if (!has_next) break;
        if constexpr (!SP2)
#pragma unroll
        for (int a = 0; a < 2; ++a)
#pragma unroll
            for (int b = 0; b < 2; ++b)
#pragma unroll
                for (int m = 0; m < 4; ++m)
#pragma unroll
                    for (int n = 0; n < 2; ++n) acc[a][b][m][n] = (f32x4){0.f, 0.f, 0.f, 0.f};
        cur = nxt; cA = nA; cB = nB; ++ui;
        if constexpr (ALIGN_EPI) { if (wr == 1) PG8_BAR; }
    }
    PG8_WAIT_V(0);
    if constexpr (!ALIGN_EPI) { if (wr == 0) PG8_BAR; }
    PG8_BAR;
    if constexpr (Epi::AFTER_DRAIN) { E.fused(acc, cur, wr, wc, fr, fq, lds, wid, lane); S.done(cur); }
#undef PG8_SA
#undef PG8_SB
#undef PG8_STAGE_
#undef PG8_STAGEA
#undef PG8_STAGEB
#undef PG8_LDA
#undef PG8_LDB
#undef PG8_MMA
#undef PG8_MMA0
#undef PG8_WAIT_V
#undef PG8_WAIT_L
#undef PG8_BAR
#undef PG8_SCHED
}
}
#ifndef PG8_SP2
#define PG8_SP2 true
#endif
#ifndef PG8_ALIGN
#define PG8_ALIGN true
#endif
constexpr int NWAVES = 8;
constexpr int BATCH = 2, T = 8192, D = 1024, H = 16, HD = 64, FF = 2816, HKV = 4;
constexpr int M = BATCH * T;
constexpr int NQKV = 3 * D, NNSA_SRC = 2608, NNSA = 2816, NFFI = 2 * FF, PLE = 256;
constexpr int NCMP = 511, CMPH = 256, CMPK = 2048;
constexpr float RMS_EPS = 1e-6f;
constexpr size_t MiB = 1u << 20;
constexpr size_t WS_CTL = 0, CTL_ZERO_BYTES = 1 * MiB;
constexpr size_t WS_WQKV = 2 * MiB;
constexpr size_t WS_WO0  = WS_WQKV + (size_t)NQKV * D * 2;
constexpr size_t WS_WFI0 = WS_WO0 + (size_t)D * D * 2;
constexpr size_t WS_WFO0 = WS_WFI0 + (size_t)NFFI * D * 2;
constexpr size_t WS_WG0  = WS_WFO0 + (size_t)D * FF * 2;
constexpr size_t WS_WP0  = WS_WG0 + (size_t)D * D * 2;
constexpr size_t WS_WNSA = WS_WP0 + (size_t)D * PLE * 2;
constexpr size_t WS_WO1  = WS_WNSA + (size_t)NNSA * D * 2;
constexpr size_t WS_WFI1 = WS_WO1 + (size_t)D * D * 2;
constexpr size_t WS_WFO1 = WS_WFI1 + (size_t)NFFI * D * 2;
constexpr size_t WS_WG1  = WS_WFO1 + (size_t)D * FF * 2;
constexpr size_t WS_WP1  = WS_WG1 + (size_t)D * D * 2;
constexpr size_t WS_WCK  = WS_WP1 + (size_t)D * PLE * 2;
constexpr size_t WS_WCV  = WS_WCK + (size_t)CMPH * CMPK * 2;
constexpr size_t WS_WEND = WS_WCV + (size_t)CMPH * CMPK * 2;
static_assert(WS_WEND <= 58 * MiB, "weights");
constexpr size_t WS_HB   = 58 * MiB;
constexpr size_t WS_KSELF = WS_HB, WS_VSELF = WS_HB + 8 * MiB;
constexpr size_t WS_SLAB = WS_HB + 16 * MiB;
constexpr size_t WS_PARKG = WS_HB + 16 * MiB;
constexpr size_t WS_KWINF = 110 * MiB, WS_VWINF = 118 * MiB;
constexpr size_t WS_KCF = 126 * MiB, WS_VCF = 126 * MiB + 512 * 1024;
constexpr size_t WS_SSQ0 = 90 * MiB, WS_SSQ1 = 91 * MiB;
constexpr size_t WS_MISC = 93 * MiB;
constexpr size_t WS_KCVC = 92 * MiB;
constexpr size_t WS_PB   = 94 * MiB;
constexpr size_t WS_QO   = 128 * MiB;
constexpr size_t WS_K0   = 160 * MiB, WS_V0 = 192 * MiB;
constexpr size_t WS_ACT  = 128 * MiB;
constexpr size_t WS_PP   = 224 * MiB;
constexpr size_t WS_KV1  = 160 * MiB;
constexpr size_t KVSZ    = (size_t)BATCH * HKV * T * HD;
constexpr size_t WS_GATES = 208 * MiB;
constexpr size_t WS_SPARE = 212 * MiB;
constexpr size_t WS_END  = 256 * MiB;
static_assert(WS_ACT + (size_t)M * FF * 2 <= WS_PP && WS_SPARE + 32 * MiB <= WS_END, "ws map");
constexpr int CW_TMO = 0, CW_CODE = 1;
constexpr int CW_BAR = 4096;
constexpr int CW_PANEL = 16384;
constexpr int RING_OFF = 0, RING_BYTES = 131072;
constexpr int LDS_BYTES = 148480;
constexpr int LDSCTL_OFF = LDS_BYTES - 512, MISC_OFF = LDSCTL_OFF + 320;
static_assert(MISC_OFF + 128 <= LDS_BYTES, "LDS map");

#define GAS __attribute__((address_space(1)))
#define LAS __attribute__((address_space(3)))
typedef unsigned short bf16;
typedef unsigned v4u __attribute__((ext_vector_type(4)));
typedef float f32x4 __attribute__((ext_vector_type(4)));
typedef short bf16x8 __attribute__((ext_vector_type(8)));
typedef unsigned u32x4_t __attribute__((ext_vector_type(4)));
typedef unsigned u32x2_t __attribute__((ext_vector_type(2)));
typedef GAS unsigned gu32;
typedef GAS unsigned long long gu64;
#define RLX_AGENT __ATOMIC_RELAXED, __HIP_MEMORY_SCOPE_AGENT
#define LDS_WAIT() asm volatile("s_waitcnt lgkmcnt(0)" ::: "memory")
#define VM_WAIT() asm volatile("s_waitcnt vmcnt(0)" ::: "memory")
__device__ __forceinline__ unsigned long long rt() { return __builtin_amdgcn_s_memrealtime(); }
__device__ __forceinline__ unsigned f2bf(float f) { unsigned u = __builtin_bit_cast(unsigned, f); return (u + 0x7fffu + ((u >> 16) & 1u)) >> 16; }
__device__ __forceinline__ unsigned pk2(float lo, float hi) { return f2bf(lo) | (f2bf(hi) << 16); }

#define XB_TMO      128
#define XB_XCNT(j)  (256  + 64 * (j))
#define XB_XSUB(j)  (1280 + 64 * (j))
#define XB_XGEN(j)  (2304 + 64 * (j))
#define XB_TOP      3328
#define XB_TOPGEN   3392
#define XCD_BAR_WORDS 3456
#define XB_SPIN_CAP (1u << 18)

__device__ __forceinline__ unsigned xb_ld(unsigned* p)              { return __hip_atomic_load(p, __ATOMIC_RELAXED, __HIP_MEMORY_SCOPE_AGENT); }
__device__ __forceinline__ unsigned xb_add(unsigned* p, unsigned v) { return __hip_atomic_fetch_add(p, v, __ATOMIC_RELAXED, __HIP_MEMORY_SCOPE_AGENT); }
__device__ __forceinline__ unsigned xb_xcc_id() { return (unsigned)__builtin_amdgcn_s_getreg((3 << 11) | 20) & 0xFu; }
#define XB_SPIN(cond, bar) do { unsigned _sp = 0; while (cond) { __builtin_amdgcn_s_sleep(1); \
    if ((++_sp & 255u) == 0u) { if (xb_ld(&(bar)[XB_TMO])) break; if (_sp > XB_SPIN_CAP) { atomicAdd(&(bar)[XB_TMO], 1u); break; } } } } while (0)

struct XcdBarrier {
    unsigned* bar; unsigned x;
    volatile LAS unsigned* st;
};

__device__ __forceinline__ XcdBarrier xcd_barrier_post(unsigned* bar, volatile LAS unsigned* st) {
    XcdBarrier b; b.bar = bar; b.x = xb_xcc_id(); b.st = st;
    if (threadIdx.x == 0) (void)xb_add(&bar[XB_XCNT(b.x)], 1u);
    return b;
}
__device__ __forceinline__ void xcd_barrier_complete(unsigned* bar, unsigned x, unsigned& nloc, unsigned& nx) {
    const unsigned G = gridDim.x * gridDim.y * gridDim.z;
    unsigned sum, cnt, mine, sp = 0u;
    for (;;) {
        sum = 0u; cnt = 0u; mine = 0u;
#pragma unroll
        for (unsigned j = 0; j < 16; ++j) { const unsigned c = xb_ld(&bar[XB_XCNT(j)]); sum += c; cnt += (c > 0u) ? 1u : 0u; }
        mine = xb_ld(&bar[XB_XCNT(x)]);
        if (sum == G) break;
        __builtin_amdgcn_s_sleep(1);
        if ((++sp & 255u) == 0u) { if (xb_ld(&bar[XB_TMO])) break; if (sp > XB_SPIN_CAP) { atomicAdd(&bar[XB_TMO], 1u); break; } }
    }
    nloc = mine > 0u ? mine : 1u; nx = cnt > 0u ? cnt : 1u;
}

__device__ __forceinline__ void xcd_barrier(const XcdBarrier& b) {
    asm volatile("s_waitcnt vmcnt(0)" ::: "memory");
    __syncthreads();
    if (threadIdx.x == 0) {
        unsigned* bar = b.bar;
        __builtin_amdgcn_s_waitcnt(0);
        unsigned nloc = b.st[0], nx = b.st[1];
        if (nloc == 0u) { xcd_barrier_complete(bar, b.x, nloc, nx); b.st[0] = nloc; b.st[1] = nx; }
        const unsigned old = xb_add(&bar[XB_XSUB(b.x)], 1u);
        const unsigned gen = old / nloc;
        if (old + 1u == (gen + 1u) * nloc) {
            __builtin_amdgcn_fence(__ATOMIC_RELEASE, "agent");
            asm volatile("s_waitcnt vmcnt(0)" ::: "memory");
            const unsigned og = xb_add(&bar[XB_TOP], 1u);
            const unsigned tg = og / nx;
            if (og + 1u == (tg + 1u) * nx) xb_add(&bar[XB_TOPGEN], 1u);
            else XB_SPIN(xb_ld(&bar[XB_TOPGEN]) == tg, bar);
            __builtin_amdgcn_fence(__ATOMIC_ACQUIRE, "agent");
            xb_add(&bar[XB_XGEN(b.x)], 1u);
            asm volatile("s_waitcnt vmcnt(0)" ::: "memory");
        } else {
            XB_SPIN(xb_ld(&bar[XB_XGEN(b.x)]) == gen, bar);
            __builtin_amdgcn_fence(__ATOMIC_ACQUIRE, "agent");
            asm volatile("s_waitcnt vmcnt(0)" ::: "memory");
        }
    }
    __syncthreads();
}
struct Frame {
    LAS unsigned char* lds;
    int tid, lane, wave;
    int vcu, G;
};
struct Args { const float* in[21]; float* out; unsigned char* ws; };
typedef const __attribute__((address_space(4))) Args* ArgsP;
__device__ __forceinline__ ArgsP kargs() { ArgsP p = (ArgsP)__builtin_amdgcn_kernarg_segment_ptr(); asm volatile("" : "+s"(p)); return p; }
__device__ __forceinline__ float wave_sum(float v) {
#pragma unroll
    for (int o = 1; o < 64; o <<= 1) v += __shfl_xor(v, o);
    return v;
}
__device__ __forceinline__ float wave_max(float v) {
#pragma unroll
    for (int o = 1; o < 64; o <<= 1) v = fmaxf(v, __shfl_xor(v, o));
    return v;
}
__device__ __forceinline__ unsigned long long wave_max_u64(unsigned long long v) {
#pragma unroll
    for (int o = 1; o < 64; o <<= 1) { const unsigned lo = __shfl_xor((unsigned)v, o), hi = __shfl_xor((unsigned)(v >> 32), o); const unsigned long long w = ((unsigned long long)hi << 32) | lo; v = w > v ? w : v; }
    return v;
}
__device__ __forceinline__ float dpp_xor1(float v) { return __uint_as_float(__builtin_amdgcn_update_dpp(0u, __float_as_uint(v), 0xB1, 0xF, 0xF, false)); }
__device__ __forceinline__ float dpp_xor2(float v) { return __uint_as_float(__builtin_amdgcn_update_dpp(0u, __float_as_uint(v), 0x4E, 0xF, 0xF, false)); }
__device__ __forceinline__ float swap32(float v) { auto rr = __builtin_amdgcn_permlane32_swap(__float_as_uint(v), __float_as_uint(v), false, false); return __uint_as_float((threadIdx.x & 32) ? rr[0] : rr[1]); }
__device__ __forceinline__ float bflo(unsigned u) { return __uint_as_float(u << 16); }
__device__ __forceinline__ float bfhi(unsigned u) { return __uint_as_float(u & 0xffff0000u); }
__device__ __forceinline__ float bf2f(bf16 u) { return __uint_as_float((unsigned)u << 16); }

template <int MAP> __device__ __forceinline__ void conv_item(const float* W, int K, int Nsrc, int Ndst, const float* gain, bf16* WT, LAS float* scr, int item, int lane) {
    const int nblk = Ndst / 32, kb = item / nblk, nb = item % nblk, k0 = 64 * kb, n0 = 32 * nb;
    const int u = lane & 7; int sc, r0;
    if (MAP == 2) { sc = ((n0 & 128) ? FF : 0) + 128 * (n0 >> 8) + (n0 & 127) + 4 * u; r0 = 4 * u; }
    else { sc = n0 + 4 * u; r0 = 4 * u; if (MAP == 1 && sc >= Nsrc) sc = -1; }
    f32x4 v[8];
#pragma unroll
    for (int i = 0; i < 8; ++i) { const int kk = (lane >> 3) + 8 * i; v[i] = sc >= 0 ? *(const GAS f32x4*)(W + (size_t)(k0 + kk) * Nsrc + sc) : (f32x4){0.f, 0.f, 0.f, 0.f}; }
    if (gain) {
#pragma unroll
        for (int i = 0; i < 8; ++i) v[i] = v[i] * gain[k0 + (lane >> 3) + 8 * i]; }
#pragma unroll
    for (int i = 0; i < 8; ++i) { const int kk = (lane >> 3) + 8 * i; LAS float* d = scr + kk * 33 + r0; d[0] = v[i].x; d[1] = v[i].y; d[2] = v[i].z; d[3] = v[i].w; }
    LDS_WAIT(); asm volatile("" ::: "memory");
    const int c = lane & 7;
#pragma unroll
    for (int j = 0; j < 4; ++j) { const int n = (lane >> 3) + 8 * j; const LAS float* s = scr + (8 * c) * 33 + n;
        v4u o; o.x = pk2(s[0 * 33], s[1 * 33]); o.y = pk2(s[2 * 33], s[3 * 33]); o.z = pk2(s[4 * 33], s[5 * 33]); o.w = pk2(s[6 * 33], s[7 * 33]);
        *(GAS v4u*)(WT + (size_t)(n0 + n) * K + k0 + 8 * c) = o; }
    LDS_WAIT(); asm volatile("" ::: "memory");
}
#define WSP(T_, off) ((T_*)(ap->ws + (off)))
__device__ __forceinline__ void b1_partials(Frame& F, int gw, int NGW) {
    ArgsP ap = kargs();
    float* b1p = WSP(float, WS_MISC);
    for (int it = gw; it < 64; it += NGW) { const int which = it >> 5, c = (it >> 2) & 7, jb = it & 3, j = jb * 64 + F.lane;
        const float* pe = which ? ap->in[12] : ap->in[11]; const float* w1 = which ? ap->in[15] : ap->in[13]; float a = 0.f;
        for (int kk = c * 256; kk < c * 256 + 256; ++kk) a += pe[kk] * w1[(size_t)kk * CMPH + j];
        b1p[(which * 8 + c) * 256 + j] = a; }
}
template <int DEFER> __device__ __forceinline__ void p0_prologue(Frame& F, int dgw = 0, int dngw = 1) {
    ArgsP ap = kargs();
    LAS float* scr = (LAS float*)(F.lds + RING_OFF + F.wave * 16384);
    const int gw = F.vcu * NWAVES + F.wave, NGW = F.G * NWAVES;
    constexpr int I_QKV = (D / 64) * (NQKV / 32), I_DD = (D / 64) * (D / 32), I_FI = (D / 64) * (NFFI / 32), I_FO = (FF / 64) * (D / 32), I_P = (PLE / 64) * (D / 32),
                  I_NSA = (D / 64) * (NNSA / 32), I_C = (CMPK / 64) * (CMPH / 32);
    constexpr int NITEMS = I_QKV + I_DD + I_FI + I_FO + I_DD + I_P + I_NSA + I_DD + I_FI + I_FO + I_DD + I_P + I_C + I_C;
    constexpr int DEF_A = I_QKV + I_DD + I_FI + I_FO + I_DD + I_P + I_NSA, DEF_B = DEF_A + I_DD + I_FI + I_FO + I_DD + I_P;
    const int it_first = DEFER == 1 ? DEF_A + dgw : DEFER == 2 ? I_QKV + dgw : gw, it_step = DEFER ? dngw : NGW, it_last = DEFER == 1 ? DEF_B : DEFER == 2 ? DEF_A : NITEMS;
    for (int it = it_first; it < it_last; it += it_step) {
        if (!DEFER && F.G == 256 && it >= I_QKV && it < DEF_B) continue;
        int r = it;
        if (r < I_QKV) { conv_item<0>(ap->in[7], D, NQKV, NQKV, ap->in[3], WSP(bf16, WS_WQKV), scr, r, F.lane); continue; } r -= I_QKV;
        if (r < I_DD)  { conv_item<0>(ap->in[8], D, D, D, nullptr, WSP(bf16, WS_WO0), scr, r, F.lane); continue; } r -= I_DD;
        if (r < I_FI)  { conv_item<2>(ap->in[17], D, NFFI, NFFI, ap->in[4], WSP(bf16, WS_WFI0), scr, r, F.lane); continue; } r -= I_FI;
        if (r < I_FO)  { conv_item<0>(ap->in[18], FF, D, D, nullptr, WSP(bf16, WS_WFO0), scr, r, F.lane); continue; } r -= I_FO;
        if (r < I_DD)  { conv_item<0>(ap->in[20], D, D, D, ap->in[5], WSP(bf16, WS_WG0), scr, r, F.lane); continue; } r -= I_DD;
        if (r < I_P)   { conv_item<0>(ap->in[19], PLE, D, D, nullptr, WSP(bf16, WS_WP0), scr, r, F.lane); continue; } r -= I_P;
        if (r < I_NSA) { conv_item<1>(ap->in[9], D, NNSA_SRC, NNSA, ap->in[3] + D, WSP(bf16, WS_WNSA), scr, r, F.lane); continue; } r -= I_NSA;
        if (r < I_DD)  { conv_item<0>(ap->in[10], D, D, D, nullptr, WSP(bf16, WS_WO1), scr, r, F.lane); continue; } r -= I_DD;
        if (r < I_FI)  { conv_item<2>(ap->in[17] + (size_t)D * NFFI, D, NFFI, NFFI, ap->in[4] + D, WSP(bf16, WS_WFI1), scr, r, F.lane); continue; } r -= I_FI;
        if (r < I_FO)  { conv_item<0>(ap->in[18] + (size_t)FF * D, FF, D, D, nullptr, WSP(bf16, WS_WFO1), scr, r, F.lane); continue; } r -= I_FO;
        if (r < I_DD)  { conv_item<0>(ap->in[20] + (size_t)D * D, D, D, D, ap->in[5] + D, WSP(bf16, WS_WG1), scr, r, F.lane); continue; } r -= I_DD;
        if (r < I_P)   { conv_item<0>(ap->in[19] + (size_t)PLE * D, PLE, D, D, nullptr, WSP(bf16, WS_WP1), scr, r, F.lane); continue; } r -= I_P;
        if (r < I_C)   { conv_item<0>(ap->in[13], CMPK, CMPH, CMPH, nullptr, WSP(bf16, WS_WCK), scr, r, F.lane); continue; } r -= I_C;
        conv_item<0>(ap->in[15], CMPK, CMPH, CMPH, nullptr, WSP(bf16, WS_WCV), scr, r, F.lane);
    }
    if (DEFER) return;
    {
        bf16* hb = WSP(bf16, WS_HB); float* ssq = WSP(float, WS_SSQ0);
        for (int m = gw; m < M; m += NGW) {
            const GAS f32x4* xr = (const GAS f32x4*)(ap->in[0] + (size_t)m * D) + F.lane; f32x4 v[4]; float s = 0.f;
#pragma unroll
            for (int j = 0; j < 4; ++j) { v[j] = xr[64 * j]; s += (v[j].x * v[j].x + v[j].y * v[j].y) + (v[j].z * v[j].z + v[j].w * v[j].w); }
            s = wave_sum(s);
            GAS unsigned long long* o8 = (GAS unsigned long long*)(hb + (size_t)m * D) + F.lane;
#pragma unroll
            for (int j = 0; j < 4; ++j) o8[64 * j] = (unsigned long long)pk2(v[j].x, v[j].y) | ((unsigned long long)pk2(v[j].z, v[j].w) << 32);
            if (F.lane < 16) ssq[(size_t)m * 16 + F.lane] = F.lane == 0 ? s : 0.f;
        }
    }
    {
        const GAS f32x4* p4 = (const GAS f32x4*)ap->in[1]; GAS unsigned long long* o8 = (GAS unsigned long long*)WSP(bf16, WS_PB);
        const int NI = (F.G == 256 ? 1 : 2) * M * PLE / 4; const int gt = F.vcu * (NWAVES * 64) + F.tid, NTH = F.G * NWAVES * 64;
        for (int i = gt; i < NI; i += NTH) { const f32x4 v = p4[i]; o8[i] = (unsigned long long)pk2(v.x, v.y) | ((unsigned long long)pk2(v.z, v.w) << 32); }
    }
    if (F.G != 256) b1_partials(F, gw, NGW);
}

__device__ __forceinline__ int t5_bucket(int n) {
    if (n < 16) return n < 0 ? 0 : n;
    if (n >= 113) return 31;
    return 16 + (n >= 19) + (n >= 21) + (n >= 24) + (n >= 27) + (n >= 31) + (n >= 35) + (n >= 40) + (n >= 46) + (n >= 52) + (n >= 59) + (n >= 67) + (n >= 77) + (n >= 87) + (n >= 99);
}
__device__ __forceinline__ void load_q64(float (&q)[64], const bf16* p) {
    const uint4* p4 = (const uint4*)p;
#pragma unroll
    for (int i = 0; i < 8; ++i) { const uint4 w = p4[i]; q[8 * i + 0] = bflo(w.x); q[8 * i + 1] = bfhi(w.x); q[8 * i + 2] = bflo(w.y); q[8 * i + 3] = bfhi(w.y);
        q[8 * i + 4] = bflo(w.z); q[8 * i + 5] = bfhi(w.z); q[8 * i + 6] = bflo(w.w); q[8 * i + 7] = bfhi(w.w); }
}
__device__ __forceinline__ float dot64(const float (&q)[64], const bf16* p) {
    const uint4* p4 = (const uint4*)p; float a = 0.f;
#pragma unroll
    for (int i = 0; i < 8; ++i) { const uint4 w = p4[i];
        a += q[8 * i + 0] * bflo(w.x); a += q[8 * i + 1] * bfhi(w.x); a += q[8 * i + 2] * bflo(w.y); a += q[8 * i + 3] * bfhi(w.y);
        a += q[8 * i + 4] * bflo(w.z); a += q[8 * i + 5] * bfhi(w.z); a += q[8 * i + 6] * bflo(w.w); a += q[8 * i + 7] * bfhi(w.w); }
    return a;
}
__device__ __forceinline__ void sb_simple(Frame& F) {
    ArgsP ap = kargs();
    bf16* QO = WSP(bf16, WS_QO); const bf16* Kh = WSP(bf16, WS_K0); const bf16* Vh = WSP(bf16, WS_V0);
    const int gt = F.vcu * (NWAVES * 64) + F.tid, NTH = F.G * NWAVES * 64;
    for (int it = gt; it < BATCH * H * T; it += NTH) {
        const int t = it & (T - 1), h = (it >> 13) & 15, b = it >> 17;
        bf16* qp = QO + ((size_t)(b * T + t)) * D + h * HD;
        float q[64]; load_q64(q, qp);
        float o[64];
#pragma unroll
        for (int d = 0; d < 64; ++d) o[d] = 0.f;
        const bf16* kp = Kh + ((size_t)(b * H + h) * T) * HD; const bf16* vp = Vh + ((size_t)(b * H + h) * T) * HD;
        float carry = 0.f;
        for (int s = t - 1; s >= 0; --s) {
            const float z = dot64(q, kp + (size_t)s * HD);
            const float sp = fmaxf(z, 0.f) + log1pf(expf(-fabsf(z)));
            const float a = expf((z - sp) + carry);
            const uint4* v4 = (const uint4*)(vp + (size_t)s * HD);
#pragma unroll
            for (int i = 0; i < 8; ++i) { const uint4 w = v4[i];
                o[8 * i + 0] += a * bflo(w.x); o[8 * i + 1] += a * bfhi(w.x); o[8 * i + 2] += a * bflo(w.y); o[8 * i + 3] += a * bfhi(w.y);
                o[8 * i + 4] += a * bflo(w.z); o[8 * i + 5] += a * bfhi(w.z); o[8 * i + 6] += a * bflo(w.w); o[8 * i + 7] += a * bfhi(w.w); }
            carry -= sp;
            if (carry < -104.f) break;
        }
        uint4* o4 = (uint4*)qp;
#pragma unroll
        for (int i = 0; i < 8; ++i) { uint4 w; w.x = pk2(o[8 * i + 0], o[8 * i + 1]); w.y = pk2(o[8 * i + 2], o[8 * i + 3]); w.z = pk2(o[8 * i + 4], o[8 * i + 5]); w.w = pk2(o[8 * i + 6], o[8 * i + 7]); o4[i] = w; }
    }
}
typedef _Float16 f16x8 __attribute__((ext_vector_type(8)));
typedef float f32x16 __attribute__((ext_vector_type(16)));
typedef short v4i16_t __attribute__((ext_vector_type(4)));
__device__ __forceinline__ bf16x8 tr_pair(const LAS unsigned char* p0, const LAS unsigned char* p1) {
    const v4i16_t lo = __builtin_amdgcn_ds_read_tr16_b64_v4i16((LAS v4i16_t*)p0), hi = __builtin_amdgcn_ds_read_tr16_b64_v4i16((LAS v4i16_t*)p1);
    return (bf16x8){lo[0], lo[1], lo[2], lo[3], hi[0], hi[1], hi[2], hi[3]};
}
__device__ __forceinline__ unsigned pkbf(float lo, float hi) { typedef float f2 __attribute__((ext_vector_type(2))); typedef __bf16 b2 __attribute__((ext_vector_type(2))); f2 v = {lo, hi}; b2 b = __builtin_convertvector(v, b2); return __builtin_bit_cast(unsigned, b); }
__device__ __forceinline__ void sb_mfma(Frame& F, size_t out_off = WS_QO) {
    ArgsP ap = kargs();
    LAS unsigned char* vl = F.lds + RING_OFF + F.wave * 16384;
    const int lane = F.lane, c = lane & 31, hh = lane >> 5;
    bf16* QO = WSP(bf16, WS_QO); const bf16* Kh = WSP(bf16, WS_K0); const bf16* Vh = WSP(bf16, WS_V0);
    f16x8 U0, U1;
    { u32x4_t w0, w1; unsigned short e0[8], e1[8];
#pragma unroll
      for (int j = 0; j < 8; ++j) { const int k0 = 8 * (j >> 2) + 4 * hh + (j & 3); e0[j] = (k0 > c) ? 0x3C00 : 0; e1[j] = (16 + k0 > c) ? 0x3C00 : 0; }
      w0.x = e0[0] | ((unsigned)e0[1] << 16); w0.y = e0[2] | ((unsigned)e0[3] << 16); w0.z = e0[4] | ((unsigned)e0[5] << 16); w0.w = e0[6] | ((unsigned)e0[7] << 16);
      w1.x = e1[0] | ((unsigned)e1[1] << 16); w1.y = e1[2] | ((unsigned)e1[3] << 16); w1.z = e1[4] | ((unsigned)e1[5] << 16); w1.w = e1[6] | ((unsigned)e1[7] << 16);
      U0 = __builtin_bit_cast(f16x8, w0); U1 = __builtin_bit_cast(f16x8, w1); }
    const LAS unsigned char* vrd = vl + (4 * hh + ((lane & 15) >> 2)) * 128 + (16 * ((lane >> 4) & 1) + 4 * (lane & 3)) * 2;
    LAS unsigned char* vwr = vl + (lane >> 1) * 128 + (lane & 1) * 64;
    const int gw = F.vcu * NWAVES + F.wave, NGW = F.G * NWAVES;
    constexpr float L2E = 1.4426950408889634f, LN2 = 0.6931471805599453f;
    for (int it = gw; it < BATCH * H * (T / 32); it += NGW) {
        const int qt = it & 255, hd = (it >> 8) & 15, b = it >> 12;
        bf16* Qp = QO + ((size_t)(b * T + 32 * qt + c)) * D + hd * HD;
        bf16x8 Qf[4];
#pragma unroll
        for (int ks = 0; ks < 4; ++ks) Qf[ks] = *(const bf16x8*)(Qp + 16 * ks + 8 * hh);
        const bf16* Kb = Kh + ((size_t)(b * H + hd) * T) * HD; const bf16* Vb = Vh + ((size_t)(b * H + hd) * T) * HD;
        f32x16 O0, O1;
#pragma unroll
        for (int r = 0; r < 16; ++r) { O0[r] = 0.f; O1[r] = 0.f; }
        float carry = 0.f;
        bf16x8 Kn[4]; u32x4_t Vn[4];
        { const bf16* kp = Kb + (size_t)(32 * qt + c) * HD + 8 * hh; const bf16* vp = Vb + (size_t)(32 * qt + (lane >> 1)) * HD + (lane & 1) * 32;
#pragma unroll
          for (int i = 0; i < 4; ++i) { Kn[i] = *(const bf16x8*)(kp + 16 * i); Vn[i] = *(const u32x4_t*)(vp + 8 * i); } }
        for (int kt = qt; kt >= 0; --kt) {
            bf16x8 Kc[4]; u32x4_t Vc[4];
#pragma unroll
            for (int i = 0; i < 4; ++i) { Kc[i] = Kn[i]; Vc[i] = Vn[i]; }
            { const int kn = kt > 0 ? kt - 1 : 0; const bf16* kp = Kb + (size_t)(32 * kn + c) * HD + 8 * hh; const bf16* vp = Vb + (size_t)(32 * kn + (lane >> 1)) * HD + (lane & 1) * 32;
#pragma unroll
                for (int i = 0; i < 4; ++i) { Kn[i] = *(const bf16x8*)(kp + 16 * i); Vn[i] = *(const u32x4_t*)(vp + 8 * i); } }
#pragma unroll
            for (int i = 0; i < 4; ++i) *(LAS u32x4_t*)(vwr + 16 * i) = Vc[i];
            f32x16 z;
#pragma unroll
            for (int r = 0; r < 16; ++r) z[r] = 0.f;
#pragma unroll
            for (int ks = 0; ks < 4; ++ks) z = __builtin_amdgcn_mfma_f32_32x32x16_bf16(Kc[ks], Qf[ks], z, 0, 0, 0);
            const bool diag = kt == qt;
            float lf[16], ls[16]; float tot = 0.f;
#pragma unroll
            for (int r = 0; r < 16; ++r) { const int key = (r & 3) + 8 * (r >> 2) + 4 * hh; const bool valid = !diag || key < c; const float zz = z[r];
                const float sp = fmaxf(zz, 0.f) + LN2 * __builtin_amdgcn_logf(1.0f + __builtin_amdgcn_exp2f(-fabsf(zz) * L2E));
                lf[r] = valid ? -sp : 0.f; ls[r] = valid ? zz - sp : -INFINITY; tot += lf[r]; }
            const f16x8 X0 = {(_Float16)lf[0], (_Float16)lf[1], (_Float16)lf[2], (_Float16)lf[3], (_Float16)lf[4], (_Float16)lf[5], (_Float16)lf[6], (_Float16)lf[7]};
            const f16x8 X1 = {(_Float16)lf[8], (_Float16)lf[9], (_Float16)lf[10], (_Float16)lf[11], (_Float16)lf[12], (_Float16)lf[13], (_Float16)lf[14], (_Float16)lf[15]};
            f32x16 Y;
#pragma unroll
            for (int r = 0; r < 16; ++r) Y[r] = 0.f;
            Y = __builtin_amdgcn_mfma_f32_32x32x16_f16(U0, X0, Y, 0, 0, 0); Y = __builtin_amdgcn_mfma_f32_32x32x16_f16(U1, X1, Y, 0, 0, 0);
            tot += __shfl_xor(tot, 32);
            float a[16];
#pragma unroll
            for (int r = 0; r < 16; ++r) a[r] = __builtin_amdgcn_exp2f((ls[r] + Y[r] + carry) * L2E);
            bf16x8 P0, P1; { u32x4_t w0, w1; w0.x = pkbf(a[0], a[1]); w0.y = pkbf(a[2], a[3]); w0.z = pkbf(a[4], a[5]); w0.w = pkbf(a[6], a[7]); w1.x = pkbf(a[8], a[9]); w1.y = pkbf(a[10], a[11]); w1.z = pkbf(a[12], a[13]); w1.w = pkbf(a[14], a[15]);
                P0 = __builtin_bit_cast(bf16x8, w0); P1 = __builtin_bit_cast(bf16x8, w1); }
            O0 = __builtin_amdgcn_mfma_f32_32x32x16_bf16(tr_pair(vrd, vrd + 8 * 128), P0, O0, 0, 0, 0);
            O0 = __builtin_amdgcn_mfma_f32_32x32x16_bf16(tr_pair(vrd + 16 * 128, vrd + 24 * 128), P1, O0, 0, 0, 0);
            O1 = __builtin_amdgcn_mfma_f32_32x32x16_bf16(tr_pair(vrd + 64, vrd + 64 + 8 * 128), P0, O1, 0, 0, 0);
            O1 = __builtin_amdgcn_mfma_f32_32x32x16_bf16(tr_pair(vrd + 64 + 16 * 128, vrd + 64 + 24 * 128), P1, O1, 0, 0, 0);
            carry += tot;
            if (__all(carry < -104.0f)) break;
        }
#pragma unroll
        for (int rg = 0; rg < 4; ++rg) { u32x2_t w0, w1; w0.x = pkbf(O0[4 * rg], O0[4 * rg + 1]); w0.y = pkbf(O0[4 * rg + 2], O0[4 * rg + 3]); w1.x = pkbf(O1[4 * rg], O1[4 * rg + 1]); w1.y = pkbf(O1[4 * rg + 2], O1[4 * rg + 3]);
            bf16* Op = WSP(bf16, out_off) + ((size_t)(b * T + 32 * qt + c)) * D + hd * HD;
            *(u32x2_t*)(Op + 8 * rg + 4 * hh) = w0; *(u32x2_t*)(Op + 32 + 8 * rg + 4 * hh) = w1; }
    }
}
__device__ __forceinline__ float gelu_tanh(float x) { const float u = 0.7978845608028654f * (x + 0.044715f * x * x * x); return 0.5f * x * (1.0f + tanhf(u)); }
__device__ __forceinline__ void cmp_stage2_generic(Frame& F) {
    ArgsP ap = kargs();
    LAS float* hbuf = (LAS float*)(F.lds + RING_OFF + F.wave * 16384);
    const int gw = F.vcu * NWAVES + F.wave, NGW = F.G * NWAVES;
    const bf16* slab = WSP(bf16, WS_SLAB); const float* b1p = WSP(float, WS_MISC); bf16* kcvc = WSP(bf16, WS_KCVC);
    for (int it = gw; it < 2 * 1024; it += NGW) {
        const int which = it >> 10, r0 = (it & 1023) * 4, tile = r0 >> 8;
        const float* w2 = which ? ap->in[16] : ap->in[14];
        float bias[4];
#pragma unroll
        for (int q = 0; q < 4; ++q) { const int j = F.lane + 64 * q; float bsum = 0.f;
#pragma unroll
            for (int c = 0; c < 8; ++c) bsum += b1p[(which * 8 + c) * 256 + j];
            bias[q] = bsum; }
#pragma unroll
        for (int rw = 0; rw < 4; ++rw) { const int rr = (r0 + rw) & 255;
#pragma unroll
            for (int q = 0; q < 4; ++q) { const int j = F.lane + 64 * q; float pre = bias[q];
#pragma unroll
                for (int ks = 0; ks < 4; ++ks) pre += bf2f(slab[((size_t)((ks * 2 + which) * 16 + tile) * 256 + rr) * 256 + j]);
                hbuf[rw * 256 + j] = gelu_tanh(pre); } }
        LDS_WAIT(); asm volatile("" ::: "memory");
        float a[4] = {0.f, 0.f, 0.f, 0.f};
        const float* w2l = w2 + F.lane;
        float wv[32], wn[32];
#pragma unroll
        for (int u = 0; u < 32; ++u) wv[u] = w2l[u * 64];
#pragma unroll 1
        for (int j0 = 0; j0 < 256; j0 += 32) {
            const int jn = j0 + 32 < 256 ? j0 + 32 : j0;
#pragma unroll
            for (int u = 0; u < 32; ++u) wn[u] = w2l[(jn + u) * 64];
#pragma unroll
            for (int u4 = 0; u4 < 8; ++u4) {
#pragma unroll
                for (int rw = 0; rw < 4; ++rw) { const f32x4 h4 = *(const LAS f32x4*)(hbuf + rw * 256 + j0 + 4 * u4);
                    a[rw] += h4[0] * wv[4 * u4 + 0]; a[rw] += h4[1] * wv[4 * u4 + 1]; a[rw] += h4[2] * wv[4 * u4 + 2]; a[rw] += h4[3] * wv[4 * u4 + 3]; } }
#pragma unroll
            for (int u = 0; u < 32; ++u) wv[u] = wn[u];
        }
#pragma unroll
        for (int rw = 0; rw < 4; ++rw) { const int r = r0 + rw, i = r & 511; const float av = i >= NCMP ? 0.f : a[rw];
            kcvc[((size_t)which * 4096 + r) * 64 + F.lane] = (bf16)f2bf(av);
            const int bh_ = r >> 9, blk = i >> 6, nn = i & 63, d = F.lane;
            if (which == 0) { const int tl = nn >> 5, r32 = nn & 31, ks = d >> 4, h = (d >> 3) & 1, e = d & 7; WSP(bf16, WS_KCF)[(((size_t)(bh_ * 8 + blk) * 8 + 4 * tl + ks) * 64 + r32 + 32 * h) * 8 + e] = (bf16)f2bf(av); }
            else { const int k4 = nn >> 4, kk = nn & 15, e = ((kk >> 3) << 2) | (kk & 3), hA = (kk >> 2) & 1, dt = d >> 5, dp = d & 31; WSP(bf16, WS_VCF)[(((size_t)(bh_ * 8 + blk) * 8 + 4 * dt + k4) * 64 + dp + 32 * hA) * 8 + e] = (bf16)f2bf(av); } }
        LDS_WAIT(); asm volatile("" ::: "memory");
    }
}
__device__ __forceinline__ void cmp_stage2(Frame& F) {
    if (F.G != 256) { cmp_stage2_generic(F); return; }
    ArgsP ap = kargs();
    LAS float* hbuf = (LAS float*)(F.lds + RING_OFF + F.wave * 16384);
    const int it = F.vcu * NWAVES + F.wave;
    const int which = F.vcu >> 7, r0 = (it & 1023) * 4, tile = r0 >> 8;
    const float* w2 = which ? ap->in[16] : ap->in[14];
    const bf16* slab = WSP(bf16, WS_SLAB); const float* b1p = WSP(float, WS_MISC); bf16* kcvc = WSP(bf16, WS_KCVC);
    f32x4 wst[8];
#pragma unroll
    for (int k = 0; k < 8; ++k) wst[k] = *(const f32x4*)(w2 + F.tid * 4 + k * 2048);
    float bias[4];
#pragma unroll
    for (int q = 0; q < 4; ++q) { const int j = F.lane + 64 * q; float bsum = 0.f;
#pragma unroll
        for (int c = 0; c < 8; ++c) bsum += b1p[(which * 8 + c) * 256 + j];
        bias[q] = bsum; }
#pragma unroll
    for (int rw = 0; rw < 4; ++rw) { const int rr = (r0 + rw) & 255;
#pragma unroll
        for (int q = 0; q < 4; ++q) { const int j = F.lane + 64 * q; float pre = bias[q];
#pragma unroll
            for (int ks = 0; ks < 4; ++ks) pre += bf2f(slab[((size_t)((ks * 2 + which) * 16 + tile) * 256 + rr) * 256 + j]);
            hbuf[rw * 256 + j] = gelu_tanh(pre); } }
#pragma unroll
    for (int k = 0; k < 8; ++k) { const int e = F.tid * 4 + k * 2048, j = e >> 6, cc = e & 63;
        *(LAS f32x4*)(F.lds + RING_OFF + (j >> 5) * 16384 + 8192 + (j & 31) * 256 + cc * 4) = wst[k]; }
    LDS_WAIT(); __builtin_amdgcn_s_barrier(); asm volatile("" ::: "memory");
    float a[4] = {0.f, 0.f, 0.f, 0.f};
#pragma unroll 2
    for (int jb = 0; jb < 8; ++jb) {
        const LAS float* ws = (const LAS float*)(F.lds + RING_OFF + jb * 16384 + 8192) + F.lane;
#pragma unroll
        for (int u4 = 0; u4 < 8; ++u4) {
            f32x4 h4[4];
#pragma unroll
            for (int rw = 0; rw < 4; ++rw) h4[rw] = *(const LAS f32x4*)(hbuf + rw * 256 + jb * 32 + 4 * u4);
#pragma unroll
            for (int e = 0; e < 4; ++e) { const float wv = ws[(4 * u4 + e) * 64];
#pragma unroll
                for (int rw = 0; rw < 4; ++rw) a[rw] += h4[rw][e] * wv; } }
    }
#pragma unroll
    for (int rw = 0; rw < 4; ++rw) { const int r = r0 + rw, i = r & 511; const float av = i >= NCMP ? 0.f : a[rw];
        kcvc[((size_t)which * 4096 + r) * 64 + F.lane] = (bf16)f2bf(av);
        const int bh_ = r >> 9, blk = i >> 6, nn = i & 63, d = F.lane;
        if (which == 0) { const int tl = nn >> 5, r32 = nn & 31, ks = d >> 4, h = (d >> 3) & 1, e = d & 7; WSP(bf16, WS_KCF)[(((size_t)(bh_ * 8 + blk) * 8 + 4 * tl + ks) * 64 + r32 + 32 * h) * 8 + e] = (bf16)f2bf(av); }
        else { const int k4 = nn >> 4, kk = nn & 15, e = ((kk >> 3) << 2) | (kk & 3), hA = (kk >> 2) & 1, dt = d >> 5, dp = d & 31; WSP(bf16, WS_VCF)[(((size_t)(bh_ * 8 + blk) * 8 + 4 * dt + k4) * 64 + dp + 32 * hA) * 8 + e] = (bf16)f2bf(av); } }
    LDS_WAIT(); asm volatile("" ::: "memory");
}
__device__ __forceinline__ void nsa_simple(Frame& F, size_t out_off = WS_QO) {
    ArgsP ap = kargs();
    LAS float* pbuf = (LAS float*)(F.lds + RING_OFF + F.wave * 16384);
    LAS float* pg = pbuf + 1024;
    LAS float* obuf = pbuf + 1536;
    LAS int* selb = (LAS int*)(pbuf + 2304);
    const int gw = F.vcu * NWAVES + F.wave, NGW = F.G * NWAVES, lane = F.lane;
    bf16* NQ = WSP(bf16, WS_QO); const bf16* KV = WSP(bf16, WS_KV1); const bf16* KCVC = WSP(bf16, WS_KCVC);
    const float* gates = WSP(float, WS_GATES); const float* rel_bias = ap->in[2];
    for (int it = gw; it < BATCH * HKV * T; it += NGW) {
        const int t = it & (T - 1), hkv = (it >> 13) & 3, b = it >> 15, bh = b * 4 + hkv, cur = t >> 6;
        const bf16* kc = KCVC + (size_t)bh * 512 * 64; const bf16* vc = KCVC + (size_t)4096 * 64 + (size_t)bh * 512 * 64;
        const bf16* ksel = KV + 2 * KVSZ + (size_t)bh * T * HD; const bf16* vsel = KV + 3 * KVSZ + (size_t)bh * T * HD;
        const bf16* kwin = KV + 4 * KVSZ + (size_t)bh * T * HD; const bf16* vwin = KV + 5 * KVSZ + (size_t)bh * T * HD;
        bf16* qrow = NQ + (size_t)(b * T + t) * D + hkv * 256;
        const int nv = t >= 31 ? ((t - 31) >> 4) + 1 : 0;
#pragma unroll 1
        for (int i = 0; i < 8; ++i) pg[lane + 64 * i] = 0.f;
#pragma unroll 1
        for (int g = 0; g < 4; ++g) {
            const int hq = hkv * 4 + g; float qv[64]; load_q64(qv, qrow + g * 64);
            float mx = -INFINITY;
#pragma unroll 1
            for (int i = 0; i < 8; ++i) { const int n = lane + 64 * i;
                const float sc = n < nv ? dot64(qv, kc + (size_t)n * 64) + rel_bias[t5_bucket(t - 16 * n - 31) * 16 + hq] : -INFINITY; pbuf[n] = sc; mx = fmaxf(mx, sc); }
            mx = wave_max(mx); const float mm = mx == -INFINITY ? 0.f : mx; float sum = 0.f;
#pragma unroll 1
            for (int i = 0; i < 8; ++i) { const int n = lane + 64 * i; const float e = n < nv ? expf(pbuf[n] - mm) : 0.f; pbuf[n] = e; sum += e; }
            sum = wave_sum(sum); const float inv = 1.0f / (sum > 0.f ? sum : 1.0f);
#pragma unroll 1
            for (int i = 0; i < 8; ++i) { const int n = lane + 64 * i; const float p = pbuf[n] * inv; pbuf[n] = p; pg[n] += p; }
            LDS_WAIT(); asm volatile("" ::: "memory");
            float a = 0.f;
            for (int n = 0; n < nv; ++n) a += pbuf[n] * bf2f(vc[(size_t)n * 64 + lane]);
            obuf[g * 64 + lane] = a;
            LDS_WAIT(); asm volatile("" ::: "memory");
        }
        unsigned long long key[2];
#pragma unroll
        for (int q = 0; q < 2; ++q) { const int j = lane + 64 * q; float imp = 0.f;
#pragma unroll
            for (int dn = -1; dn <= 3; ++dn) { const int n = 4 * j + dn; if (n >= 0 && n < 512) imp += pg[n]; }
            const bool forced = (j == 0) || (j == cur) || (j == cur - 1); const float val = forced ? 100.0f : imp;
            key[q] = j <= cur ? (((unsigned long long)__float_as_uint(val) << 32) | (unsigned)(128 - j)) : 0ull; }
#pragma unroll 1
        for (int r = 0; r < 16; ++r) { unsigned long long k = key[0] > key[1] ? key[0] : key[1]; k = wave_max_u64(k);
            const int sj = k ? 128 - (int)(unsigned)(k & 0xffffffffull) : -1; if (lane == 0) selb[r] = sj;
            if (k) { if (key[0] == k) key[0] = 0ull; if (key[1] == k) key[1] = 0ull; } }
        LDS_WAIT(); asm volatile("" ::: "memory");
#pragma unroll 1
        for (int g = 0; g < 4; ++g) {
            const int hq = hkv * 4 + g; float qv[64]; load_q64(qv, qrow + g * 64);
            float mx = -INFINITY;
#pragma unroll 1
            for (int r = 0; r < 16; ++r) { const int sj = selb[r]; const int pos = sj * 64 + lane, dist = t - pos;
                const float sc = (sj >= 0 && dist >= 0) ? dot64(qv, ksel + (size_t)pos * 64) + rel_bias[t5_bucket(dist) * 16 + hq] : -INFINITY; pbuf[r * 64 + lane] = sc; mx = fmaxf(mx, sc); }
            mx = wave_max(mx); float sum = 0.f;
#pragma unroll 1
            for (int r = 0; r < 16; ++r) { const float sc = pbuf[r * 64 + lane]; const float e = sc == -INFINITY ? 0.f : expf(sc - mx); pbuf[r * 64 + lane] = e; sum += e; }
            sum = wave_sum(sum); const float inv = 1.0f / sum;
            LDS_WAIT(); asm volatile("" ::: "memory");
            float a = 0.f;
#pragma unroll 1
            for (int r = 0; r < 16; ++r) { const int sj = selb[r]; if (sj < 0) continue; const bf16* vb = vsel + (size_t)sj * 64 * 64 + lane;
                for (int kk = 0; kk < 64; ++kk) a += pbuf[r * 64 + kk] * bf2f(vb[kk * 64]); }
            obuf[256 + g * 64 + lane] = a * inv;
            LDS_WAIT(); asm volatile("" ::: "memory");
            mx = -INFINITY;
#pragma unroll 1
            for (int i = 0; i < 8; ++i) { const int kk = lane + 64 * i, pos = t - 511 + kk;
                const float sc = pos >= 0 ? dot64(qv, kwin + (size_t)pos * 64) + rel_bias[t5_bucket(511 - kk) * 16 + hq] : -INFINITY; pbuf[kk] = sc; mx = fmaxf(mx, sc); }
            mx = wave_max(mx); sum = 0.f;
#pragma unroll 1
            for (int i = 0; i < 8; ++i) { const int kk = lane + 64 * i; const float sc = pbuf[kk]; const float e = sc == -INFINITY ? 0.f : expf(sc - mx); pbuf[kk] = e; sum += e; }
            sum = wave_sum(sum); const float inv2 = 1.0f / sum;
            LDS_WAIT(); asm volatile("" ::: "memory");
            a = 0.f;
            for (int kk = (t >= 511 ? 0 : 511 - t); kk < 512; ++kk) a += pbuf[kk] * bf2f(vwin[(size_t)(t - 511 + kk) * 64 + lane]);
            obuf[512 + g * 64 + lane] = a * inv2;
            LDS_WAIT(); asm volatile("" ::: "memory");
        }
        const float* gr = gates + (size_t)(b * T + t) * 64 + hkv * 4;
#pragma unroll
        for (int g = 0; g < 4; ++g) { const float v = gr[g] * obuf[g * 64 + lane] + gr[16 + g] * obuf[256 + g * 64 + lane] + gr[32 + g] * obuf[512 + g * 64 + lane]; (WSP(bf16, out_off) + (size_t)(b * T + t) * D + hkv * 256)[g * 64 + lane] = (bf16)f2bf(v); }
        LDS_WAIT(); asm volatile("" ::: "memory");
    }
}

constexpr int NSA_KP = 144, NSA_VP = 192;
constexpr int NSA_KBUF = 64 * NSA_KP, NSA_VBUF = 64 * NSA_VP, NSA_BUF = NSA_KBUF + NSA_VBUF;
constexpr int NSA_OFF_IMP = 2 * NSA_BUF;
constexpr int NSA_OFF_BIAS = 126976;
constexpr int NSA_OFF_SEL = NSA_OFF_BIAS + 4 * 128 * 4;
constexpr int NSA_OFF_T1 = NSA_OFF_SEL + 64 * 16;
static_assert(NSA_OFF_IMP + 64 * 128 * 4 <= NSA_OFF_BIAS && NSA_OFF_T1 + 4 * 256 * 4 <= LDSCTL_OFF, "NSA LDS map");
constexpr float NSA_L2E = 1.4426950408889634f;
struct NsaState { f32x16 O0, O1; float m, l; };
__device__ __forceinline__ void nsa_reset(NsaState& s) {
#pragma unroll
    for (int r = 0; r < 16; ++r) { s.O0[r] = 0.f; s.O1[r] = 0.f; }
    s.m = -INFINITY; s.l = 0.f;
}
template <bool NEAR, int MASK, int PASS, bool TB = false, bool KPF = false>
__device__ __forceinline__ void nsa_step_r(NsaState& st, bf16x8 (&Kc)[8], const bf16x8 (&Vc)[8], const LAS unsigned char* Qrow  , int lane, float cbias2, int dbase, int dstep,
                                         const LAS float* biasg, float minv  , float linv  , float (&gs)[8], float (&lastv)[8], const char* knext = nullptr) {
    const int hh = lane >> 5;
    bf16x8 Qf[4];
#pragma unroll
    for (int ks = 0; ks < 4; ++ks) Qf[ks] = *(const LAS bf16x8*)(Qrow + 32 * ks);
    f32x16 S[2];
#pragma unroll
    for (int tl = 0; tl < 2; ++tl) {
#pragma unroll
        for (int r = 0; r < 16; ++r) S[tl][r] = 0.f;
#pragma unroll
        for (int ks = 0; ks < 4; ++ks) S[tl] = __builtin_amdgcn_mfma_f32_32x32x16_bf16(Kc[tl * 4 + ks], Qf[ks], S[tl], 0, 0, 0);
    }
    if (KPF) { const unsigned vo_ = (unsigned)lane * 16u;
#pragma unroll
        for (int f_ = 0; f_ < 8; ++f_) Kc[f_] = *(const bf16x8*)(knext + (vo_ + (unsigned)f_ * 1024u)); }
    { asm volatile("" : "+v"(dbase)); }
    float mx = -INFINITY, mx2 = -INFINITY; constexpr bool PLAIN = !NEAR && MASK == 0;
    if (PLAIN) {
        float m0 = fmaxf(S[0][0], S[1][0]), m1 = fmaxf(S[0][1], S[1][1]);
#pragma unroll
        for (int r = 2; r < 16; r += 2) { m0 = fmaxf(m0, fmaxf(S[0][r], S[1][r])); m1 = fmaxf(m1, fmaxf(S[0][r + 1], S[1][r + 1])); }
        mx = fmaxf(m0, m1) * NSA_L2E + cbias2;
    } else if (TB) {
        const LAS float* tb = biasg + (dbase + 1 - 4 * hh);
#pragma unroll
        for (int tl = 0; tl < 2; ++tl) {
            if (tl == 1) asm volatile("" ::: "memory");
#pragma unroll
            for (int r = 0; r < 16; ++r) { const float v = __builtin_fmaf(S[tl][r], NSA_L2E, tb[63 - (32 * tl + (r & 3) + 8 * (r >> 2))]); S[tl][r] = v; if (r & 1) mx = fmaxf(mx, v); else mx2 = fmaxf(mx2, v); }
        }
        mx = fmaxf(mx, mx2);
    } else {
#pragma unroll
    for (int tl = 0; tl < 2; ++tl) {
        if (NEAR && tl == 1) asm volatile("" ::: "memory");
#pragma unroll
        for (int r = 0; r < 16; ++r) {
            float v;
            if (NEAR) { const int key = 32 * tl + (r & 3) + 8 * (r >> 2) + 4 * hh; const int dist = dbase - dstep * key; int idx = dist < 0 ? 0 : dist; idx = idx > 127 ? 127 : idx;
                v = (S[tl][r] + biasg[idx]) * NSA_L2E + cbias2;
                bool ok = true; if (MASK == 1 || MASK == 3) ok = dist >= 0; if (MASK == 2) ok = dist >= 0 && dist < 512;
                v = ok ? v : -INFINITY;
            } else {
                v = S[tl][r] * NSA_L2E + cbias2;
                if (MASK == 2) { const int key = 32 * tl + (r & 3) + 8 * (r >> 2) + 4 * hh; const int dist = dbase - dstep * key; v = (dist >= 0 && dist < 512) ? v : -INFINITY; }
            }
            S[tl][r] = v; mx = fmaxf(mx, v);
        }
    }
    }
    if (PASS == 2) {
        { auto rr = __builtin_amdgcn_permlane32_swap(__float_as_uint(mx), __float_as_uint(mx), false, false); mx = fmaxf(__uint_as_float(rr[0]), __uint_as_float(rr[1])); }
        st.m = fmaxf(st.m, mx);
    } else if (PASS == 0) {
        { auto rr = __builtin_amdgcn_permlane32_swap(__float_as_uint(mx), __float_as_uint(mx), false, false); mx = fmaxf(__uint_as_float(rr[0]), __uint_as_float(rr[1])); }
        const float mn = fmaxf(st.m, mx), mref = mn == -INFINITY ? 0.f : mn;
        if (__any(mn != st.m)) {
            const float alpha = __builtin_amdgcn_exp2f(st.m - mref);
#pragma unroll
            for (int r = 0; r < 16; ++r) { st.O0[r] *= alpha; st.O1[r] *= alpha; }
            st.l *= alpha; st.m = mn;
        }
        float ls = 0.f;
        if (PLAIN) { const float off = cbias2 - mref;
#pragma unroll
            for (int tl = 0; tl < 2; ++tl)
#pragma unroll
                for (int r = 0; r < 16; ++r) { const float p = __builtin_amdgcn_exp2f(__builtin_fmaf(S[tl][r], NSA_L2E, off)); S[tl][r] = p; ls += p; }
        } else {
#pragma unroll
        for (int tl = 0; tl < 2; ++tl)
#pragma unroll
            for (int r = 0; r < 16; ++r) { const float p = __builtin_amdgcn_exp2f(S[tl][r] - mref); S[tl][r] = p; ls += p; }
        }
        st.l += ls;
#pragma unroll
        for (int tl = 0; tl < 2; ++tl)
#pragma unroll
            for (int s = 0; s < 2; ++s) { u32x4_t w; w.x = pkbf(S[tl][8 * s + 0], S[tl][8 * s + 1]); w.y = pkbf(S[tl][8 * s + 2], S[tl][8 * s + 3]); w.z = pkbf(S[tl][8 * s + 4], S[tl][8 * s + 5]); w.w = pkbf(S[tl][8 * s + 6], S[tl][8 * s + 7]);
                const bf16x8 P = __builtin_bit_cast(bf16x8, w);
                st.O0 = __builtin_amdgcn_mfma_f32_32x32x16_bf16(Vc[2 * tl + s], P, st.O0, 0, 0, 0);
                st.O1 = __builtin_amdgcn_mfma_f32_32x32x16_bf16(Vc[4 + 2 * tl + s], P, st.O1, 0, 0, 0); }
    } else {
        const float mref = minv == -INFINITY ? 0.f : minv;
        if (PLAIN) {
#pragma unroll
            for (int tl = 0; tl < 2; ++tl)
#pragma unroll
                for (int r = 0; r < 16; ++r) S[tl][r] = __builtin_fmaf(S[tl][r], NSA_L2E, cbias2);
        }
#pragma unroll
        for (int tl = 0; tl < 2; ++tl)
#pragma unroll
            for (int rg = 0; rg < 4; ++rg) { const float p0 = __builtin_amdgcn_exp2f(S[tl][4 * rg + 0] - mref) * linv, p1 = __builtin_amdgcn_exp2f(S[tl][4 * rg + 1] - mref) * linv,
                                                         p2 = __builtin_amdgcn_exp2f(S[tl][4 * rg + 2] - mref) * linv, p3 = __builtin_amdgcn_exp2f(S[tl][4 * rg + 3] - mref) * linv;
                gs[4 * tl + rg] = (p0 + p1) + (p2 + p3); lastv[4 * tl + rg] = p3; }
    }
}
#define NSA_BAR() do { asm volatile("s_waitcnt lgkmcnt(0)" ::: "memory"); __builtin_amdgcn_s_barrier(); asm volatile("" ::: "memory"); } while (0)

__device__ __forceinline__ void nsa_relayout(Frame& F) {
    ArgsP ap = kargs();
    LAS unsigned char* vt = F.lds + RING_OFF + F.wave * 16384 + 2048;
    const int gw = F.vcu * NWAVES + F.wave, NGW = F.G * NWAVES, lane = F.lane, hh = lane >> 5;
    const bf16* KV = WSP(bf16, WS_KV1); bf16* KF = WSP(bf16, WS_KSELF); bf16* VF = WSP(bf16, WS_VSELF);
    const LAS unsigned char* vrd = vt + (4 * hh + ((lane & 15) >> 2)) * 192 + (16 * ((lane >> 4) & 1) + 4 * (lane & 3)) * 2;
    for (int it = gw; it < 2 * 8 * 128; it += NGW) {
        const int pair = it >> 10, bh = (it >> 7) & 7, j = it & 127;
        const bf16* ks = KV + (size_t)(2 + 2 * pair) * KVSZ + ((size_t)bh * T + 64 * j) * HD; const bf16* vs = ks + KVSZ;
        bf16* kf = (pair ? WSP(bf16, WS_KWINF) : KF) + (size_t)(bh * 128 + j) * 4096; bf16* vf = (pair ? WSP(bf16, WS_VWINF) : VF) + (size_t)(bh * 128 + j) * 4096;
        u32x4_t kv_[8], vv_[8];
#pragma unroll
        for (int f = 0; f < 8; ++f) { kv_[f] = *(const u32x4_t*)(ks + (32 * (f >> 2) + (lane & 31)) * HD + 16 * (f & 3) + 8 * hh); const int id = lane + 64 * f; vv_[f] = *(const u32x4_t*)(vs + (id >> 3) * HD + (id & 7) * 8); }
#pragma unroll
        for (int f = 0; f < 8; ++f) { *(u32x4_t*)(kf + (f * 64 + lane) * 8) = kv_[f]; const int id = lane + 64 * f; *(LAS u32x4_t*)(vt + (id >> 3) * 192 + (id & 7) * 16) = vv_[f]; }
        LDS_WAIT(); asm volatile("" ::: "memory");
#pragma unroll
        for (int f = 0; f < 8; ++f) { const int dt = f >> 2, k4 = f & 3; const LAS unsigned char* p = vrd + dt * 64 + 16 * k4 * 192; const bf16x8 fr = tr_pair(p, p + 8 * 192); *(bf16x8*)(vf + (f * 64 + lane) * 8) = fr; }
        LDS_WAIT(); asm volatile("" ::: "memory");
    }
}
constexpr int SC_OACC = 0;
constexpr int SC_M = 66560, SC_L = SC_M + 1024;
constexpr int SC_QS = 75776;
constexpr float SC_SHIFT = 10.0f, SC_LSMAX = 262144.0f;
constexpr int SC_FLAG = SC_L + 1024;
constexpr int SC_LIST = SC_QS + 256 * 144;
constexpr int SC_CAP = 136;
static_assert(SC_LIST + 8 * SC_CAP * 12 <= NSA_OFF_BIAS, "selected-branch LDS map");
__device__ __forceinline__ unsigned f2ord(float f) { const unsigned u = __float_as_uint(f); return (u & 0x80000000u) ? ~u : (u | 0x80000000u); }
__device__ __forceinline__ float ord2f(unsigned u) { return u == 0u ? -INFINITY : ((u & 0x80000000u) ? __uint_as_float(u & 0x7fffffffu) : __uint_as_float(~u)); }
template <int PB> __device__ __forceinline__ void sc_item(LAS unsigned char* L, const bf16x8 (&Kc)[8], const bf16x8 (&Vc)[8], const bf16x8 (&Qg)[4], int lane, int col, bool valid, int tcol, int j, int qb, float b31, const LAS float* biasg) {
    const int hh = lane >> 5;
    f32x16 S[2];
#pragma unroll
    for (int tl = 0; tl < 2; ++tl) {
#pragma unroll
        for (int r = 0; r < 16; ++r) S[tl][r] = 0.f;
#pragma unroll
        for (int ks = 0; ks < 4; ++ks) S[tl] = __builtin_amdgcn_mfma_f32_32x32x16_bf16(Kc[tl * 4 + ks], Qg[ks], S[tl], 0, 0, 0);
    }
    LAS unsigned* Mx = (LAS unsigned*)(L + SC_M); LAS int* Ls = (LAS int*)(L + SC_L); LAS int* Oa = (LAS int*)(L + SC_OACC);
    const bool nearb = j >= qb - 2;
    float mx = -INFINITY; const float cb = valid ? b31 : -INFINITY;
    if (nearb) {
        int dbase = tcol - 64 * j; asm volatile("" : "+v"(dbase));
#pragma unroll
        for (int tl = 0; tl < 2; ++tl)
#pragma unroll
            for (int r = 0; r < 16; ++r) { const int key = 32 * tl + (r & 3) + 8 * (r >> 2) + 4 * hh; const int dist = dbase - key; int idx = dist < 0 ? 0 : dist; idx = idx > 127 ? 127 : idx;
                float v = (S[tl][r] + biasg[idx]) * NSA_L2E; v = (dist >= 0 && valid) ? v : -INFINITY; S[tl][r] = v; mx = fmaxf(mx, v); }
    } else if (PB == 0) {
        float m0 = fmaxf(S[0][0], S[1][0]), m1 = fmaxf(S[0][1], S[1][1]);
#pragma unroll
        for (int r = 2; r < 16; r += 2) { m0 = fmaxf(m0, fmaxf(S[0][r], S[1][r])); m1 = fmaxf(m1, fmaxf(S[0][r + 1], S[1][r + 1])); }
        mx = __builtin_fmaf(fmaxf(m0, m1), NSA_L2E, cb);
    }
    if (PB == 0) {
        { auto rr = __builtin_amdgcn_permlane32_swap(__float_as_uint(mx), __float_as_uint(mx), false, false); mx = fmaxf(__uint_as_float(rr[0]), __uint_as_float(rr[1])); }
        if (valid && hh == 0) __hip_atomic_fetch_max(Mx + col, f2ord(mx), __ATOMIC_RELAXED, __HIP_MEMORY_SCOPE_WORKGROUP);
    } else {
        const float mref = (valid ? ord2f(Mx[col]) : 0.f) - SC_SHIFT;
        const float esc = nearb ? 1.0f : NSA_L2E, eof = nearb ? -mref : cb - mref;
        float ls = 0.f;
        f32x16 O0, O1;
#pragma unroll
        for (int r = 0; r < 16; ++r) { O0[r] = 0.f; O1[r] = 0.f; }
#define SC_EXPCHUNK(k4_, dst) do { const int tl_ = (k4_) >> 1, s8_ = 8 * ((k4_) & 1); float q_[8]; \
            _Pragma("unroll") for (int e_ = 0; e_ < 8; ++e_) { q_[e_] = __builtin_amdgcn_exp2f(__builtin_fmaf(S[tl_][s8_ + e_], esc, eof)); ls += q_[e_]; } \
            u32x4_t w_; w_.x = pkbf(q_[0], q_[1]); w_.y = pkbf(q_[2], q_[3]); w_.z = pkbf(q_[4], q_[5]); w_.w = pkbf(q_[6], q_[7]); dst = __builtin_bit_cast(bf16x8, w_); } while (0)
        bf16x8 Pa, Pb;
        SC_EXPCHUNK(0, Pa);
        __builtin_amdgcn_sched_barrier(0);
        O0 = __builtin_amdgcn_mfma_f32_32x32x16_bf16(Vc[0], Pa, O0, 0, 0, 0); O1 = __builtin_amdgcn_mfma_f32_32x32x16_bf16(Vc[4], Pa, O1, 0, 0, 0);
        SC_EXPCHUNK(1, Pb);
        __builtin_amdgcn_sched_barrier(0);
        O0 = __builtin_amdgcn_mfma_f32_32x32x16_bf16(Vc[1], Pb, O0, 0, 0, 0); O1 = __builtin_amdgcn_mfma_f32_32x32x16_bf16(Vc[5], Pb, O1, 0, 0, 0);
        SC_EXPCHUNK(2, Pa);
        __builtin_amdgcn_sched_barrier(0);
        O0 = __builtin_amdgcn_mfma_f32_32x32x16_bf16(Vc[2], Pa, O0, 0, 0, 0); O1 = __builtin_amdgcn_mfma_f32_32x32x16_bf16(Vc[6], Pa, O1, 0, 0, 0);
        SC_EXPCHUNK(3, Pb);
        __builtin_amdgcn_sched_barrier(0);
        O0 = __builtin_amdgcn_mfma_f32_32x32x16_bf16(Vc[3], Pb, O0, 0, 0, 0); O1 = __builtin_amdgcn_mfma_f32_32x32x16_bf16(Vc[7], Pb, O1, 0, 0, 0);
#undef SC_EXPCHUNK
        { auto rr = __builtin_amdgcn_permlane32_swap(__float_as_uint(ls), __float_as_uint(ls), false, false); ls = __uint_as_float(rr[0]) + __uint_as_float(rr[1]); }
        if (valid && hh == 0) __hip_atomic_fetch_add(Ls + col, (int)ls, __ATOMIC_RELAXED, __HIP_MEMORY_SCOPE_WORKGROUP);
        if (valid && ls > SC_LSMAX) *(volatile LAS unsigned*)(L + SC_FLAG) = 1u;
        if (valid) { LAS int* o = Oa + col * 65 + 4 * hh;
#pragma unroll
            for (int r = 0; r < 16; ++r) __hip_atomic_fetch_add(o + (r & 3) + 8 * (r >> 2), (int)O0[r], __ATOMIC_RELAXED, __HIP_MEMORY_SCOPE_WORKGROUP);
#pragma unroll
            for (int r = 0; r < 16; ++r) __hip_atomic_fetch_add(o + 32 + (r & 3) + 8 * (r >> 2), (int)O1[r], __ATOMIC_RELAXED, __HIP_MEMORY_SCOPE_WORKGROUP); }
    }
}
__device__ __forceinline__ int sc_build(LAS unsigned char* L, int lane, int w, int qb, unsigned ws0, unsigned ws1, unsigned ws2, unsigned ws3) {
    LAS int* il = (LAS int*)(L + SC_LIST) + w * SC_CAP; LAS unsigned char* iq = L + SC_LIST + 8 * SC_CAP * 4 + w * SC_CAP * 8; int n = 0;
#pragma unroll 1
    for (int j = w; j <= qb; j += 8) {
        if (j == 0 || j >= qb - 1) continue;
        const unsigned wsel = j < 32 ? ws0 : j < 64 ? ws1 : j < 96 ? ws2 : ws3; const bool bit = (wsel >> (j & 31)) & 1u; const unsigned long long mask = __ballot(bit); const int cnt = __popcll(mask);
        const int ntl = (cnt + 7) >> 3; if (ntl == 0) continue;
        const int rank = __popcll(mask & ((1ull << lane) - 1ull));
        if (bit) iq[n * 8 + rank] = (unsigned char)lane;
        if (lane < 8 * ntl - cnt) iq[n * 8 + cnt + lane] = 0xFF;
        if (lane < ntl) il[n + lane] = j;
        n += ntl;
    }
    asm volatile("s_waitcnt lgkmcnt(0)" ::: "memory");
    return n;
}
template <int PB> __device__ __forceinline__ void sc_pass(LAS unsigned char* L, const bf16* KF, const bf16* VF, int lane, int w, int qb, int nitems, float b31, const LAS float* biasg) {
    const int c = lane & 31, hh = lane >> 5;
    const LAS int* il = (const LAS int*)(L + SC_LIST) + w * SC_CAP; const LAS unsigned char* iq = L + SC_LIST + 8 * SC_CAP * 4 + w * SC_CAP * 8; const LAS unsigned char* Qs = L + SC_QS;
    bf16x8 Kc[8], Vc[8], Kn[8], Vn[8];
    int it = __builtin_amdgcn_readfirstlane(il[0]);
    { const int j0 = it & 255;
#pragma unroll
      for (int f = 0; f < 8; ++f) { Kc[f] = *(const bf16x8*)((const char*)KF + (size_t)j0 * 8192 + ((unsigned)lane * 16u + (unsigned)f * 1024u)); if (PB == 1) Vc[f] = *(const bf16x8*)((const char*)VF + (size_t)j0 * 8192 + ((unsigned)lane * 16u + (unsigned)f * 1024u)); } }
#pragma unroll 1
    for (int i = 0; i < nitems; ++i) {
        const int inx = __builtin_amdgcn_readfirstlane(il[i + 1 < nitems ? i + 1 : i]);
        const int j = it & 255, jn = inx & 255;
        const int qraw = iq[i * 8 + (c >> 2)];
        const bool ld = jn != j;
        if (ld) {
#pragma unroll
            for (int f = 0; f < 8; ++f) Kn[f] = *(const bf16x8*)((const char*)KF + (size_t)jn * 8192 + ((unsigned)lane * 16u + (unsigned)f * 1024u)); }
        const bool valid = qraw != 0xFF; const int q = valid ? qraw : 0; const int col = 4 * q + (c & 3), tcol = 64 * qb + q;
        bf16x8 Qg[4];
#pragma unroll
        for (int ks = 0; ks < 4; ++ks) Qg[ks] = *(const LAS bf16x8*)(Qs + col * 144 + (16 * ks + 8 * hh) * 2);
        if (PB == 1 && ld) {
#pragma unroll
            for (int f = 0; f < 8; ++f) Vn[f] = *(const bf16x8*)((const char*)VF + (size_t)jn * 8192 + ((unsigned)lane * 16u + (unsigned)f * 1024u)); }
        sc_item<PB>(L, Kc, Vc, Qg, lane, col, valid, tcol, j, qb, b31, biasg);
        if (ld) {
#pragma unroll
            for (int f = 0; f < 8; ++f) { Kc[f] = Kn[f]; if (PB == 1) Vc[f] = Vn[f]; } }
        it = inx;
    }
}
template <int VAR = 0> __device__ __forceinline__ void nsa_mfma(Frame& F, size_t out_off = WS_QO) {
    ArgsP ap = kargs();
    LAS unsigned char* L = F.lds + RING_OFF;
    LAS float* impL = (LAS float*)(L + NSA_OFF_IMP); LAS float* biasL = (LAS float*)(L + NSA_OFF_BIAS); LAS unsigned* selL = (LAS unsigned*)(L + NSA_OFF_SEL);
    const int tid_outer = F.tid, w = F.wave;
    const float* rel_bias = ap->in[2];
    const int bh = F.vcu >> 5, b = bh >> 2, hkv = bh & 3, ui = F.vcu & 31;
    if (F.G != 256) return;
    { const int gg = tid_outer >> 7, dd = tid_outer & 127; biasL[gg * 128 + dd] = rel_bias[t5_bucket(dd) * 16 + hkv * 4 + gg];
      LAS float* T1 = (LAS float*)(L + NSA_OFF_T1);
#pragma unroll
      for (int e = 0; e < 2; ++e) { const int x = (tid_outer & 127) + 128 * e, dist = x - 64; T1[gg * 256 + x] = dist < 0 ? -INFINITY : rel_bias[t5_bucket(dist) * 16 + hkv * 4 + gg] * NSA_L2E; } }
#define NSA_PTRS_C() ArgsP ap2 = kargs(); const bf16* kc = (const bf16*)(ap2->ws + WS_KCVC) + (size_t)bh * 512 * 64; const bf16* vc = kc + (size_t)4096 * 64
#define NSA_PTRS_KV(kname, vname, idx) ArgsP ap3 = kargs(); const bf16* kname = (const bf16*)(ap3->ws + WS_KV1) + (size_t)(idx) * KVSZ + (size_t)bh * T * HD; const bf16* vname = kname + KVSZ
#define NSA_PARK_ADD() do { _Pragma("unroll") for (int s_ = 0; s_ < 2; ++s_) _Pragma("unroll") for (int r8 = 0; r8 < 2; ++r8) { const u32x4_t a_ = ((const u32x4_t*)park)[4 * s_ + r8], b_ = ((const u32x4_t*)park)[4 * s_ + 2 + r8]; const unsigned* ap_ = (const unsigned*)&a_; const unsigned* bp_ = (const unsigned*)&b_; \
        _Pragma("unroll") for (int e = 0; e < 4; ++e) { st.O0[8 * r8 + 2 * e] += bflo(ap_[e]); st.O0[8 * r8 + 2 * e + 1] += bfhi(ap_[e]); st.O1[8 * r8 + 2 * e] += bflo(bp_[e]); st.O1[8 * r8 + 2 * e + 1] += bfhi(bp_[e]); } } } while (0)
#define NSA_LSUM(dst, src) do { auto rr_ = __builtin_amdgcn_permlane32_swap(__float_as_uint(src), __float_as_uint(src), false, false); dst = __uint_as_float(rr_[0]) + __uint_as_float(rr_[1]); } while (0)
    NSA_BAR();
    float gs[8], lastv[8];
#pragma unroll 1
    for (int un = 0; un < 4; ++un) {
        int tid = tid_outer; asm volatile("" : "+v"(tid)); const int lane = tid & 63, c = lane & 31, hh = lane >> 5, g = c & 3, hq = hkv * 4 + g;
        const float b31 = kargs()->in[2][31 * 16 + hq] * NSA_L2E; const LAS float* biasg = biasL + g * 128; const LAS float* t1g = (const LAS float*)(L + NSA_OFF_T1) + g * 256;
        const int qb = un == 0 ? ui : un == 1 ? 63 - ui : un == 2 ? 64 + ui : 127 - ui;
        const int ql = 8 * w + (c >> 2), t = 64 * qb + ql;
        bf16* qrow; float gate_c, gate_s, gate_w; float* park;
        { ArgsP ap1 = kargs(); qrow = (bf16*)(ap1->ws + WS_QO) + (size_t)(b * T + t) * D + hq * HD; const float* gr = (const float*)(ap1->ws + WS_GATES) + (size_t)(b * T + t) * 64 + hq; gate_c = gr[0]; gate_s = gr[16]; gate_w = gr[32];
          park = (float*)(ap1->ws + WS_PARKG) + ((size_t)blockIdx.x * 512 + tid) * 32; }
        const LAS unsigned char* Qrow = L + SC_QS + (32 * w + c) * 144 + 16 * hh;
        {
#pragma unroll
          for (int ks = 0; ks < 4; ++ks) *(LAS bf16x8*)(L + SC_QS + (32 * w + c) * 144 + (16 * ks + 8 * hh) * 2) = *(const bf16x8*)(qrow + 16 * ks + 8 * hh); }
        asm volatile("s_waitcnt lgkmcnt(0)" ::: "memory");
        NsaState st;
#define NSA_LDK(dst, base, blk) do { const char* bb_ = (const char*)(base) + (size_t)(blk) * 8192; const unsigned vo_ = (unsigned)lane * 16u;   \
        _Pragma("unroll") for (int f_ = 0; f_ < 8; ++f_) dst[f_] = *(const bf16x8*)(bb_ + (vo_ + (unsigned)f_ * 1024u)); } while (0)
        nsa_reset(st);
        const int jb0 = qb >= 8 ? qb - 8 : 0;
        if (!(VAR & 4)) {
            ArgsP ap3 = kargs(); const bf16* KFw = (const bf16*)(ap3->ws + WS_KWINF) + (size_t)bh * 128 * 4096; const bf16* VFw = (const bf16*)(ap3->ws + WS_VWINF) + (size_t)bh * 128 * 4096;
            bf16x8 Kc[8];
            NSA_LDK(Kc, KFw, jb0);
#pragma unroll 1
            for (int jb = jb0; jb <= qb; ++jb) {
                bf16x8 Vc[8];
                NSA_LDK(Vc, VFw, jb);
                const char* kn = (const char*)KFw + (size_t)(jb + 1) * 8192;
                if (jb >= qb - 2) { if (jb > jb0 && jb > qb - 2) NSA_LDK(Kc, KFw, jb);
                    nsa_step_r<true, 1, 0, true>(st, Kc, Vc, Qrow, lane, 0.f, t - 64 * jb, 1, t1g, 0.f, 0.f, gs, lastv); }
                else if (jb == qb - 8) nsa_step_r<false, 2, 0>(st, Kc, Vc, Qrow, lane, b31, t - 64 * jb, 1, biasg, 0.f, 0.f, gs, lastv);
                else { if (jb > jb0 && jb == qb - 7) NSA_LDK(Kc, KFw, jb);
                    nsa_step_r<false, 0, 0, false, true>(st, Kc, Vc, Qrow, lane, b31, 0, 0, biasg, 0.f, 0.f, gs, lastv, kn); }
            }
        }
        { float ltot; NSA_LSUM(ltot, st.l); const float sc = ltot > 0.f ? gate_w / ltot : 0.f;
#pragma unroll
          for (int r8 = 0; r8 < 2; ++r8) { u32x4_t a, b2; unsigned* ap_ = (unsigned*)&a; unsigned* bp_ = (unsigned*)&b2; for (int e = 0; e < 4; ++e) { ap_[e] = pkbf(sc * st.O0[8 * r8 + 2 * e], sc * st.O0[8 * r8 + 2 * e + 1]); bp_[e] = pkbf(sc * st.O1[8 * r8 + 2 * e], sc * st.O1[8 * r8 + 2 * e + 1]); } ((u32x4_t*)park)[r8] = a; ((u32x4_t*)park)[2 + r8] = b2; } }
        const int nbc = (VAR & 1) ? 0 : (4 * qb + 3 + 63) >> 6;
        const int dbc = t - 31;
        nsa_reset(st);
        const bf16* KFc; const bf16* VFc; { ArgsP ap2 = kargs(); KFc = (const bf16*)(ap2->ws + WS_KCF) + (size_t)bh * 8 * 4096; VFc = (const bf16*)(ap2->ws + WS_VCF) + (size_t)bh * 8 * 4096; }
        {
#pragma unroll 1
            for (int i = 0; i < nbc; ++i) {
                bf16x8 Kc[8], Vc[8];
                NSA_LDK(Kc, KFc, i); NSA_LDK(Vc, VFc, i);
                const bool near_ = 64 * i + 63 >= 4 * qb - 8;
                if (near_) nsa_step_r<true, 3, 0>(st, Kc, Vc, Qrow, lane, 0.f, dbc - 16 * 64 * i, 16, biasg, 0.f, 0.f, gs, lastv);
                else nsa_step_r<false, 0, 0>(st, Kc, Vc, Qrow, lane, b31, 0, 0, biasg, 0.f, 0.f, gs, lastv);
            }
        }
        const float mfin = st.m; float lfin; NSA_LSUM(lfin, st.l);
        { const float inv = lfin > 0.f ? 1.0f / lfin : 0.f; const float sc = gate_c * inv;
#pragma unroll
          for (int r8 = 0; r8 < 2; ++r8) { u32x4_t a, b2; unsigned* ap_ = (unsigned*)&a; unsigned* bp_ = (unsigned*)&b2; for (int e = 0; e < 4; ++e) { ap_[e] = pkbf(sc * st.O0[8 * r8 + 2 * e], sc * st.O0[8 * r8 + 2 * e + 1]); bp_[e] = pkbf(sc * st.O1[8 * r8 + 2 * e], sc * st.O1[8 * r8 + 2 * e + 1]); } ((u32x4_t*)park)[4 + r8] = a; ((u32x4_t*)park)[6 + r8] = b2; } }
        if (nbc > 0) {
            const float linv = lfin > 0.f ? 1.0f / lfin : 0.f; float carry_last = 0.f;
#pragma unroll 1
            for (int i = 0; i < nbc; ++i) {
                bf16x8 Kc[8];
                NSA_LDK(Kc, KFc, i);
                const bool near_ = 64 * i + 63 >= 4 * qb - 8;
                if (near_) nsa_step_r<true, 3, 1>(st, Kc, Kc, Qrow, lane, 0.f, dbc - 16 * 64 * i, 16, biasg, mfin, linv, gs, lastv);
                else nsa_step_r<false, 0, 1>(st, Kc, Kc, Qrow, lane, b31, 0, 0, biasg, mfin, linv, gs, lastv);
                float plp = carry_last;
#pragma unroll
                for (int k8 = 0; k8 < 8; ++k8) {
                    const float pl = swap32(lastv[k8]);
                    const float prev = hh ? pl : plp;
                    float v = gs[k8] + prev;
                    v += dpp_xor1(v); v += dpp_xor2(v);
                    if (g == 0) impL[ql * 128 + 16 * i + 2 * k8 + hh] = v;
                    plp = pl;
                }
                carry_last = plp;
            }
        }
        asm volatile("s_waitcnt lgkmcnt(0)" ::: "memory");
#pragma unroll 1
        for (int qi = 0; qi < ((VAR & 8) ? 0 : 8); qi += 4) {
            unsigned k0[4], k1[4];
#pragma unroll
            for (int u = 0; u < 4; ++u) { const int q2 = 8 * w + qi + u; const int ja = lane, jb_ = lane + 64;
                const bool fa = (ja == 0) || (ja == qb) || (ja == qb - 1), fb = (jb_ == qb) || (jb_ == qb - 1);
                const float i0 = ja <= qb ? impL[q2 * 128 + ja] : 0.f, i1 = jb_ <= qb ? impL[q2 * 128 + jb_] : 0.f;
                k0[u] = ja <= qb ? __float_as_uint(fa ? 100.0f : i0) + 1u : 0u; k1[u] = jb_ <= qb ? __float_as_uint(fb ? 100.0f : i1) + 1u : 0u; }
            unsigned pf[4] = {0u, 0u, 0u, 0u};
            if (qb >= 16) {
                int exact = 0;
#pragma unroll 1
                for (int bit = 30; bit >= 0 && exact != 15; --bit) {
#pragma unroll
                    for (int u = 0; u < 4; ++u) { const unsigned cand = pf[u] | (1u << bit); const int n = __popcll(__ballot(k0[u] >= cand)) + __popcll(__ballot(k1[u] >= cand)); pf[u] = n >= 16 ? cand : pf[u]; exact |= (n == 16) ? (1 << u) : 0; }
                }
            } else { pf[0] = pf[1] = pf[2] = pf[3] = 1u; }
#pragma unroll
            for (int u = 0; u < 4; ++u) {
                unsigned long long g0 = __ballot(k0[u] > pf[u]), g1 = __ballot(k1[u] > pf[u]), t0 = __ballot(k0[u] == pf[u]), t1 = __ballot(k1[u] == pf[u]);
                int need = 16 - (__popcll(g0) + __popcll(g1));
                if (qb < 16) { g0 |= t0; g1 |= t1; need = 0; }
#pragma unroll 1
                while (need > 0 && (t0 | t1)) { if (t0) { const unsigned long long lb = t0 & (0ull - t0); g0 |= lb; t0 ^= lb; } else { const unsigned long long lb = t1 & (0ull - t1); g1 |= lb; t1 ^= lb; } --need; }
                if (lane == 0) { const int q2 = 8 * w + qi + u; selL[q2 * 4 + 0] = (unsigned)g0; selL[q2 * 4 + 1] = (unsigned)(g0 >> 32); selL[q2 * 4 + 2] = (unsigned)g1; selL[q2 * 4 + 3] = (unsigned)(g1 >> 32); }
            }
        }
        NSA_BAR();
        if (!(VAR & 2)) {
            { LAS float* Oa = (LAS float*)(L + SC_OACC) + (32 * w + c) * 65 + 32 * hh;
#pragma unroll
              for (int i = 0; i < 32; ++i) Oa[i] = 0.f;
              if (hh == 0) { ((LAS unsigned*)(L + SC_M))[32 * w + c] = 0u; ((LAS float*)(L + SC_L))[32 * w + c] = 0.f; }
              if (tid == 0) *(volatile LAS unsigned*)(L + SC_FLAG) = 0u;
            }
            const unsigned ws0 = selL[lane * 4 + 0], ws1 = selL[lane * 4 + 1], ws2 = selL[lane * 4 + 2], ws3 = selL[lane * 4 + 3];
            NSA_BAR();
            ArgsP ap4 = kargs(); const bf16* KFb = (const bf16*)(ap4->ws + WS_KSELF) + (size_t)bh * 128 * 4096; const bf16* VFb = (const bf16*)(ap4->ws + WS_VSELF) + (size_t)bh * 128 * 4096;
            const int nitems = sc_build(L, lane, w, qb, ws0, ws1, ws2, ws3);
#define NSA_FORCED(PASSNO) do { _Pragma("unroll 1") for (int fi = 0; fi < 3; ++fi) { const int j = fi == 0 ? qb : fi == 1 ? qb - 1 : 0; if (j < 0 || (fi == 2 && qb <= 1)) continue; \
                bf16x8 Kc[8], Vc[8]; NSA_LDK(Kc, KFb, j); if (PASSNO == 0) NSA_LDK(Vc, VFb, j); \
                if (j >= qb - 2) nsa_step_r<true, 1, PASSNO, true>(st, Kc, (PASSNO == 0 ? Vc : Kc), Qrow, lane, 0.f, t - 64 * j, 1, t1g, 0.f, 0.f, gs, lastv); \
                else nsa_step_r<false, 0, PASSNO>(st, Kc, (PASSNO == 0 ? Vc : Kc), Qrow, lane, b31, 0, 0, biasg, 0.f, 0.f, gs, lastv); } } while (0)
            nsa_reset(st);
            NSA_FORCED(2);
            if (hh == 0) ((LAS unsigned*)(L + SC_M))[32 * w + c] = f2ord(st.m);
            NSA_BAR();
            if (nitems > 0) sc_pass<1>(L, KFb, VFb, lane, w, qb, nitems, b31, biasg);
            NSA_BAR();
#ifdef PROBE_FORCE_FALLBACK
            const bool redo = true;
#else
            const bool redo = *(volatile LAS unsigned*)(L + SC_FLAG) != 0u;
#endif
            if (redo) {
                NSA_BAR();
                { LAS float* Oz = (LAS float*)(L + SC_OACC) + (32 * w + c) * 65 + 32 * hh;
#pragma unroll
                  for (int i = 0; i < 32; ++i) Oz[i] = 0.f;
                  if (hh == 0) { ((LAS unsigned*)(L + SC_M))[32 * w + c] = 0u; ((LAS float*)(L + SC_L))[32 * w + c] = 0.f; }
                  if (tid == 0) *(volatile LAS unsigned*)(L + SC_FLAG) = 0u; }
                NSA_BAR();
                if (nitems > 0) sc_pass<0>(L, KFb, VFb, lane, w, qb, nitems, b31, biasg);
                NSA_BAR();
                if (nitems > 0) sc_pass<1>(L, KFb, VFb, lane, w, qb, nitems, b31, biasg);
                NSA_BAR();
            }
            nsa_reset(st);
            NSA_FORCED(0);
            { const LAS int* Oa = (const LAS int*)(L + SC_OACC) + (32 * w + c) * 65 + 4 * hh; const float lrest = (float)((const LAS int*)(L + SC_L))[32 * w + c]; const float mrest = ord2f(((const LAS unsigned*)(L + SC_M))[32 * w + c]);
              float lf; NSA_LSUM(lf, st.l); const float Mx_ = fmaxf(st.m, mrest);
              const float af = __builtin_amdgcn_exp2f(st.m - Mx_), ar = (mrest == -INFINITY || lrest == 0.f) ? 0.f : __builtin_amdgcn_exp2f(mrest - Mx_ - SC_SHIFT);
              const float sc = gate_s / (lf * af + lrest * ar), sf = sc * af, sr = sc * ar;
#pragma unroll
              for (int r = 0; r < 16; ++r) { const int d = (r & 3) + 8 * (r >> 2); st.O0[r] = sf * st.O0[r] + sr * (float)Oa[d]; st.O1[r] = sf * st.O1[r] + sr * (float)Oa[32 + d]; } }
            NSA_PARK_ADD();
        } else {
#pragma unroll
            for (int r = 0; r < 16; ++r) { st.O0[r] = 0.f; st.O1[r] = 0.f; }
            NSA_PARK_ADD();
        }
#pragma unroll
        for (int rg = 0; rg < 4; ++rg) { u32x2_t w0, w1; w0.x = pkbf(st.O0[4 * rg], st.O0[4 * rg + 1]); w0.y = pkbf(st.O0[4 * rg + 2], st.O0[4 * rg + 3]); w1.x = pkbf(st.O1[4 * rg], st.O1[4 * rg + 1]); w1.y = pkbf(st.O1[4 * rg + 2], st.O1[4 * rg + 3]);
            bf16* orow = (bf16*)(kargs()->ws + out_off) + (size_t)(b * T + t) * D + hq * HD;
            if (VAR == 0 || out_off == WS_QO) { *(u32x2_t*)(orow + 8 * rg + 4 * hh) = w0; *(u32x2_t*)(orow + 32 + 8 * rg + 4 * hh) = w1; }
            else { asm volatile("" :: "v"(w0.x), "v"(w0.y), "v"(w1.x), "v"(w1.y)); } }
        NSA_BAR();
    }
}

#define PHASE_BEGIN() ArgsP ap = kargs(); (void)ap
template <int PH> __device__ __forceinline__ void run_phase(LAS unsigned char* lds_base) {
    Frame F; F.lds = lds_base;
    int bx = blockIdx.x, G = gridDim.x; asm volatile("" : "+s"(bx), "+s"(G));
    { int t_ = threadIdx.x; asm volatile("" : "+v"(t_)); F.tid = t_; F.lane = t_ & 63; F.wave = __builtin_amdgcn_readfirstlane(t_ >> 6); F.G = G; F.vcu = (G % 8 == 0) ? (bx % 8) * (G / 8) + bx / 8 : bx; }
    constexpr int ph = PH; constexpr int layer = (PH >= 7 && PH < 16) ? 1 : 0;
        switch (ph) {
        case 0:
#ifndef SKIP_P0
            p0_prologue<0>(F);
#endif
            break;
        case 1: {
            PHASE_BEGIN();
            pg8::Gemm g{WSP(bf16, WS_HB), WSP(bf16, WS_WQKV)}; pg8::StaticOrder S; S.init(M, NQKV, G, bx);
            pg8::fill_rstd(F.lds, WSP(float, WS_SSQ0), S);
            pg8::EpiQKV E{F.lds, WSP(bf16, WS_QO), WSP(bf16, WS_K0), WSP(bf16, WS_V0)};
            pg8::gemm_phase<pg8::EpiQKV, pg8::StaticOrder, D, D, D, PG8_ALIGN, PG8_SP2>(F.lds + RING_OFF, g, S, E);
        } break;
        case 2:
#ifdef USE_SB_SIMPLE
            sb_simple(F);
#else
            if (G == 256 && F.wave < 4) p0_prologue<2>(F, F.vcu * NWAVES + F.wave, G * NWAVES);
            sb_mfma(F);
            if (G == 256 && F.wave >= 4) p0_prologue<2>(F, F.vcu * NWAVES + F.wave, G * NWAVES);
#endif
            break;
        case 3: case 11: {
            PHASE_BEGIN();
            pg8::Gemm g{WSP(bf16, WS_QO), layer ? WSP(bf16, WS_WO1) : WSP(bf16, WS_WO0)}; pg8::StaticOrder S; S.init(M, D, G, bx);
            if (layer == 0) { pg8::EpiRes<false> E{(const void*)WSP(bf16, WS_HB), WSP(bf16, WS_HB), WSP(float, WS_SSQ1)};
                pg8::gemm_phase<pg8::EpiRes<false>, pg8::StaticOrder, D, D, D, PG8_ALIGN, PG8_SP2>(F.lds + RING_OFF, g, S, E); }
            else { pg8::EpiRes<false> E{(const void*)WSP(bf16, WS_PP), WSP(bf16, WS_HB), WSP(float, WS_SSQ0)};
                pg8::gemm_phase<pg8::EpiRes<false>, pg8::StaticOrder, D, D, D, PG8_ALIGN, PG8_SP2>(F.lds + RING_OFF, g, S, E); }
        } break;
        case 4: case 12: {
            PHASE_BEGIN();
            pg8::Gemm g{WSP(bf16, WS_HB), layer ? WSP(bf16, WS_WFI1) : WSP(bf16, WS_WFI0)}; pg8::StaticOrder S; S.init(M, NFFI, G, bx);
            pg8::fill_rstd(F.lds, layer ? WSP(float, WS_SSQ0) : WSP(float, WS_SSQ1), S);
            pg8::EpiSwiglu E{F.lds, WSP(bf16, WS_ACT)};
            pg8::gemm_phase<pg8::EpiSwiglu, pg8::StaticOrder, D, D, D, PG8_ALIGN, PG8_SP2>(F.lds + RING_OFF, g, S, E);
            {
                ArgsP ap5 = kargs();
                pg8::Gemm g2{(const bf16*)(ap5->ws + WS_PB) + (size_t)layer * M * PLE, (const bf16*)(ap5->ws + (layer ? WS_WP1 : WS_WP0))}; pg8::UpperHalfOrder S2{bx, G};
                pg8::EpiBf16Plain E2{(bf16*)(ap5->ws + WS_PP), D};
                pg8::gemm_phase<pg8::EpiBf16Plain, pg8::UpperHalfOrder, PLE, PLE, PLE, PG8_ALIGN, PG8_SP2>(F.lds + RING_OFF, g2, S2, E2);
            }
        } break;
        case 5: case 13: {
            {
                PHASE_BEGIN();
                pg8::Gemm g{WSP(bf16, WS_ACT), layer ? WSP(bf16, WS_WFO1) : WSP(bf16, WS_WFO0)}; pg8::StaticOrder S; S.init(M, D, G, bx);
                pg8::EpiRes<false> E{(const void*)WSP(bf16, WS_HB), WSP(bf16, WS_HB), layer ? WSP(float, WS_SSQ1) : WSP(float, WS_SSQ0)};
                pg8::gemm_phase<pg8::EpiRes<false>, pg8::StaticOrder, FF, FF, FF, PG8_ALIGN, PG8_SP2>(F.lds + RING_OFF, g, S, E);
            }
        } break;
        case 6: case 14: {
            PHASE_BEGIN();
            pg8::Gemm g{WSP(bf16, WS_HB), layer ? WSP(bf16, WS_WG1) : WSP(bf16, WS_WG0)}; pg8::StaticOrder S; S.init(M, D, G, bx);
            pg8::fill_rstd(F.lds, layer ? WSP(float, WS_SSQ1) : WSP(float, WS_SSQ0), S);
            if (layer == 0) { pg8::EpiGate<false> E{F.lds, WSP(bf16, WS_HB), ap->out, WSP(bf16, WS_PP), WSP(float, WS_SSQ1)};
                pg8::gemm_phase<pg8::EpiGate<false>, pg8::StaticOrder, D, D, D, PG8_ALIGN, PG8_SP2>(F.lds + RING_OFF, g, S, E); }
            else { pg8::EpiGateFinal E{F.lds, WSP(bf16, WS_HB), ap->out, WSP(bf16, WS_PP), WSP(float, WS_SSQ0), (unsigned*)(ap->ws + WS_CTL) + CW_PANEL, ap->in[6], (unsigned*)(ap->ws + WS_CTL) + CW_TMO};
                pg8::gemm_phase<pg8::EpiGateFinal, pg8::StaticOrder, D, D, D, PG8_ALIGN, PG8_SP2>(F.lds + RING_OFF, g, S, E); }
        } break;
        case 7: {
            PHASE_BEGIN();
            pg8::Gemm g{WSP(bf16, WS_PP), WSP(bf16, WS_WNSA)}; pg8::StaticOrder S; S.init(M, NNSA, G, bx);
            pg8::fill_rstd(F.lds, WSP(float, WS_SSQ1), S);
            pg8::EpiNSA E{F.lds, WSP(bf16, WS_QO), WSP(bf16, WS_KV1), KVSZ, WSP(float, WS_GATES)};
            pg8::gemm_phase<pg8::EpiNSA, pg8::StaticOrder, D, D, D, PG8_ALIGN, PG8_SP2>(F.lds + RING_OFF, g, S, E);
            if (G == 256 && bx >= 192 && F.wave == 0) b1_partials(F, bx - 192, 64);
            if (G == 256 && bx >= 192) {
                ArgsP ap7 = kargs(); constexpr int PB_HALF = M * PLE / 4;
                const GAS f32x4* p4 = (const GAS f32x4*)ap7->in[1] + PB_HALF; GAS unsigned long long* o8 = (GAS unsigned long long*)(ap7->ws + WS_PB) + PB_HALF;
                const int gt = (bx - 192) * (NWAVES * 64) + F.tid;
#pragma unroll 1
                for (int i0 = gt; i0 < PB_HALF; i0 += 8 * 64 * NWAVES * 64) { f32x4 v[8];
#pragma unroll
                    for (int k = 0; k < 8; ++k) v[k] = p4[i0 + k * (64 * NWAVES * 64)];
#pragma unroll
                    for (int k = 0; k < 8; ++k) o8[i0 + k * (64 * NWAVES * 64)] = (unsigned long long)pk2(v[k].x, v[k].y) | ((unsigned long long)pk2(v[k].z, v[k].w) << 32); }
            }
        } break;
        case 8: {
            PHASE_BEGIN();
            const int uix = F.vcu; const bool has = uix < 128; const int which = (uix >> 6) & 1, tile = (uix >> 2) & 15, ks = uix & 3;
            const bf16* Ab = WSP(bf16, WS_KV1) + (size_t)which * KVSZ + (size_t)(tile >> 1) * T * HD + (size_t)(tile & 1) * 256 * 1024 + ks * 512;
            const bf16* Bb = (which ? WSP(bf16, WS_WCV) : WSP(bf16, WS_WCK)) + ks * 512;
            pg8::Gemm g{Ab, Bb}; pg8::OneUnit S{has};
            pg8::EpiSlab E{WSP(bf16, WS_SLAB) + (size_t)((ks * 2 + which) * 16 + tile) * 65536};
            pg8::gemm_phase<pg8::EpiSlab, pg8::OneUnit, 1024, CMPK, 512, false, PG8_SP2>(F.lds + RING_OFF, g, S, E);
            nsa_relayout(F);
            if (F.G == 256 && F.vcu >= 128) p0_prologue<1>(F, (F.vcu - 128) * NWAVES + F.wave, 128 * NWAVES);
        } break;
        case 9:
#ifndef SKIP_C2
            cmp_stage2(F);
#endif
            break;
        case 10:
#ifdef USE_NSA_SIMPLE
            nsa_simple(F);
#else
            nsa_mfma<0>(F);
#endif
            break;
#ifdef PROBE_DUP
#ifndef PROBE_VAR
#define PROBE_VAR 0
#endif
        case 18: sb_mfma(F, WS_PP); break;
        case 19: nsa_mfma<(PROBE_VAR | 16)>(F, WS_SPARE); break;
#endif
#ifdef PROBE_NSA_DIFF
        case 16: nsa_simple(F, WS_SPARE); break;
        case 17: {
            PHASE_BEGIN(); bf16* q = WSP(bf16, WS_QO); const bf16* x = WSP(bf16, WS_SPARE); const int gt = F.vcu * (NWAVES * 64) + F.tid, NTH = F.G * NWAVES * 64;
            for (int i = gt; i < M * D; i += NTH) { const float a = bf2f(q[i]), r = bf2f(x[i]);
#ifdef PROBE_NSA_SCALE
                q[i] = (bf16)f2bf(1.25f * a);
#else
                q[i] = (bf16)f2bf(r + 32.0f * (a - r));
#endif
            }
        } break;
#endif
        default: {
            PHASE_BEGIN();
            const int gw = F.vcu * NWAVES + F.wave, NGW = F.G * NWAVES; const float* gf = ap->in[6]; const float* SSQ = WSP(float, WS_SSQ0);
            f32x4 gv[4];
#pragma unroll
            for (int j = 0; j < 4; ++j) gv[j] = ((const f32x4*)gf)[F.lane + 64 * j];
            for (int m = gw; m < M; m += NGW) {
                float s = F.lane < 16 ? SSQ[(size_t)m * 16 + F.lane] : 0.f; s = wave_sum(s);
                const float r = rsqrtf(s * (1.0f / 1024.0f) + RMS_EPS);
                GAS f32x4* xr = (GAS f32x4*)(ap->out + (size_t)m * D) + F.lane;
#pragma unroll
                for (int j = 0; j < 4; ++j) { f32x4 v = xr[64 * j]; v = v * r * gv[j]; xr[64 * j] = v; }
            }
        } break;
        }
}
__global__ void __launch_bounds__(NWAVES * 64, 2) fwd_kernel(Args args) {
    extern __shared__ __attribute__((aligned(16))) unsigned char lds[];
    LAS unsigned char* L = (LAS unsigned char*)lds;
    { const int tid = threadIdx.x; for (int u = tid; u < (LDS_BYTES - LDSCTL_OFF) / 4; u += NWAVES * 64) ((LAS unsigned*)(L + LDSCTL_OFF))[u] = 0u; }
    __syncthreads();
    XcdBarrier bar = xcd_barrier_post((unsigned*)((gu32*)(args.ws + WS_CTL) + CW_BAR), (volatile LAS unsigned*)(L + MISC_OFF) + 8);
#define BAR_() do { XcdBarrier b2 = bar; asm volatile("" : "+s"(b2.bar), "+s"(b2.x)); xcd_barrier(b2); } while (0)
#define STEP(P) run_phase<P>(L); BAR_()
#ifdef PROBE_DUP
#define DUP_(P) if (PROBE_DUP == (P)) { STEP(P == 2 ? 18 : P == 10 ? 19 : P); }
#else
#define DUP_(P)
#endif
    DUP_(0) STEP(0); DUP_(1) STEP(1); DUP_(2) STEP(2); DUP_(3) STEP(3); DUP_(4) STEP(4); STEP(5); STEP(6); DUP_(7) STEP(7); DUP_(8) STEP(8); DUP_(9) STEP(9);
#ifdef PROBE_NSA_DIFF
    STEP(16);
#endif
    DUP_(10) STEP(10);
#ifdef PROBE_NSA_DIFF
    STEP(17);
#endif
    STEP(11); STEP(12); STEP(13);
    run_phase<14>(L);
}

extern "C" void kernel_launch(void* const* d_in, const int* in_sizes, int n_in, void* d_out, int out_size, void* d_ws, size_t ws_size, hipStream_t stream) {
    static int grid = 0;
    if (grid == 0) {
        if (n_in != 21 || in_sizes[0] != M * D || out_size != M * D || ws_size < WS_END) { fprintf(stderr, "kernel_launch: unexpected shapes (n_in %d, in0 %d, out %d, ws %zu)\n", n_in, n_in > 0 ? in_sizes[0] : -1, out_size, ws_size); grid = -1; return; }
        int dev = 0, cus = 0, per_cu = 0;
        if (hipGetDevice(&dev) != hipSuccess || hipDeviceGetAttribute(&cus, hipDeviceAttributeMultiprocessorCount, dev) != hipSuccess) { grid = -1; return; }
        if (hipFuncSetAttribute((const void*)fwd_kernel, hipFuncAttributeMaxDynamicSharedMemorySize, LDS_BYTES) != hipSuccess) { fprintf(stderr, "kernel_launch: hipFuncSetAttribute failed\n"); grid = -1; return; }
        if (hipOccupancyMaxActiveBlocksPerMultiprocessor(&per_cu, (const void*)fwd_kernel, NWAVES * 64, LDS_BYTES) != hipSuccess || per_cu < 1) { fprintf(stderr, "kernel_launch: occupancy query reports %d blocks per CU\n", per_cu); per_cu = 1; }
        (void)hipGetLastError();
        if (cus != 256) { fprintf(stderr, "kernel_launch: built for a 256-CU device (found %d CUs); nothing launched\n", cus); grid = -1; return; }
        grid = cus * (per_cu < 1 ? 1 : 1);
    }
    if (grid < 0) return;
    if (hipMemsetAsync((char*)d_ws + WS_CTL, 0, CTL_ZERO_BYTES, stream) != hipSuccess) { fprintf(stderr, "kernel_launch: memset failed\n"); return; }
    Args a{};
    for (int i = 0; i < 21; ++i) a.in[i] = (const float*)d_in[i];
    a.out = (float*)d_out; a.ws = (unsigned char*)d_ws;
    hipLaunchKernelGGL(fwd_kernel, dim3(grid), dim3(NWAVES * 64), LDS_BYTES, stream, a);
    const hipError_t le = hipPeekAtLastError();
    if (le != hipSuccess) fprintf(stderr, "kernel_launch: launch failed: %s\n", hipGetErrorName(le));
}
```
